# Optimizing an MI355X kernel written in HIP

```python
import jax, jax.numpy as jnp
from jax import lax
import numpy as np

D_MODEL = 1024
BATCH = 8
SEQ = 2048
DEPTH = 2

N_MIXERS = 2
N_LAYERS_A = (DEPTH + 1) // 2
N_LAYERS_B = DEPTH // 2
PLE_DIM = 256
CONV_A_WIDTH = 3
D_RNN = D_MODEL
LRU_BLOCK = 256
N_LRU_BLOCKS = D_RNN // LRU_BLOCK
CONV_B_WIDTH = 4
RG_C = 8.0
N_GROUPS = 4
EXPERTS_PER_GROUP = 8
N_EXPERTS = N_GROUPS * EXPERTS_PER_GROUP
TOP_K = 2
D_EXPERT = 512
ROUTE_BLOCK = 128
EPS = 1e-6

kernel_name = 'hybrid_shortconv_rglru_hmoe_encoder'


def rmsnorm(x, g):
    x32 = x.astype(jnp.float32)
    y = x32 * lax.rsqrt(jnp.mean(x32 * x32, axis=-1, keepdims=True) + EPS)
    return (y * g.astype(jnp.float32)).astype(x.dtype)


def depthwise_conv(x, w, pad):
    return lax.conv_general_dilated(
        x, w[:, None, :], window_strides=(1,), padding=[pad],
        dimension_numbers=('NWC', 'WIO', 'NWC'), feature_group_count=x.shape[-1])


def short_conv_mixer(xn, w_in, conv_w, w_out):
    bgate, cgate, h = jnp.split(xn @ w_in, 3, axis=-1)
    u = depthwise_conv(cgate * h, conv_w, (1, 1))
    return (bgate * u) @ w_out


def _linear_combine(earlier, later):
    a_e, b_e = earlier
    a_l, b_l = later
    return a_l * a_e, a_l * b_e + b_l


def rglru_direction(uh, w_r, b_r, w_i, b_i, lam, reverse):
    bsz, s, nh, dh = uh.shape
    u = uh.reshape(bsz, s, nh * dh)
    r = jax.nn.sigmoid((jnp.einsum('bshd,hde->bshe', uh, w_r).reshape(bsz, s, -1) + b_r).astype(jnp.float32))
    i = jax.nn.sigmoid((jnp.einsum('bshd,hde->bshe', uh, w_i).reshape(bsz, s, -1) + b_i).astype(jnp.float32))
    log_a = -RG_C * r * jax.nn.softplus(-lam.astype(jnp.float32))
    a = jnp.exp(log_a)
    gated = jnp.sqrt(-jnp.expm1(2.0 * log_a)) * (i * u.astype(jnp.float32))
    _, h = lax.associative_scan(_linear_combine, (a, gated), axis=1, reverse=reverse)
    return h.astype(uh.dtype)


def rglru_mixer(xn, w_in, conv_w, conv_bias, w_rg, b_rg, w_ig, b_ig, lam, w_out):
    y_branch, u = jnp.split(xn @ w_in, 2, axis=-1)
    y_branch = jax.nn.gelu(y_branch)
    u = depthwise_conv(u, conv_w, (2, 1)) + conv_bias
    bsz, s, _ = u.shape
    uh = u.reshape(bsz, s, N_LRU_BLOCKS, LRU_BLOCK)
    h = (rglru_direction(uh, w_rg[0], b_rg[0], w_ig[0], b_ig[0], lam[0], False)
         + rglru_direction(uh, w_rg[1], b_rg[1], w_ig[1], b_ig[1], lam[1], True))
    return (y_branch * h) @ w_out


def hier_moe(x, w_rg, b_rg, w_re, b_re, w_gate, w_up, w_down):
    bsz, s, d = x.shape
    n = bsz * s
    xf = x.reshape(n, d)
    pg = jax.nn.softmax((xf @ w_rg).astype(jnp.float32) + b_rg.astype(jnp.float32), axis=-1)
    pg_top, g_top = lax.top_k(pg, 1)
    le = ((xf @ w_re).astype(jnp.float32) + b_re.astype(jnp.float32)).reshape(n, N_GROUPS, EXPERTS_PER_GROUP)
    le_sel = jnp.take_along_axis(le, g_top[:, :, None], axis=1)[:, 0]
    pe = jax.nn.softmax(le_sel, axis=-1)
    top_p, top_i = lax.top_k(pe, TOP_K)
    top_p = top_p / jnp.sum(top_p, axis=-1, keepdims=True)
    expert = g_top * EXPERTS_PER_GROUP + top_i
    weight = pg_top * top_p

    n_slots = n * TOP_K
    e_flat = expert.reshape(-1)
    tok_flat = jnp.arange(n_slots, dtype=jnp.int32) // TOP_K
    w_flat = weight.reshape(-1)
    order = jnp.argsort(e_flat)
    e_sorted = e_flat[order]
    counts = jnp.bincount(e_flat, length=N_EXPERTS)
    start = jnp.cumsum(counts) - counts
    padded = ((counts + ROUTE_BLOCK - 1) // ROUTE_BLOCK) * ROUTE_BLOCK
    pend = jnp.cumsum(padded)
    pstart = pend - padded
    dest = pstart[e_sorted] + (jnp.arange(n_slots) - start[e_sorted])
    n_blocks = -(-n_slots // ROUTE_BLOCK) + N_EXPERTS
    slot_of_pos = jnp.full((n_blocks * ROUTE_BLOCK,), n_slots, jnp.int32).at[dest].set(order.astype(jnp.int32))
    tok_pad = jnp.concatenate([tok_flat, jnp.array([n], jnp.int32)])[slot_of_pos]
    w_pad = jnp.concatenate([w_flat, jnp.zeros((1,), jnp.float32)])[slot_of_pos]
    block_expert = jnp.clip(jnp.searchsorted(pend, jnp.arange(n_blocks) * ROUTE_BLOCK, side='right'), 0, N_EXPERTS - 1)
    x_pad = jnp.concatenate([xf, jnp.zeros((1, d), xf.dtype)], axis=0)

    def expert_block(args):
        idx, e = args
        xb = x_pad[idx]
        hb = jax.nn.silu(xb @ w_gate[e]) * (xb @ w_up[e])
        return hb @ w_down[e]

    y_blocks = lax.map(expert_block, (tok_pad.reshape(n_blocks, ROUTE_BLOCK), block_expert))
    contrib = y_blocks.reshape(-1, d) * w_pad[:, None].astype(x.dtype)
    y = jnp.zeros((n + 1, d), x.dtype).at[tok_pad].add(contrib)
    return y[:n].reshape(bsz, s, d)


def _normal(key, shape, fan_in):
    return jax.random.normal(key, shape, jnp.float32) * (fan_in ** -0.5)


def setup_inputs(seed: int = 0) -> dict:
    key = jax.random.key(seed)
    ks = jax.random.split(key, 28)
    f32 = jnp.float32
    D, R, H, Bk = D_MODEL, D_RNN, N_LRU_BLOCKS, LRU_BLOCK
    x = jax.random.normal(ks[0], (BATCH, SEQ, D), f32)
    p = jax.random.normal(ks[1], (DEPTH, BATCH, SEQ, PLE_DIM), f32)
    norm_mix = 1.0 + 0.05 * jax.random.normal(ks[2], (DEPTH, D), f32)
    w_in_a = _normal(ks[3], (N_LAYERS_A, D, 3 * D), D)
    conv_a = _normal(ks[4], (N_LAYERS_A, CONV_A_WIDTH, D), CONV_A_WIDTH)
    w_out_a = _normal(ks[5], (N_LAYERS_A, D, D), D)
    w_in_b = _normal(ks[6], (N_LAYERS_B, D, 2 * R), D)
    conv_b = _normal(ks[7], (N_LAYERS_B, CONV_B_WIDTH, R), CONV_B_WIDTH)
    conv_bias_b = 0.01 * jax.random.normal(ks[8], (N_LAYERS_B, R), f32)
    w_rgate_b = _normal(ks[9], (N_LAYERS_B, 2, H, Bk, Bk), Bk)
    b_rgate_b = 0.01 * jax.random.normal(ks[10], (N_LAYERS_B, 2, R), f32)
    w_igate_b = _normal(ks[11], (N_LAYERS_B, 2, H, Bk, Bk), Bk)
    b_igate_b = 0.01 * jax.random.normal(ks[12], (N_LAYERS_B, 2, R), f32)
    a0 = jax.random.uniform(ks[13], (N_LAYERS_B, 2, R), f32, minval=0.9, maxval=0.999)
    sig = a0 ** (1.0 / RG_C)
    lam_b = jnp.log(sig) - jnp.log1p(-sig)
    w_out_b = _normal(ks[14], (N_LAYERS_B, R, D), R)
    norm_ffn = 1.0 + 0.05 * jax.random.normal(ks[15], (DEPTH, D), f32)
    w_router_group = _normal(ks[16], (DEPTH, D, N_GROUPS), D)
    b_router_group = 0.01 * jax.random.normal(ks[17], (DEPTH, N_GROUPS), f32)
    w_router_expert = _normal(ks[18], (DEPTH, D, N_EXPERTS), D)
    b_router_expert = 0.01 * jax.random.normal(ks[19], (DEPTH, N_EXPERTS), f32)
    w_exp_gate = _normal(ks[20], (DEPTH, N_EXPERTS, D, D_EXPERT), D)
    w_exp_up = _normal(ks[21], (DEPTH, N_EXPERTS, D, D_EXPERT), D)
    w_exp_down = _normal(ks[22], (DEPTH, N_EXPERTS, D_EXPERT, D), D_EXPERT)
    norm_ple = 1.0 + 0.05 * jax.random.normal(ks[23], (DEPTH, D), f32)
    w_ple = _normal(ks[24], (DEPTH, PLE_DIM, D), PLE_DIM)
    w_ple_gate = _normal(ks[25], (DEPTH, D, D), D)
    b_ple_gate = 0.01 * jax.random.normal(ks[26], (DEPTH, D), f32)
    norm_final = 1.0 + 0.05 * jax.random.normal(ks[27], (D,), f32)
    return {'x': x, 'p': p, 'norm_mix': norm_mix,
            'w_in_a': w_in_a, 'conv_a': conv_a, 'w_out_a': w_out_a,
            'w_in_b': w_in_b, 'conv_b': conv_b, 'conv_bias_b': conv_bias_b,
            'w_rgate_b': w_rgate_b, 'b_rgate_b': b_rgate_b,
            'w_igate_b': w_igate_b, 'b_igate_b': b_igate_b,
            'lam_b': lam_b, 'w_out_b': w_out_b, 'norm_ffn': norm_ffn,
            'w_router_group': w_router_group, 'b_router_group': b_router_group,
            'w_router_expert': w_router_expert, 'b_router_expert': b_router_expert,
            'w_exp_gate': w_exp_gate, 'w_exp_up': w_exp_up, 'w_exp_down': w_exp_down,
            'norm_ple': norm_ple, 'w_ple': w_ple, 'w_ple_gate': w_ple_gate,
            'b_ple_gate': b_ple_gate, 'norm_final': norm_final}


def reference(x, p, norm_mix, w_in_a, conv_a, w_out_a, w_in_b, conv_b, conv_bias_b,
              w_rgate_b, b_rgate_b, w_igate_b, b_igate_b, lam_b, w_out_b, norm_ffn,
              w_router_group, b_router_group, w_router_expert, b_router_expert,
              w_exp_gate, w_exp_up, w_exp_down, norm_ple, w_ple, w_ple_gate,
              b_ple_gate, norm_final):
    h = x
    for i in range(DEPTH):
        xn = rmsnorm(h, norm_mix[i])
        j = i // N_MIXERS
        if i % N_MIXERS == 0:
            mix = short_conv_mixer(xn, w_in_a[j], conv_a[j], w_out_a[j])
        else:
            mix = rglru_mixer(xn, w_in_b[j], conv_b[j], conv_bias_b[j], w_rgate_b[j], b_rgate_b[j],
                              w_igate_b[j], b_igate_b[j], lam_b[j], w_out_b[j])
        h = h + mix
        h = h + hier_moe(rmsnorm(h, norm_ffn[i]), w_router_group[i], b_router_group[i],
                         w_router_expert[i], b_router_expert[i],
                         w_exp_gate[i], w_exp_up[i], w_exp_down[i])
        gate = jax.nn.sigmoid(rmsnorm(h, norm_ple[i]) @ w_ple_gate[i] + b_ple_gate[i])
        h = h + gate * (p[i] @ w_ple[i])
    return rmsnorm(h, norm_final)
```

```cpp
#include <hip/hip_runtime.h>
#include <cstdio>
#include <cstdint>

constexpr int D = 1024, BATCH = 8, SEQ = 2048, NTOK = BATCH * SEQ, PLE = 256, NEXP = 32, FEXP = 512, CAP = NTOK;
constexpr float EPS = 1e-6f;

__global__ __launch_bounds__(256) void k_rmsnorm(const float* in, const float* __restrict__ g, float* out) {
    const int row = blockIdx.x, t = threadIdx.x;
    const float4 v = ((const float4*)(in + (size_t)row * D))[t];
    float s = v.x * v.x + v.y * v.y + v.z * v.z + v.w * v.w;
    for (int o = 1; o < 64; o <<= 1) s += __shfl_xor(s, o);
    __shared__ float red[4];
    if ((t & 63) == 0) red[t >> 6] = s;
    __syncthreads();
    s = red[0] + red[1] + red[2] + red[3];
    const float r = rsqrtf(s * (1.0f / D) + EPS);
    const float4 gg = ((const float4*)g)[t];
    float4 o; o.x = v.x * r * gg.x; o.y = v.y * r * gg.y; o.z = v.z * r * gg.z; o.w = v.w * r * gg.w;
    ((float4*)(out + (size_t)row * D))[t] = o;
}

__global__ __launch_bounds__(256) void k_gemm(const float* __restrict__ A, int lda, long aZ, const int* __restrict__ rowidx, long rZ, int agather, const int* __restrict__ cnt, int M,
                                              const float* __restrict__ B, int ldb, long bZ, float* __restrict__ C, float* __restrict__ C1, int ldc, long cZ, const int* __restrict__ cstart,
                                              const int* __restrict__ astart, int omode, const float* __restrict__ wl, int K) {
    const int z = blockIdx.z, m0 = blockIdx.y * 64, n0 = blockIdx.x * 64, tid = threadIdx.x;
    const int Mz = cnt ? cnt[z] : M;
    if (m0 >= Mz) return;
    __shared__ float As[16][68];
    __shared__ float Bs[16][68];
    const float* Az = A + z * aZ; const float* Bz = B + z * bZ;
    const int ar = tid >> 2, ak = (tid & 3) * 4;
    const int bk = tid >> 4, bn = (tid & 15) * 4;
    long arow = -1;
    if (m0 + ar < Mz) { if (agather) arow = rowidx[z * rZ + m0 + ar] >> 1; else arow = (astart ? astart[z] : 0) + m0 + ar; }
    const int ty = tid >> 4, tx = tid & 15;
    float acc[4][4] = {};
    for (int k0 = 0; k0 < K; k0 += 16) {
        float4 av = make_float4(0.f, 0.f, 0.f, 0.f);
        if (arow >= 0) av = *(const float4*)(Az + arow * lda + k0 + ak);
        const float4 bv = *(const float4*)(Bz + (size_t)(k0 + bk) * ldb + n0 + bn);
        As[ak + 0][ar] = av.x; As[ak + 1][ar] = av.y; As[ak + 2][ar] = av.z; As[ak + 3][ar] = av.w;
        *(float4*)&Bs[bk][bn] = bv;
        __syncthreads();
#pragma unroll
        for (int k = 0; k < 16; ++k) {
            const float4 a = *(const float4*)&As[k][ty * 4];
            const float4 b = *(const float4*)&Bs[k][tx * 4];
            const float aa[4] = {a.x, a.y, a.z, a.w}, bb[4] = {b.x, b.y, b.z, b.w};
#pragma unroll
            for (int i = 0; i < 4; ++i)
#pragma unroll
                for (int j = 0; j < 4; ++j) acc[i][j] += aa[i] * bb[j];
        }
        __syncthreads();
    }
#pragma unroll
    for (int i = 0; i < 4; ++i) {
        const int m = m0 + ty * 4 + i;
        if (m >= Mz) continue;
        float4 o = make_float4(acc[i][0], acc[i][1], acc[i][2], acc[i][3]);
        if (omode == 0) {
            const long orow = (cstart ? cstart[z] : 0) + m;
            *(float4*)(C + z * cZ + orow * ldc + n0 + tx * 4) = o;
        } else {
            const int s = rowidx[z * rZ + m]; const float w = wl[z * rZ + m];
            o.x *= w; o.y *= w; o.z *= w; o.w *= w;
            float* base = (s & 1) ? C1 : C;
            *(float4*)(base + (size_t)(s >> 1) * ldc + n0 + tx * 4) = o;
        }
    }
}

__global__ __launch_bounds__(256) void k_convA(const float* __restrict__ bch, const float* __restrict__ cw, float* __restrict__ out) {
    const int row = blockIdx.x, t = row % SEQ;
    for (int c = threadIdx.x; c < D; c += 256) {
        const float* r0 = bch + (size_t)row * 3 * D;
        float g1 = r0[D + c] * r0[2 * D + c], g0 = 0.f, g2 = 0.f;
        if (t > 0) { const float* rm = r0 - 3 * D; g0 = rm[D + c] * rm[2 * D + c]; }
        if (t < SEQ - 1) { const float* rp = r0 + 3 * D; g2 = rp[D + c] * rp[2 * D + c]; }
        out[(size_t)row * D + c] = r0[c] * (cw[c] * g0 + cw[D + c] * g1 + cw[2 * D + c] * g2);
    }
}
__global__ __launch_bounds__(256) void k_add(const float* a, const float* b, float* o, size_t n4) {
    for (size_t i = blockIdx.x * 256ull + threadIdx.x; i < n4; i += (size_t)gridDim.x * 256) {
        const float4 x = ((const float4*)a)[i], y = ((const float4*)b)[i];
        ((float4*)o)[i] = make_float4(x.x + y.x, x.y + y.y, x.z + y.z, x.w + y.w);
    }
}
__global__ __launch_bounds__(256) void k_add3(float* __restrict__ h, const float* __restrict__ a, const float* __restrict__ b, size_t n4) {
    for (size_t i = blockIdx.x * 256ull + threadIdx.x; i < n4; i += (size_t)gridDim.x * 256) {
        const float4 x = ((const float4*)h)[i], y = ((const float4*)a)[i], z = ((const float4*)b)[i];
        ((float4*)h)[i] = make_float4(x.x + y.x + z.x, x.y + y.y + z.y, x.z + y.z + z.z, x.w + y.w + z.w);
    }
}
__device__ __forceinline__ float sigm(float x) { return 1.0f / (1.0f + expf(-x)); }
__global__ __launch_bounds__(256) void k_ple(float* __restrict__ h, const float* __restrict__ gl, const float* __restrict__ bias, const float* __restrict__ pw) {
    const int row = blockIdx.x;
    for (int c = threadIdx.x; c < D; c += 256) { const size_t i = (size_t)row * D + c; h[i] += sigm(gl[i] + bias[c]) * pw[i]; }
}
__global__ __launch_bounds__(256) void k_router(const float* __restrict__ xf, const float* __restrict__ wg, const float* __restrict__ bg, const float* __restrict__ we, const float* __restrict__ be,
                                                int* __restrict__ cnt, int* __restrict__ lslot, float* __restrict__ lw) {
    const int tok = blockIdx.x * 4 + (threadIdx.x >> 6), lane = threadIdx.x & 63;
    float acc[36];
#pragma unroll
    for (int j = 0; j < 36; ++j) acc[j] = 0.f;
    for (int i = 0; i < 16; ++i) {
        const int k = lane + 64 * i; const float x = xf[(size_t)tok * D + k];
#pragma unroll
        for (int j = 0; j < 4; ++j) acc[j] += x * wg[k * 4 + j];
#pragma unroll
        for (int j = 0; j < 32; ++j) acc[4 + j] += x * we[k * 32 + j];
    }
#pragma unroll
    for (int j = 0; j < 36; ++j) for (int o = 1; o < 64; o <<= 1) acc[j] += __shfl_xor(acc[j], o);
    __shared__ float sl[4][40];
    float* L = sl[threadIdx.x >> 6];
    if (lane == 0) {
#pragma unroll
        for (int j = 0; j < 36; ++j) L[j] = acc[j];
        int g = 0;
        for (int j = 0; j < 4; ++j) L[j] += bg[j];
        for (int j = 1; j < 4; ++j) if (L[j] > L[g]) g = j;
        float sg = 0.f; for (int j = 0; j < 4; ++j) sg += expf(L[j] - L[g]);
        const float pg = 1.0f / sg;
        float* le = L + 4 + g * 8;
        for (int i = 0; i < 8; ++i) le[i] += be[g * 8 + i];
        int i0 = 0; for (int i = 1; i < 8; ++i) if (le[i] > le[i0]) i0 = i;
        int i1 = (i0 == 0) ? 1 : 0; for (int i = 0; i < 8; ++i) if (i != i0 && le[i] > le[i1]) i1 = i;
        const float e1 = expf(le[i1] - le[i0]); const float w0 = 1.0f / (1.0f + e1), w1 = e1 / (1.0f + e1);
        const int E0 = g * 8 + i0, E1 = g * 8 + i1;
        const int p0 = atomicAdd(&cnt[E0], 1); lslot[E0 * CAP + p0] = 2 * tok; lw[E0 * CAP + p0] = pg * w0;
        const int p1 = atomicAdd(&cnt[E1], 1); lslot[E1 * CAP + p1] = 2 * tok + 1; lw[E1 * CAP + p1] = pg * w1;
    }
}
__global__ void k_cstart(const int* __restrict__ cnt, int* __restrict__ cstart) {
    if (threadIdx.x == 0) { int s = 0; for (int e = 0; e < NEXP; ++e) { cstart[e] = s; s += (cnt[e] + 255) / 256 * 256; } }
}
__global__ __launch_bounds__(256) void k_silu_mul(float* __restrict__ g, const float* __restrict__ u, size_t n) {
    for (size_t i = blockIdx.x * 256ull + threadIdx.x; i < n; i += (size_t)gridDim.x * 256) { const float x = g[i]; g[i] = x * sigm(x) * u[i]; }
}
__global__ __launch_bounds__(256) void k_convB(const float* __restrict__ yu, const float* __restrict__ cw, const float* __restrict__ cb, float* __restrict__ out) {
    const int row = blockIdx.x, t = row % SEQ;
    for (int c = threadIdx.x; c < D; c += 256) {
        float s = cb[c];
#pragma unroll
        for (int k = 0; k < 4; ++k) { const int tt = t + k - 2; if (tt >= 0 && tt < SEQ) s += cw[k * D + c] * yu[(size_t)(row + k - 2) * 2 * D + D + c]; }
        out[(size_t)row * D + c] = s;
    }
}
__global__ __launch_bounds__(256) void k_scan(const float* __restrict__ rl, const float* __restrict__ il, const float* __restrict__ u, const float* __restrict__ br, const float* __restrict__ bi,
                                              const float* __restrict__ lam, float* __restrict__ hs, int rev) {
    const int idx = blockIdx.x * 256 + threadIdx.x, b = idx / D, c = idx % D;
    const float sp = log1pf(expf(-lam[c])), bR = br[c], bI = bi[c];
    float h = 0.f;
    for (int s = 0; s < SEQ; ++s) {
        const int t = rev ? SEQ - 1 - s : s; const size_t i = (size_t)(b * SEQ + t) * D + c;
        const float r = sigm(rl[i] + bR), ig = sigm(il[i] + bI);
        const float la = -8.0f * r * sp, a = expf(la);
        const float gt = sqrtf(-expm1f(2.0f * la)) * (ig * u[i]);
        h = a * h + gt;
        if (rev) hs[i] += h; else hs[i] = h;
    }
}
__device__ __forceinline__ float gelu_tanh(float x) { const float c = 0.7978845608028654f; return 0.5f * x * (1.0f + tanhf(c * (x + 0.044715f * x * x * x))); }
__global__ __launch_bounds__(256) void k_mulY(const float* __restrict__ yu, const float* __restrict__ hs, float* __restrict__ out) {
    const int row = blockIdx.x;
    for (int c = threadIdx.x; c < D; c += 256) out[(size_t)row * D + c] = gelu_tanh(yu[(size_t)row * 2 * D + c]) * hs[(size_t)row * D + c];
}

static void gemm(hipStream_t st, const float* A, int lda, const float* B, int ldb, float* C, int ldc, int M, int N, int K) {
    hipLaunchKernelGGL(k_gemm, dim3(N / 64, M / 64, 1), dim3(256), 0, st, A, lda, 0L, (const int*)nullptr, 0L, 0, (const int*)nullptr, M, B, ldb, 0L, C, (float*)nullptr, ldc, 0L,
                       (const int*)nullptr, (const int*)nullptr, 0, (const float*)nullptr, K);
}

extern "C" void kernel_launch(void* const* d_in, const int* in_sizes, int n_in, void* d_out, int out_size, void* d_ws, size_t ws_size, hipStream_t stream) {
    const float* x = (const float*)d_in[0]; const float* p = (const float*)d_in[1]; const float* norm_mix = (const float*)d_in[2];
    const float* w_in_a = (const float*)d_in[3]; const float* conv_a = (const float*)d_in[4]; const float* w_out_a = (const float*)d_in[5];
    const float* w_in_b = (const float*)d_in[6]; const float* conv_b = (const float*)d_in[7]; const float* conv_bias_b = (const float*)d_in[8];
    const float* w_rgate = (const float*)d_in[9]; const float* b_rgate = (const float*)d_in[10]; const float* w_igate = (const float*)d_in[11]; const float* b_igate = (const float*)d_in[12];
    const float* lam = (const float*)d_in[13]; const float* w_out_b = (const float*)d_in[14]; const float* norm_ffn = (const float*)d_in[15];
    const float* w_rg = (const float*)d_in[16]; const float* b_rg = (const float*)d_in[17]; const float* w_re = (const float*)d_in[18]; const float* b_re = (const float*)d_in[19];
    const float* w_eg = (const float*)d_in[20]; const float* w_eu = (const float*)d_in[21]; const float* w_ed = (const float*)d_in[22];
    const float* norm_ple = (const float*)d_in[23]; const float* w_ple = (const float*)d_in[24]; const float* w_pleg = (const float*)d_in[25]; const float* b_pleg = (const float*)d_in[26];
    const float* norm_final = (const float*)d_in[27];
    float* H = (float*)d_out;
    char* ws = (char*)d_ws;
    const size_t SZ = (size_t)NTOK * D * 4;
    float* T1 = (float*)ws;
    float* T2 = (float*)(ws + 3 * SZ); float* T3 = (float*)(ws + 4 * SZ); float* T4 = (float*)(ws + 5 * SZ);
    char* misc = ws + 6 * SZ;
    int* cnt = (int*)misc; int* cstart = cnt + 64; int* lslot = cnt + 128; float* lw = (float*)(lslot + NEXP * CAP);
    const size_t need = 6 * SZ + 1024 + 2ull * NEXP * CAP * 4;
    if (ws_size < need) { fprintf(stderr, "ws too small: %zu < %zu\n", ws_size, need); return; }
    const size_t n4 = (size_t)NTOK * D / 4;

    auto moe_ple = [&](int L) {
        hipLaunchKernelGGL(k_rmsnorm, dim3(NTOK), dim3(256), 0, stream, H, norm_ffn + L * D, T2);
        hipMemsetAsync(cnt, 0, 256, stream);
        hipLaunchKernelGGL(k_router, dim3(NTOK / 4), dim3(256), 0, stream, T2, w_rg + (size_t)L * D * 4, b_rg + L * 4, w_re + (size_t)L * D * 32, b_re + L * 32, cnt, lslot, lw);
        hipLaunchKernelGGL(k_cstart, dim3(1), dim3(64), 0, stream, cnt, cstart);
        float* HG = T1; float* HU = T1 + (size_t)40960 * FEXP;
        const float* wg = w_eg + (size_t)L * NEXP * D * FEXP; const float* wu = w_eu + (size_t)L * NEXP * D * FEXP; const float* wd = w_ed + (size_t)L * NEXP * FEXP * D;
        hipLaunchKernelGGL(k_gemm, dim3(FEXP / 64, CAP / 64, NEXP), dim3(256), 0, stream, T2, D, 0L, lslot, (long)CAP, 1, cnt, 0, wg, FEXP, (long)D * FEXP, HG, (float*)nullptr, FEXP, 0L, cstart,
                           (const int*)nullptr, 0, (const float*)nullptr, D);
        hipLaunchKernelGGL(k_gemm, dim3(FEXP / 64, CAP / 64, NEXP), dim3(256), 0, stream, T2, D, 0L, lslot, (long)CAP, 1, cnt, 0, wu, FEXP, (long)D * FEXP, HU, (float*)nullptr, FEXP, 0L, cstart,
                           (const int*)nullptr, 0, (const float*)nullptr, D);
        hipLaunchKernelGGL(k_silu_mul, dim3(4096), dim3(256), 0, stream, HG, HU, (size_t)40960 * FEXP);
        hipLaunchKernelGGL(k_gemm, dim3(D / 64, CAP / 64, NEXP), dim3(256), 0, stream, HG, FEXP, 0L, lslot, (long)CAP, 0, cnt, 0, wd, D, (long)FEXP * D, T3, T4, D, 0L, (const int*)nullptr,
                           cstart, 1, lw, FEXP);
        hipLaunchKernelGGL(k_add3, dim3(4096), dim3(256), 0, stream, H, T3, T4, n4);
        hipLaunchKernelGGL(k_rmsnorm, dim3(NTOK), dim3(256), 0, stream, H, norm_ple + L * D, T2);
        gemm(stream, T2, D, w_pleg + (size_t)L * D * D, D, T3, D, NTOK, D, D);
        gemm(stream, p + (size_t)L * NTOK * PLE, PLE, w_ple + (size_t)L * PLE * D, D, T4, D, NTOK, D, PLE);
        hipLaunchKernelGGL(k_ple, dim3(NTOK), dim3(256), 0, stream, H, T3, b_pleg + L * D, T4);
    };

    hipLaunchKernelGGL(k_rmsnorm, dim3(NTOK), dim3(256), 0, stream, x, norm_mix, T2);
    gemm(stream, T2, D, w_in_a, 3 * D, T1, 3 * D, NTOK, 3 * D, D);
    hipLaunchKernelGGL(k_convA, dim3(NTOK), dim3(256), 0, stream, T1, conv_a, T3);
    gemm(stream, T3, D, w_out_a, D, T2, D, NTOK, D, D);
    hipLaunchKernelGGL(k_add, dim3(4096), dim3(256), 0, stream, x, T2, H, n4);
    moe_ple(0);
    hipLaunchKernelGGL(k_rmsnorm, dim3(NTOK), dim3(256), 0, stream, H, norm_mix + D, T2);
    gemm(stream, T2, D, w_in_b, 2 * D, T1, 2 * D, NTOK, 2 * D, D);
    float* HS = T1 + 2 * (size_t)NTOK * D;
    hipLaunchKernelGGL(k_convB, dim3(NTOK), dim3(256), 0, stream, T1, conv_b, conv_bias_b, T3);
    for (int d = 0; d < 2; ++d) {
        hipLaunchKernelGGL(k_gemm, dim3(256 / 64, NTOK / 64, 4), dim3(256), 0, stream, T3, D, 256L, (const int*)nullptr, 0L, 0, (const int*)nullptr, NTOK, w_rgate + (size_t)d * 4 * 256 * 256, 256,
                           256L * 256, T2, (float*)nullptr, D, 256L, (const int*)nullptr, (const int*)nullptr, 0, (const float*)nullptr, 256);
        hipLaunchKernelGGL(k_gemm, dim3(256 / 64, NTOK / 64, 4), dim3(256), 0, stream, T3, D, 256L, (const int*)nullptr, 0L, 0, (const int*)nullptr, NTOK, w_igate + (size_t)d * 4 * 256 * 256, 256,
                           256L * 256, T4, (float*)nullptr, D, 256L, (const int*)nullptr, (const int*)nullptr, 0, (const float*)nullptr, 256);
        hipLaunchKernelGGL(k_scan, dim3(BATCH * D / 256), dim3(256), 0, stream, T2, T4, T3, b_rgate + d * D, b_igate + d * D, lam + d * D, HS, d);
    }
    hipLaunchKernelGGL(k_mulY, dim3(NTOK), dim3(256), 0, stream, T1, HS, T2);
    gemm(stream, T2, D, w_out_b, D, T3, D, NTOK, D, D);
    hipLaunchKernelGGL(k_add, dim3(4096), dim3(256), 0, stream, H, T3, H, n4);
    moe_ple(1);
    hipLaunchKernelGGL(k_rmsnorm, dim3(NTOK), dim3(256), 0, stream, H, norm_final, H);
}
```

```cpp
#include <hip/hip_runtime.h>
#include <cstdio>
#include <cstdint>
constexpr int D = 1024, BATCH = 8, SEQ = 2048, NTOK = BATCH * SEQ, PLE = 256, NEXP = 32, FEXP = 512, CAP = NTOK;
constexpr float EPS = 1e-6f;
constexpr int HYB = 21; constexpr bool HYB_PER_PHASE = true; constexpr int NV_START = 13; constexpr bool NV_FAST_ROUTER = true; constexpr int NV_FAST_ROUTER_LAYERS = 2;
constexpr size_t NV_T1 = (size_t)8 << 20, NV_T2 = (size_t)200 << 20, NV_T3 = (size_t)264 << 20, NV_T4 = (size_t)328 << 20, NV_MISC = (size_t)400 << 20;
#define LAS __attribute__((address_space(3)))
#define GAS __attribute__((address_space(1)))
typedef unsigned short bf16_t;
typedef short bf16x8 __attribute__((ext_vector_type(8)));
typedef _Float16 half8 __attribute__((ext_vector_type(8)));
typedef _Float16 half2v __attribute__((ext_vector_type(2)));
typedef float f32x4 __attribute__((ext_vector_type(4)));
typedef float f32x2 __attribute__((ext_vector_type(2)));
typedef unsigned u32x4 __attribute__((ext_vector_type(4)));
typedef unsigned u32x2 __attribute__((ext_vector_type(2)));
namespace pg {
constexpr int BM = 256, BK = 64, HALF = 128, HTB = HALF * BK * 2, STAGE_BYTES = 8 * HTB, NXCD = 8, WGM = 8;
__host__ __device__ __forceinline__ int lds_byte(int r, int c) { const int st = (r >> 4) * 2 + (c >> 5), rr = r & 15, cc = c & 31, ob = rr * 64 + cc * 2; return st * 1024 + (ob ^ (((ob >> 9) & 1) << 5)); }
__host__ __device__ __forceinline__ void stage_rc(int b, int& R, int& C) { const int st = b / 1024, sb = b % 1024, swz = sb ^ (((sb >> 9) & 1) << 5); R = (st >> 1) * 16 + swz / 64; C = (st & 1) * 32 + (swz % 64) / 2; }

struct Unit { int arow, acol, brow, orow, pn, aux; };
struct GemmDesc { const bf16_t* A; int lda; const bf16_t* Bt; int ldb; int K; };

struct DenseOrder {
    int nM, nN, nwg, G, c;
    __device__ void init(int nM_, int nN_, int G_, int c_) { nM = nM_; nN = nN_; nwg = nM * nN; G = G_; c = c_; }
    __device__ bool tile(int i, int& pm, int& pn) const {
        const long L = (long)i * G + c; if (L >= nwg) return false;
        int wgid = (int)L; { const int q = nwg / NXCD, r = nwg % NXCD, xcd = wgid % NXCD, off = wgid / NXCD; wgid = (xcd < r ? xcd * (q + 1) : r * (q + 1) + (xcd - r) * q) + off; }
        const int nig = WGM * nN, gid = wgid / nig, fm = gid * WGM, gsz = (nM - fm) < WGM ? (nM - fm) : WGM;
        pm = fm + ((wgid % nig) % gsz); pn = (wgid % nig) / gsz; return true;
    }
};

__device__ __forceinline__ unsigned cvt_pk_bf16(float lo, float hi) { half2v v; v.x = (_Float16)lo; v.y = (_Float16)hi; return __builtin_bit_cast(unsigned, v); }

template <class Epi, class Sched, bool ALIGN_EPI>
__device__ __forceinline__ void gemm_phase(LAS unsigned char* lds, const GemmDesc g, const Sched& S, const Epi& E) {
    int tid_ = threadIdx.x; asm volatile("" : "+v"(tid_));
    const int tid = tid_, wid = __builtin_amdgcn_readfirstlane(tid >> 6), lane = tid & 63, wr = wid >> 2, wc = wid & 3, fr = lane & 15, fq = lane >> 4;
    const int K = g.K, nt = K / BK;
    int R0, C0; stage_rc(tid * 16, R0, C0);
    unsigned voffB[2]; voffB[0] = (unsigned)(R0 * g.ldb + C0) * 2u; voffB[1] = voffB[0] + (unsigned)(64 * g.ldb) * 2u;
    const unsigned c2 = (unsigned)C0 * 2u;
    const size_t kstep = (size_t)(BK * 2);
    const size_t hstepB = (size_t)HALF * g.ldb * 2;
    const unsigned ldsw = (unsigned)wid * 1024u;
    const int aoff = lds_byte(wr * 64 + fr, fq * 8), boff = lds_byte(wc * 32 + fr, fq * 8);
#define PG_SA(b, h) (((b) * 2 + (h)) * HTB)
#define PG_SB(b, h) ((4 + (b) * 2 + (h)) * HTB)
#define PG_STAGE(bufoff, gbase, voff) do { _Pragma("unroll") for (int _i = 0; _i < 2; ++_i) \
        __builtin_amdgcn_global_load_lds((const unsigned*)((const char*)(gbase) + (voff)[_i]), (LAS unsigned*)(lds + (bufoff) + ldsw + _i * 8192), 16, 0, 0); } while (0)
#define PG_LDA(dst, b, h) do { _Pragma("unroll") for (int m = 0; m < 4; ++m) _Pragma("unroll") for (int k = 0; k < 2; ++k) dst[m][k] = *(const LAS bf16x8*)(lds + PG_SA(b, h) + aoff + m * 2048 + k * 1024); } while (0)
#define PG_LDB(dst, b, h) do { _Pragma("unroll") for (int n = 0; n < 2; ++n) _Pragma("unroll") for (int k = 0; k < 2; ++k) dst[n][k] = *(const LAS bf16x8*)(lds + PG_SB(b, h) + boff + n * 2048 + k * 1024); } while (0)
#define PG_MMA(ai, bj, At, Bt) do { __builtin_amdgcn_s_setprio(1); _Pragma("unroll") for (int m = 0; m < 4; ++m) _Pragma("unroll") for (int n = 0; n < 2; ++n) _Pragma("unroll") for (int k = 0; k < 2; ++k) \
        acc[ai][bj][m][n] = __builtin_amdgcn_mfma_f32_16x16x32_f16(__builtin_bit_cast(half8, Bt[n][k]), __builtin_bit_cast(half8, At[m][k]), acc[ai][bj][m][n], 0, 0, 0); __builtin_amdgcn_s_setprio(0); } while (0)
#define PG_WAIT_V(n) asm volatile("s_waitcnt vmcnt(" #n ")" ::: "memory")
#define PG_WAIT_L(n) asm volatile("s_waitcnt lgkmcnt(" #n ")" ::: "memory")
#define PG_BAR __builtin_amdgcn_s_barrier()
#define PG_SCHED __builtin_amdgcn_sched_barrier(0)
    Unit cur, nxt; int ui = 0;
    if (!S.next(0, cur)) return;
    f32x4 acc[2][2][4][2];
#pragma unroll
    for (int a = 0; a < 2; ++a)
#pragma unroll
        for (int b = 0; b < 2; ++b)
#pragma unroll
            for (int m = 0; m < 4; ++m)
#pragma unroll
                for (int n = 0; n < 2; ++n) acc[a][b][m][n] = (f32x4){0.f, 0.f, 0.f, 0.f};
    bf16x8 At[4][2], B0[2][2], B1[2][2];
    unsigned offA[2][2];
    S.a_offs(cur, R0, c2, offA);
    const char* Ab = (const char*)g.A;
    const char* cB = (const char*)g.Bt + (size_t)cur.brow * g.ldb * 2;
    PG_STAGE(PG_SB(0, 0), cB, voffB); PG_STAGE(PG_SB(0, 1), cB + hstepB, voffB); PG_STAGE(PG_SA(0, 0), Ab, offA[0]); PG_STAGE(PG_SA(0, 1), Ab, offA[1]);
    if (wr == 1) PG_BAR;
    PG_WAIT_V(2); PG_BAR;
    PG_STAGE(PG_SB(1, 0), cB + kstep, voffB); PG_STAGE(PG_SA(1, 0), Ab + kstep, offA[0]); PG_STAGE(PG_SB(1, 1), cB + hstepB + kstep, voffB);
    PG_WAIT_V(6); PG_BAR;
    for (;;) {
        const bool has_next = S.next(ui + 1, nxt);
        const char* nB = has_next ? (const char*)g.Bt + (size_t)nxt.brow * g.ldb * 2 : cB;
        unsigned offN[2][2]; S.a_offs(has_next ? nxt : cur, R0, c2, offN);
#pragma clang loop unroll(disable)
        for (int t = 0; t < nt; t += 2) {
            const bool last = (t == nt - 2);
            const char* a1 = Ab + (size_t)(t + 1) * kstep;
            const char* a2 = last ? Ab : Ab + (size_t)(t + 2) * kstep; const char* b2 = last ? nB : cB + (size_t)(t + 2) * kstep;
            const char* a3 = a2 + kstep; const char* b3 = b2 + kstep;
            PG_LDB(B0, 0, 0); PG_LDB(B1, 0, 1); PG_SCHED; PG_LDA(At, 0, 0); PG_STAGE(PG_SA(1, 1), a1, offA[1]);
#pragma unroll
            for (int h_ = 0; h_ < 2; ++h_)
#pragma unroll
                for (int i_ = 0; i_ < 2; ++i_) offA[h_][i_] = last ? offN[h_][i_] : offA[h_][i_];
            PG_WAIT_V(8); PG_WAIT_L(0); PG_BAR; PG_MMA(0, 0, At, B0); PG_MMA(0, 1, At, B1); PG_BAR; PG_SCHED;
            PG_LDA(At, 0, 1); PG_STAGE(PG_SB(0, 0), b2, voffB); PG_STAGE(PG_SB(0, 1), b2 + hstepB, voffB); PG_STAGE(PG_SA(0, 0), a2, offA[0]);
            PG_WAIT_V(8); PG_WAIT_L(0); PG_BAR; PG_MMA(1, 0, At, B0); PG_MMA(1, 1, At, B1); PG_BAR; PG_SCHED;
            PG_LDB(B0, 1, 0); PG_LDB(B1, 1, 1); PG_SCHED; PG_LDA(At, 1, 0); PG_STAGE(PG_SA(0, 1), a2, offA[1]);
            PG_WAIT_V(8); PG_WAIT_L(0); PG_BAR; PG_MMA(0, 0, At, B0); PG_MMA(0, 1, At, B1); PG_BAR; PG_SCHED;
            PG_LDA(At, 1, 1); PG_STAGE(PG_SB(1, 0), b3, voffB); PG_STAGE(PG_SB(1, 1), b3 + hstepB, voffB); PG_STAGE(PG_SA(1, 0), a3, offA[0]);
            PG_WAIT_V(8); PG_WAIT_L(0); PG_BAR; PG_MMA(1, 0, At, B0); PG_MMA(1, 1, At, B1); PG_BAR; PG_SCHED;
        }
        if constexpr (ALIGN_EPI) { if (wr == 0) PG_BAR; }
        { int fr_e = fr, fq_e = fq; asm volatile("" : "+v"(fr_e), "+v"(fq_e));
          E(acc, cur, wr, wc, fr_e, fq_e); }
        __builtin_amdgcn_s_waitcnt(0x0F70);
        if (!has_next) break;
#pragma unroll
        for (int a = 0; a < 2; ++a)
#pragma unroll
            for (int b = 0; b < 2; ++b)
#pragma unroll
                for (int m = 0; m < 4; ++m)
#pragma unroll
                    for (int n = 0; n < 2; ++n) acc[a][b][m][n] = (f32x4){0.f, 0.f, 0.f, 0.f};
        cur = nxt; cB = nB; ++ui;
        if constexpr (ALIGN_EPI) { if (wr == 1) PG_BAR; }
    }
    PG_WAIT_V(0);
    if constexpr (!ALIGN_EPI) { if (wr == 0) PG_BAR; }
    PG_BAR;
#undef PG_SA
#undef PG_SB
#undef PG_STAGE
#undef PG_LDA
#undef PG_LDB
#undef PG_MMA
#undef PG_WAIT_V
#undef PG_WAIT_L
#undef PG_BAR
#undef PG_SCHED
}
}

typedef GAS unsigned gu32;
#define XB_TMO      128
#define XB_XCNT(j)  (256  + 64 * (j))
#define XB_XSUB(j)  (1280 + 64 * (j))
#define XB_XGEN(j)  (2304 + 64 * (j))
#define XB_TOP      3328
#define XB_TOPGEN   3392
#define XCD_BAR_WORDS 3456
#define XB_SPIN_CAP (1u << 18)
__device__ __forceinline__ unsigned xb_ld(unsigned* p)              { return __hip_atomic_load(p, __ATOMIC_RELAXED, __HIP_MEMORY_SCOPE_AGENT); }
__device__ __forceinline__ unsigned xb_add(unsigned* p, unsigned v) { return __hip_atomic_fetch_add(p, v, __ATOMIC_RELAXED, __HIP_MEMORY_SCOPE_AGENT); }
__device__ __forceinline__ unsigned xb_xcc_id() { return (unsigned)__builtin_amdgcn_s_getreg((3 << 11) | 20) & 0xFu; }
#define XB_SPIN(cond, bar) do { unsigned _sp = 0; while (cond) { __builtin_amdgcn_s_sleep(1); \
    if ((++_sp & 255u) == 0u) { if (xb_ld(&(bar)[XB_TMO])) break; if (_sp > XB_SPIN_CAP) { atomicAdd(&(bar)[XB_TMO], 1u); break; } } } } while (0)
struct XcdBarrier { unsigned* bar; unsigned x; volatile LAS unsigned* st; };
__device__ __forceinline__ XcdBarrier xcd_barrier_post(unsigned* bar, volatile LAS unsigned* st) {
    XcdBarrier b; b.bar = bar; b.x = xb_xcc_id(); b.st = st;
    if (threadIdx.x == 0) (void)xb_add(&bar[XB_XCNT(b.x)], 1u);
    return b;
}
__device__ __forceinline__ void xcd_barrier_complete(unsigned* bar, unsigned x, unsigned& nloc, unsigned& nx) {
    const unsigned G = gridDim.x * gridDim.y * gridDim.z;
    unsigned sum, cnt, mine, sp = 0u;
    for (;;) {
        sum = 0u; cnt = 0u; mine = 0u;
#pragma unroll
        for (unsigned j = 0; j < 16; ++j) { const unsigned c = xb_ld(&bar[XB_XCNT(j)]); sum += c; cnt += (c > 0u) ? 1u : 0u; mine = (j == x) ? c : mine; }
        if (sum == G) break;
        __builtin_amdgcn_s_sleep(1);
        if ((++sp & 255u) == 0u) { if (xb_ld(&bar[XB_TMO])) break; if (sp > XB_SPIN_CAP) { atomicAdd(&bar[XB_TMO], 1u); break; } }
    }
    nloc = mine > 0u ? mine : 1u; nx = cnt > 0u ? cnt : 1u;
}
__device__ __forceinline__ void xcd_barrier(const XcdBarrier& b) {
    asm volatile("s_waitcnt vmcnt(0)" ::: "memory");
    __syncthreads();
    if (threadIdx.x == 0) {
        unsigned* bar = b.bar;
        __builtin_amdgcn_s_waitcnt(0);
        unsigned nloc = b.st[0], nx = b.st[1];
        if (nloc == 0u) { xcd_barrier_complete(bar, b.x, nloc, nx); b.st[0] = nloc; b.st[1] = nx; }
        const unsigned old = xb_add(&bar[XB_XSUB(b.x)], 1u);
        const unsigned gen = old / nloc;
        if (old + 1u == (gen + 1u) * nloc) {
            __builtin_amdgcn_fence(__ATOMIC_RELEASE, "agent");
            asm volatile("s_waitcnt vmcnt(0)" ::: "memory");
            const unsigned og = xb_add(&bar[XB_TOP], 1u);
            const unsigned tg = og / nx;
            if (og + 1u == (tg + 1u) * nx) xb_add(&bar[XB_TOPGEN], 1u);
            else XB_SPIN(xb_ld(&bar[XB_TOPGEN]) == tg, bar);
            __builtin_amdgcn_fence(__ATOMIC_ACQUIRE, "agent");
            xb_add(&bar[XB_XGEN(b.x)], 1u);
            asm volatile("s_waitcnt vmcnt(0)" ::: "memory");
        } else {
            XB_SPIN(xb_ld(&bar[XB_XGEN(b.x)]) == gen, bar);
            __builtin_amdgcn_fence(__ATOMIC_ACQUIRE, "agent");
            asm volatile("s_waitcnt vmcnt(0)" ::: "memory");
        }
    }
    __syncthreads();
}
constexpr int NWAVES = 8;
constexpr size_t MiB = 1u << 20;
constexpr int LDS_BYTES = 147456;
constexpr int RING_BYTES = 131072;
constexpr int TAB_OFF = RING_BYTES;
constexpr int TAB_BYTES = 12288;
constexpr int MISC_OFF = TAB_OFF + TAB_BYTES;
constexpr size_t WS_CTL = 0;
constexpr size_t CTL_ZERO_BYTES = 64 * 1024;
constexpr int CW_BAR = 1024;
constexpr int CW_CNT = 8192;
constexpr size_t WS_SSP = 1 * MiB;
constexpr size_t WS_SSP1 = 6 * MiB + 512 * 1024;
constexpr size_t WS_RSTD = 2 * MiB;
constexpr size_t WS_LSLOT = 2 * MiB + 256 * 1024;
constexpr size_t WS_LW = WS_LSLOT + 2 * MiB;
constexpr size_t WS_WSM = 8 * MiB;
constexpr size_t OFF_WINA = 0, OFF_WOUTA = 6 * MiB, OFF_WINB = 8 * MiB, OFF_WGATE = 12 * MiB, OFF_WOUTB = 14 * MiB, OFF_WPLEG = 16 * MiB, OFF_WPLE = 20 * MiB;
constexpr size_t WS_WMOE = 30 * MiB;
constexpr size_t WS_HB = 222 * MiB;
constexpr size_t WS_PW = 254 * MiB;
constexpr size_t WS_PB = 286 * MiB;
constexpr size_t WS_R0 = 302 * MiB, RSZ = 32 * MiB;
constexpr size_t WS_END = WS_R0 + 6 * RSZ + 28 * MiB;
#define WS_R(i) (WS_R0 + (size_t)(i) * RSZ)

#define RLX_AGENT __ATOMIC_RELAXED, __HIP_MEMORY_SCOPE_AGENT
#define LDS_WAIT() asm volatile("s_waitcnt lgkmcnt(0)" ::: "memory")
#define VM_WAIT() asm volatile("s_waitcnt vmcnt(0)" ::: "memory")
__device__ __forceinline__ unsigned pk2(float lo, float hi) { return pg::cvt_pk_bf16(lo, hi); }
__device__ __forceinline__ float bf_lo(unsigned w) { return (float)__builtin_bit_cast(half2v, w).x; }
__device__ __forceinline__ float bf_hi(unsigned w) { return (float)__builtin_bit_cast(half2v, w).y; }
__device__ __forceinline__ float wave_sum(float v) {
#pragma unroll
    for (int o = 1; o < 64; o <<= 1) v += __shfl_xor(v, o);
    return v;
}
__device__ __forceinline__ float fsigm(float x) { return __builtin_amdgcn_rcpf(1.0f + __builtin_amdgcn_exp2f(-1.4426950408889634f * x)); }

__device__ __forceinline__ int map_lin8(int c) { const int q = c & 31; return (c & ~31) + 16 * ((q >> 2) & 1) + 4 * (q >> 3) + (q & 3); }
__device__ __forceinline__ int map_pair(int ch, int type) { return 256 * (ch >> 7) + 128 * ((ch >> 6) & 1) + 32 * ((ch >> 4) & 3) + 16 * type + (ch & 15); }

struct Args { const float* in[28]; float* out; unsigned char* ws; int ph_lo, ph_hi; };

struct Frame {
    LAS unsigned char* lds;
    volatile LAS unsigned* MISC;
    int tid, lane, wave, vcu, G;
};

struct PrepJob { const float* W; int ldw, K, ncols, nbatch; size_t sbs; const float* gain; bf16_t* dst; size_t dbs; int mode, type; };
__device__ __forceinline__ void prep_item(const PrepJob& J, LAS float* scr, int item, int lane) {
    const int nblk = J.ncols / 32, per = (J.K / 64) * nblk, b = item / per, r = item % per, kb = r / nblk, nb = r % nblk, k0 = 64 * kb, n0 = 32 * nb;
    const float* W = J.W + (size_t)b * J.sbs; bf16_t* WT = J.dst + (size_t)b * J.dbs;
#pragma unroll 8
    for (int i = 0; i < 32; ++i) { const int kk = 2 * i + (lane >> 5); float v = W[(size_t)(k0 + kk) * J.ldw + n0 + (lane & 31)]; if (J.gain) v *= J.gain[k0 + kk]; scr[kk * 33 + (lane & 31)] = v; }
    LDS_WAIT(); asm volatile("" ::: "memory");
    const int c = lane & 7;
#pragma unroll
    for (int j = 0; j < 4; ++j) { const int n = (lane >> 3) + 8 * j; const LAS float* s = scr + (8 * c) * 33 + n;
        u32x4 o; o.x = pk2(s[0 * 33], s[1 * 33]); o.y = pk2(s[2 * 33], s[3 * 33]); o.z = pk2(s[4 * 33], s[5 * 33]); o.w = pk2(s[6 * 33], s[7 * 33]);
        const int col = n0 + n; const int drow = (J.mode == 0) ? map_lin8(col) : map_pair(col, J.type);
        *(GAS u32x4*)(WT + (size_t)drow * J.K + k0 + 8 * c) = o; }
    LDS_WAIT(); asm volatile("" ::: "memory");
}
__device__ __forceinline__ bool prep_job(const Args& a, int j, PrepJob& J) {
    unsigned char* ws = a.ws; bf16_t* wsm = (bf16_t*)(ws + WS_WSM);
    const float* norm_mix = a.in[2]; const float* norm_ffn = a.in[15]; const float* norm_ple = a.in[23];
    J.sbs = 0; J.dbs = 0; J.nbatch = 1; J.gain = nullptr; J.type = 0; J.mode = 0;
    switch (j) {
    case 0: J = PrepJob{a.in[3], 3 * D, D, D, 1, 0, norm_mix, wsm + OFF_WINA / 2 + (size_t)2048 * D, 0, 0, 0}; return true;
    case 1: J = PrepJob{a.in[3] + D, 3 * D, D, D, 1, 0, norm_mix, wsm + OFF_WINA / 2, 0, 1, 0}; return true;
    case 2: J = PrepJob{a.in[3] + 2 * D, 3 * D, D, D, 1, 0, norm_mix, wsm + OFF_WINA / 2, 0, 1, 1}; return true;
    case 3: J = PrepJob{a.in[5], D, D, D, 1, 0, nullptr, wsm + OFF_WOUTA / 2, 0, 0, 0}; return true;
    case 4: J = PrepJob{a.in[6], 2 * D, D, 2 * D, 1, 0, norm_mix + D, wsm + OFF_WINB / 2, 0, 0, 0}; return true;
    case 5: J = PrepJob{a.in[9], 256, 256, 256, 8, (size_t)256 * 256, nullptr, wsm + OFF_WGATE / 2, (size_t)512 * 256, 1, 0}; return true;
    case 6: J = PrepJob{a.in[11], 256, 256, 256, 8, (size_t)256 * 256, nullptr, wsm + OFF_WGATE / 2, (size_t)512 * 256, 1, 1}; return true;
    case 7: J = PrepJob{a.in[14], D, D, D, 1, 0, nullptr, wsm + OFF_WOUTB / 2, 0, 0, 0}; return true;
    case 8: J = PrepJob{a.in[25], D, D, D, 1, 0, norm_ple, wsm + OFF_WPLEG / 2, 0, 0, 0}; return true;
    case 9: J = PrepJob{a.in[25] + (size_t)D * D, D, D, D, 1, 0, norm_ple + D, wsm + OFF_WPLEG / 2 + (size_t)D * D, 0, 0, 0}; return true;
    case 10: J = PrepJob{a.in[24], D, 256, D, 2, (size_t)256 * D, nullptr, wsm + OFF_WPLE / 2, (size_t)D * 256, 0, 0}; return true;
    case 11: case 12: { const int L = j - 11; bf16_t* base = (bf16_t*)(ws + WS_WMOE + (size_t)L * 96 * MiB);
        J = PrepJob{a.in[20] + (size_t)L * 32 * D * 512, 512, D, 512, 32, (size_t)D * 512, norm_ffn + L * D, base, (size_t)1024 * D, 1, 0}; return true; }
    case 13: case 14: { const int L = j - 13; bf16_t* base = (bf16_t*)(ws + WS_WMOE + (size_t)L * 96 * MiB);
        J = PrepJob{a.in[21] + (size_t)L * 32 * D * 512, 512, D, 512, 32, (size_t)D * 512, norm_ffn + L * D, base, (size_t)1024 * D, 1, 1}; return true; }
    case 15: case 16: { const int L = j - 15; bf16_t* base = (bf16_t*)(ws + WS_WMOE + (size_t)L * 96 * MiB + 64 * MiB);
        J = PrepJob{a.in[22] + (size_t)L * 32 * 512 * D, D, 512, D, 32, (size_t)512 * D, nullptr, base, (size_t)1024 * 512, 0, 0}; return true; }
    default: return false;
    }
}
constexpr int N_PREP_JOBS = 17;
__device__ __forceinline__ void p0_prologue(Frame& F, const Args& a, int job_lo, int job_hi) {
    LAS float* scr = (LAS float*)(F.lds + F.wave * 16384);
    const int gw = F.vcu * NWAVES + F.wave, NGW = F.G * NWAVES;
    for (int j = job_lo; j < job_hi; ++j) {
        PrepJob J; if (!prep_job(a, j, J)) break;
        const int items = J.nbatch * (J.K / 64) * (J.ncols / 32);
        for (int it = gw; it < items; it += NGW) prep_item(J, scr, it, F.lane);
    }
    const float* x = a.in[0]; bf16_t* xb = (bf16_t*)(a.ws + WS_R(0)); float* rstd = (float*)(a.ws + WS_RSTD);
    for (int m = gw; m < NTOK; m += NGW) {
        const GAS f32x4* xr = (const GAS f32x4*)(x + (size_t)m * D) + F.lane;
        f32x4 v[4]; float s = 0.f;
#pragma unroll
        for (int j = 0; j < 4; ++j) { v[j] = xr[64 * j]; s += (v[j].x * v[j].x + v[j].y * v[j].y) + (v[j].z * v[j].z + v[j].w * v[j].w); }
        s = wave_sum(s);
        GAS u32x2* o8 = (GAS u32x2*)(xb + (size_t)m * D) + F.lane;
#pragma unroll
        for (int j = 0; j < 4; ++j) { u32x2 w; w.x = pk2(v[j].x, v[j].y); w.y = pk2(v[j].z, v[j].w); o8[64 * j] = w; }
        if (F.lane == 0) rstd[m] = 1.0f / sqrtf(s * (1.0f / D) + EPS);
    }
    const GAS f32x4* p4 = (const GAS f32x4*)a.in[1]; GAS u32x2* pb = (GAS u32x2*)(a.ws + WS_PB);
    const size_t n4 = (size_t)2 * NTOK * 256 / 4;
    for (size_t i = (size_t)gw * 64 + F.lane; i < n4; i += (size_t)NGW * 64) { const f32x4 v = p4[i]; u32x2 w; w.x = pk2(v.x, v.y); w.y = pk2(v.z, v.w); pb[i] = w; }
}

struct DenseSched {
    pg::DenseOrder O; int lda2;
    __device__ void init(int nN, int G, int c, int lda) { O.init(NTOK / 256, nN, G, c); lda2 = lda * 2; }
    __device__ bool next(int i, pg::Unit& u) const { int pm, pn; if (!O.tile(i, pm, pn)) return false; u.arow = pm * 256; u.acol = 0; u.brow = pn * 256; u.orow = pm * 256; u.pn = pn; u.aux = 0; return true; }
    __device__ __forceinline__ void a_offs(const pg::Unit& u, int R0, unsigned c2, unsigned (&o)[2][2]) const {
#pragma unroll
        for (int h = 0; h < 2; ++h)
#pragma unroll
            for (int i = 0; i < 2; ++i) o[h][i] = (unsigned)(u.arow + h * 128 + i * 64 + R0) * (unsigned)lda2 + (unsigned)u.acol * 2u + c2;
    }
};

struct EpiInA {
    bf16_t* G; bf16_t* Bg; const float* rstd;
    __device__ __forceinline__ void operator()(const f32x4 (&acc)[2][2][4][2], const pg::Unit& u, int wr, int wc, int fr, int fq) const {
        const int row0 = u.orow + wr * 64 + fr;
        if (u.pn < 8) {
            const int col0 = u.pn * 128 + wc * 16 + fq * 4;
#pragma unroll
            for (int ai = 0; ai < 2; ++ai)
#pragma unroll
                for (int m = 0; m < 4; ++m) { const int row = row0 + ai * 128 + m * 16; const float s = rstd[row]; const float s2 = s * s;
#pragma unroll
                    for (int bj = 0; bj < 2; ++bj) { const f32x4 c = acc[ai][bj][m][0], h = acc[ai][bj][m][1];
                        u32x2 w; w.x = pg::cvt_pk_bf16(c[0] * h[0] * s2, c[1] * h[1] * s2); w.y = pg::cvt_pk_bf16(c[2] * h[2] * s2, c[3] * h[3] * s2);
                        *(u32x2*)(G + (size_t)row * D + col0 + bj * 64) = w; } }
        } else {
            const int col0 = (u.pn - 8) * 256 + wc * 32 + fq * 8;
#pragma unroll
            for (int ai = 0; ai < 2; ++ai)
#pragma unroll
                for (int m = 0; m < 4; ++m) { const int row = row0 + ai * 128 + m * 16; const float s = rstd[row];
#pragma unroll
                    for (int bj = 0; bj < 2; ++bj) { const f32x4 v0 = acc[ai][bj][m][0] * s, v1 = acc[ai][bj][m][1] * s;
                        u32x4 w; w.x = pg::cvt_pk_bf16(v0[0], v0[1]); w.y = pg::cvt_pk_bf16(v0[2], v0[3]); w.z = pg::cvt_pk_bf16(v1[0], v1[1]); w.w = pg::cvt_pk_bf16(v1[2], v1[3]);
                        *(u32x4*)(Bg + (size_t)row * D + col0 + bj * 128) = w; } }
        }
    }
};

struct EpiResid {
    const float* resid; float* Hf; bf16_t* Hb; float* ssp;
    __device__ __forceinline__ void operator()(const f32x4 (&acc)[2][2][4][2], const pg::Unit& u, int wr, int wc, int fr, int fq) const {
        const int row0 = u.orow + wr * 64 + fr, col0 = u.pn * 256 + wc * 32 + fq * 8;
#pragma unroll
        for (int ai = 0; ai < 2; ++ai)
#pragma unroll
            for (int m = 0; m < 4; ++m) { const int row = row0 + ai * 128 + m * 16; const size_t off = (size_t)row * D + col0; float ss = 0.f;
#pragma unroll
                for (int bj = 0; bj < 2; ++bj) {
                    const f32x4 r0 = *(const f32x4*)(resid + off + bj * 128), r1 = *(const f32x4*)(resid + off + bj * 128 + 4);
                    const f32x4 v0 = acc[ai][bj][m][0] + r0, v1 = acc[ai][bj][m][1] + r1;
                    ss += (v0[0] * v0[0] + v0[1] * v0[1]) + (v0[2] * v0[2] + v0[3] * v0[3]) + (v1[0] * v1[0] + v1[1] * v1[1]) + (v1[2] * v1[2] + v1[3] * v1[3]);
                    *(f32x4*)(Hf + off + bj * 128) = v0; *(f32x4*)(Hf + off + bj * 128 + 4) = v1;
                    u32x4 w; w.x = pk2(v0[0], v0[1]); w.y = pk2(v0[2], v0[3]); w.z = pk2(v1[0], v1[1]); w.w = pk2(v1[2], v1[3]);
                    *(u32x4*)(Hb + off + bj * 128) = w; }
                ss += __shfl_xor(ss, 16); ss += __shfl_xor(ss, 32);
                if (fq == 0) ssp[(size_t)row * 16 + u.pn * 4 + wc] = ss; }
    }
};

__device__ __forceinline__ void unpack8(const u32x4 w, float (&f)[8]) { f[0] = bf_lo(w.x); f[1] = bf_hi(w.x); f[2] = bf_lo(w.y); f[3] = bf_hi(w.y); f[4] = bf_lo(w.z); f[5] = bf_hi(w.z); f[6] = bf_lo(w.w); f[7] = bf_hi(w.w); }
__device__ __forceinline__ u32x4 pack8(const float (&f)[8]) { u32x4 w; w.x = pk2(f[0], f[1]); w.y = pk2(f[2], f[3]); w.z = pk2(f[4], f[5]); w.w = pk2(f[6], f[7]); return w; }
__device__ __forceinline__ void p2_conv_a(Frame& F, const bf16_t* G, const bf16_t* Bg, const float* cw, bf16_t* A2) {
    const int gw = F.vcu * NWAVES + F.wave, NGW = F.G * NWAVES;
    for (int it = gw; it < 2048; it += NGW) {
        const int r0 = (it >> 1) * 16, c0 = (it & 1) * 512 + F.lane * 8, t0 = r0 % SEQ;
        float w0[8], w1[8], w2[8];
#pragma unroll
        for (int j = 0; j < 8; ++j) { w0[j] = cw[c0 + j]; w1[j] = cw[D + c0 + j]; w2[j] = cw[2 * D + c0 + j]; }
        const bf16_t* gp = G + (size_t)r0 * D + c0; const bf16_t* bp = Bg + (size_t)r0 * D + c0; bf16_t* op = A2 + (size_t)r0 * D + c0;
        float gm[8], gc[8], gn[8];
        if (t0 > 0) unpack8(*(const GAS u32x4*)(gp - D), gm); else {
#pragma unroll
            for (int j = 0; j < 8; ++j) gm[j] = 0.f; }
        unpack8(*(const GAS u32x4*)gp, gc);
#pragma unroll 4
        for (int r = 0; r < 16; ++r) {
            if (t0 + r + 1 < SEQ) unpack8(*(const GAS u32x4*)(gp + (size_t)(r + 1) * D), gn); else {
#pragma unroll
                for (int j = 0; j < 8; ++j) gn[j] = 0.f; }
            float b[8], o[8]; unpack8(*(const GAS u32x4*)(bp + (size_t)r * D), b);
#pragma unroll
            for (int j = 0; j < 8; ++j) { o[j] = b[j] * (w0[j] * gm[j] + w1[j] * gc[j] + w2[j] * gn[j]); gm[j] = gc[j]; gc[j] = gn[j]; }
            *(GAS u32x4*)(op + (size_t)r * D) = pack8(o);
        }
    }
}

__device__ __forceinline__ void p4_router(Frame& F, const float* Hf, const float* gain, const float* wg, const float* bg, const float* we, const float* be,
                                          unsigned* gcnt, int* lslot, float* lw, float* rstd_out) {
    LAS float* sL = (LAS float*)F.lds + F.wave * 40;
    LAS int* s_e = (LAS int*)(F.lds + 2048); LAS float* s_w = (LAS float*)(F.lds + 2560); LAS int* s_rank = (LAS int*)(F.lds + 3072);
    LAS unsigned* lcnt = (LAS unsigned*)(F.lds + 3584); LAS unsigned* lbase = (LAS unsigned*)(F.lds + 3712);
    for (int blk = F.vcu; blk < NTOK / 64; blk += F.G) {
        if (F.tid < 32) lcnt[F.tid] = 0u;
        __syncthreads();
        for (int q = 0; q < 8; ++q) {
            const int ts = F.wave * 8 + q, tok = blk * 64 + ts;
            float acc[36]; float ss = 0.f;
#pragma unroll
            for (int j = 0; j < 36; ++j) acc[j] = 0.f;
#pragma unroll 2
            for (int i = 0; i < 16; ++i) {
                const int k = F.lane + 64 * i; const float x = Hf[(size_t)tok * D + k]; ss += x * x; const float xg = x * gain[k];
                const f32x4 g4 = *(const f32x4*)(wg + (size_t)k * 4);
                acc[0] += xg * g4[0]; acc[1] += xg * g4[1]; acc[2] += xg * g4[2]; acc[3] += xg * g4[3];
#pragma unroll
                for (int jj = 0; jj < 8; ++jj) { const f32x4 e4 = *(const f32x4*)(we + (size_t)k * 32 + 4 * jj);
                    acc[4 + 4 * jj] += xg * e4[0]; acc[5 + 4 * jj] += xg * e4[1]; acc[6 + 4 * jj] += xg * e4[2]; acc[7 + 4 * jj] += xg * e4[3]; }
            }
            ss = wave_sum(ss); const float rs = 1.0f / sqrtf(ss * (1.0f / D) + EPS);
#pragma unroll
            for (int j = 0; j < 36; ++j) acc[j] = wave_sum(acc[j]);
            if (F.lane == 0) {
#pragma unroll
                for (int j = 0; j < 4; ++j) sL[j] = acc[j] * rs + bg[j];
#pragma unroll
                for (int j = 0; j < 32; ++j) sL[4 + j] = acc[4 + j] * rs + be[j];
                int g = 0;
                for (int j = 1; j < 4; ++j) if (sL[j] > sL[g]) g = j;
                float sg = 0.f; for (int j = 0; j < 4; ++j) sg += expf(sL[j] - sL[g]);
                const float pgt = 1.0f / sg;
                LAS float* le = sL + 4 + g * 8;
                int i0 = 0; for (int i = 1; i < 8; ++i) if (le[i] > le[i0]) i0 = i;
                int i1 = (i0 == 0) ? 1 : 0; for (int i = 0; i < 8; ++i) if (i != i0 && le[i] > le[i1]) i1 = i;
                const float e1 = expf(le[i1] - le[i0]); const float w0 = 1.0f / (1.0f + e1), w1 = e1 / (1.0f + e1);
                const int E0 = g * 8 + i0, E1 = g * 8 + i1;
                s_e[2 * ts] = E0; s_e[2 * ts + 1] = E1; s_w[2 * ts] = pgt * w0; s_w[2 * ts + 1] = pgt * w1;
                s_rank[2 * ts] = (int)__hip_atomic_fetch_add(&lcnt[E0], 1u, __ATOMIC_RELAXED, __HIP_MEMORY_SCOPE_WORKGROUP);
                s_rank[2 * ts + 1] = (int)__hip_atomic_fetch_add(&lcnt[E1], 1u, __ATOMIC_RELAXED, __HIP_MEMORY_SCOPE_WORKGROUP);
                rstd_out[tok] = rs;
            }
        }
        __syncthreads();
        if (F.tid < 32) lbase[F.tid] = __hip_atomic_fetch_add(gcnt + F.tid, lcnt[F.tid], __ATOMIC_RELAXED, __HIP_MEMORY_SCOPE_AGENT);
        __syncthreads();
        if (F.tid < 128) { const int s = F.tid, E = s_e[s]; const unsigned pos = lbase[E] + (unsigned)s_rank[s]; const int tok = blk * 64 + (s >> 1);
            lslot[(size_t)E * CAP + pos] = 2 * tok + (s & 1); lw[(size_t)E * CAP + pos] = s_w[s]; }
        __syncthreads();
    }
}

constexpr int MAXU = 5;
struct MoeSched {
    LAS int* ud; int n; const LAS unsigned* tabA; int mode; int lda2;
    __device__ bool next(int i, pg::Unit& u) const { if (i >= n) return false; const int e = ud[4 * i], pn = ud[4 * i + 2], rbg = ud[4 * i + 3];
        u.arow = mode == 0 ? i * 256 : rbg * 256; u.acol = 0; u.brow = e * 1024 + pn * 256; u.orow = rbg * 256; u.pn = pn; u.aux = i; return true; }
    __device__ __forceinline__ void a_offs(const pg::Unit& u, int R0, unsigned c2, unsigned (&o)[2][2]) const {
#pragma unroll
        for (int h = 0; h < 2; ++h)
#pragma unroll
            for (int i = 0; i < 2; ++i) { const int r = h * 128 + i * 64 + R0;
                o[h][i] = (mode == 0 ? tabA[u.arow + r] : (unsigned)(u.arow + r) * (unsigned)lda2) + c2; }
    }
};
__device__ __forceinline__ int moe_setup(Frame& F, const unsigned* gcnt, const int* lslot, const float* lw, const float* rstd, int which) {
    LAS int* ud = (LAS int*)(F.lds + TAB_OFF); LAS unsigned* tabA = (LAS unsigned*)(F.lds + TAB_OFF + 128); LAS unsigned* tabB = (LAS unsigned*)(F.lds + TAB_OFF + 128 + MAXU * 1024);
    __syncthreads();
    if (F.tid == 0) {
        int n = 0, rbg = 0; const int c = F.vcu;
        for (int e = 0; e < NEXP; ++e) { const int nrb = ((int)gcnt[e] + 255) >> 8;
            for (int rb = 0; rb < nrb; ++rb, ++rbg)
                for (int pn = 0; pn < 4; ++pn) { const int L = 4 * rbg + pn; if ((L % F.G) == c && n < MAXU) { ud[4 * n] = e; ud[4 * n + 1] = rb; ud[4 * n + 2] = pn; ud[4 * n + 3] = rbg; ++n; } } }
        ud[4 * MAXU] = n;
    }
    __syncthreads();
    const int n = ud[4 * MAXU];
    for (int i = 0; i < n; ++i) {
        if (F.tid < 256) { const int e = ud[4 * i], rb = ud[4 * i + 1], idx = rb * 256 + F.tid; const bool ok = idx < (int)gcnt[e];
            const int slot = ok ? lslot[(size_t)e * CAP + idx] : 0;
            if (which == 0) { tabA[i * 256 + F.tid] = (unsigned)(slot >> 1) * (unsigned)(D * 2); tabB[i * 256 + F.tid] = __builtin_bit_cast(unsigned, rstd[slot >> 1]); }
            else { tabA[i * 256 + F.tid] = ok ? (unsigned)slot : 0xffffffffu; tabB[i * 256 + F.tid] = ok ? __builtin_bit_cast(unsigned, lw[(size_t)e * CAP + idx]) : 0u; } }
    }
    VM_WAIT(); LDS_WAIT();
    __syncthreads();
    return n;
}
struct EpiUp {
    bf16_t* HID; const LAS unsigned* tabB;
    __device__ __forceinline__ void operator()(const f32x4 (&acc)[2][2][4][2], const pg::Unit& u, int wr, int wc, int fr, int fq) const {
        const int r0 = wr * 64 + fr, col0 = u.pn * 128 + wc * 16 + fq * 4;
#pragma unroll
        for (int ai = 0; ai < 2; ++ai)
#pragma unroll
            for (int m = 0; m < 4; ++m) { const int r = r0 + ai * 128 + m * 16; const float s = __builtin_bit_cast(float, tabB[u.aux * 256 + r]);
#pragma unroll
                for (int bj = 0; bj < 2; ++bj) { const f32x4 g = acc[ai][bj][m][0] * s, v = acc[ai][bj][m][1] * s; float o[4];
#pragma unroll
                    for (int j = 0; j < 4; ++j) o[j] = g[j] * fsigm(g[j]) * v[j];
                    u32x2 w; w.x = pk2(o[0], o[1]); w.y = pk2(o[2], o[3]);
                    *(u32x2*)(HID + (size_t)(u.orow + r) * FEXP + col0 + bj * 64) = w; } }
    }
};
struct EpiDown {
    bf16_t* Y; const LAS unsigned* tabA; const LAS unsigned* tabB;
    __device__ __forceinline__ void operator()(const f32x4 (&acc)[2][2][4][2], const pg::Unit& u, int wr, int wc, int fr, int fq) const {
        const int r0 = wr * 64 + fr, col0 = u.pn * 256 + wc * 32 + fq * 8;
#pragma unroll
        for (int ai = 0; ai < 2; ++ai)
#pragma unroll
            for (int m = 0; m < 4; ++m) { const int r = r0 + ai * 128 + m * 16; const unsigned slot = tabA[u.aux * 256 + r]; const float w = __builtin_bit_cast(float, tabB[u.aux * 256 + r]);
                if (slot != 0xffffffffu) {
#pragma unroll
                    for (int bj = 0; bj < 2; ++bj) { const f32x4 v0 = acc[ai][bj][m][0] * w, v1 = acc[ai][bj][m][1] * w;
                        u32x4 o; o.x = pk2(v0[0], v0[1]); o.y = pk2(v0[2], v0[3]); o.z = pk2(v1[0], v1[1]); o.w = pk2(v1[2], v1[3]);
                        *(u32x4*)(Y + (size_t)slot * D + col0 + bj * 128) = o; } } }
    }
};
__device__ __forceinline__ void p7_combine(Frame& F, float* Hf, bf16_t* Hb, const bf16_t* Y, float* ssp) {
    DenseSched S; S.init(4, F.G, (int)blockIdx.x, D);
    pg::Unit u;
    for (int i = 0; S.next(i, u); ++i) {
        for (int rr = F.wave; rr < 256; rr += NWAVES) {
            const int row = u.orow + rr, col = u.pn * 256 + F.lane * 4; const size_t off = (size_t)row * D + col;
            f32x4 h = *(const GAS f32x4*)(Hf + off);
            const u32x2 y0 = *(const GAS u32x2*)(Y + (size_t)(2 * row) * D + col), y1 = *(const GAS u32x2*)(Y + (size_t)(2 * row + 1) * D + col);
            h[0] += bf_lo(y0.x) + bf_lo(y1.x); h[1] += bf_hi(y0.x) + bf_hi(y1.x); h[2] += bf_lo(y0.y) + bf_lo(y1.y); h[3] += bf_hi(y0.y) + bf_hi(y1.y);
            *(GAS f32x4*)(Hf + off) = h;
            u32x2 w; w.x = pk2(h[0], h[1]); w.y = pk2(h[2], h[3]); *(GAS u32x2*)(Hb + off) = w;
            const float ss = wave_sum((h[0] * h[0] + h[1] * h[1]) + (h[2] * h[2] + h[3] * h[3]));
            if (F.lane < 4) ssp[(size_t)row * 16 + u.pn * 4 + F.lane] = F.lane == 0 ? ss : 0.f;
        }
    }
}

__device__ __forceinline__ float row_rstd(const float* ssp, int row) {
    const f32x4* p = (const f32x4*)(ssp + (size_t)row * 16); const f32x4 a = p[0], b = p[1], c = p[2], d = p[3];
    const float ss = ((a[0] + a[1]) + (a[2] + a[3])) + ((b[0] + b[1]) + (b[2] + b[3])) + ((c[0] + c[1]) + (c[2] + c[3])) + ((d[0] + d[1]) + (d[2] + d[3]));
    return 1.0f / sqrtf(ss * (1.0f / D) + EPS);
}
__device__ __forceinline__ float gelu_t(float x) {
    const float z = 1.5957691216057308f * (x + 0.044715f * x * x * x); return x * fsigm(z);
}
struct EpiLin {
    bf16_t* O0; bf16_t* O1; int split, act0, act1; const float* ssp;
    __device__ __forceinline__ void operator()(const f32x4 (&acc)[2][2][4][2], const pg::Unit& u, int wr, int wc, int fr, int fq) const {
        const bool first = u.pn < split; bf16_t* O = first ? O0 : O1; const int act = first ? act0 : act1;
        const int row0 = u.orow + wr * 64 + fr, col0 = (first ? u.pn : u.pn - split) * 256 + wc * 32 + fq * 8;
#pragma unroll
        for (int ai = 0; ai < 2; ++ai)
#pragma unroll
            for (int m = 0; m < 4; ++m) { const int row = row0 + ai * 128 + m * 16; const float s = ssp ? row_rstd(ssp, row) : 1.0f;
#pragma unroll
                for (int bj = 0; bj < 2; ++bj) { f32x4 v0 = acc[ai][bj][m][0] * s, v1 = acc[ai][bj][m][1] * s;
                    if (act == 1) {
#pragma unroll
                        for (int j = 0; j < 4; ++j) { v0[j] = gelu_t(v0[j]); v1[j] = gelu_t(v1[j]); } }
                    u32x4 w; w.x = pk2(v0[0], v0[1]); w.y = pk2(v0[2], v0[3]); w.z = pk2(v1[0], v1[1]); w.w = pk2(v1[2], v1[3]);
                    *(u32x4*)(O + (size_t)row * D + col0 + bj * 128) = w; }
                asm volatile("" ::: "memory"); __builtin_amdgcn_sched_barrier(0); }
    }
};
struct EpiPle {
    float* Hf; bf16_t* Hb; const float* ssp; float* ssp_out; const bf16_t* PW; const float* bias;
    __device__ __forceinline__ void operator()(const f32x4 (&acc)[2][2][4][2], const pg::Unit& u, int wr, int wc, int fr, int fq) const {
        const int row0 = u.orow + wr * 64 + fr, col0 = u.pn * 256 + wc * 32 + fq * 8;
        f32x4 bv[2][2];
#pragma unroll
        for (int bj = 0; bj < 2; ++bj) { bv[bj][0] = *(const f32x4*)(bias + col0 + bj * 128); bv[bj][1] = *(const f32x4*)(bias + col0 + bj * 128 + 4); }
#pragma unroll
        for (int ai = 0; ai < 2; ++ai)
#pragma unroll
            for (int m = 0; m < 4; ++m) { const int row = row0 + ai * 128 + m * 16; const size_t off = (size_t)row * D + col0; const float s = row_rstd(ssp, row); float ss = 0.f;
#pragma unroll
                for (int bj = 0; bj < 2; ++bj) {
                    f32x4 h0 = *(const f32x4*)(Hf + off + bj * 128), h1 = *(const f32x4*)(Hf + off + bj * 128 + 4);
                    const u32x4 pw = *(const u32x4*)(PW + off + bj * 128); float pf[8]; unpack8(pw, pf);
                    const f32x4 a0 = acc[ai][bj][m][0] * s + bv[bj][0], a1 = acc[ai][bj][m][1] * s + bv[bj][1];
#pragma unroll
                    for (int j = 0; j < 4; ++j) { h0[j] += fsigm(a0[j]) * pf[j]; h1[j] += fsigm(a1[j]) * pf[4 + j]; }
                    ss += (h0[0] * h0[0] + h0[1] * h0[1]) + (h0[2] * h0[2] + h0[3] * h0[3]) + (h1[0] * h1[0] + h1[1] * h1[1]) + (h1[2] * h1[2] + h1[3] * h1[3]);
                    *(f32x4*)(Hf + off + bj * 128) = h0; *(f32x4*)(Hf + off + bj * 128 + 4) = h1;
                    u32x4 w; w.x = pk2(h0[0], h0[1]); w.y = pk2(h0[2], h0[3]); w.z = pk2(h1[0], h1[1]); w.w = pk2(h1[2], h1[3]);
                    *(u32x4*)(Hb + off + bj * 128) = w; }
                ss += __shfl_xor(ss, 16); ss += __shfl_xor(ss, 32);
                if (fq == 0) ssp_out[(size_t)row * 16 + u.pn * 4 + wc] = ss;
                asm volatile("" ::: "memory"); __builtin_amdgcn_sched_barrier(0); }
    }
};
struct GateSched {
    pg::DenseOrder O;
    __device__ void init(int G, int c) { O.init(NTOK / 256, 16, G, c); }
    __device__ bool next(int i, pg::Unit& u) const { int pm, pn; if (!O.tile(i, pm, pn)) return false; u.arow = pm * 256; u.acol = ((pn >> 1) & 3) * 256; u.brow = pn * 256; u.orow = pm * 256; u.pn = pn; u.aux = 0; return true; }
    __device__ __forceinline__ void a_offs(const pg::Unit& u, int R0, unsigned c2, unsigned (&o)[2][2]) const {
#pragma unroll
        for (int h = 0; h < 2; ++h)
#pragma unroll
            for (int i = 0; i < 2; ++i) o[h][i] = (unsigned)(u.arow + h * 128 + i * 64 + R0) * (unsigned)(D * 2) + (unsigned)u.acol * 2u + c2;
    }
};
struct EpiGate {
    bf16_t* LA; bf16_t* GT; const bf16_t* ub; const float* br; const float* bi; const float* lam;
    __device__ __forceinline__ void operator()(const f32x4 (&acc)[2][2][4][2], const pg::Unit& u, int wr, int wc, int fr, int fq) const {
        const int d = u.pn >> 3, ch0 = ((u.pn >> 1) & 3) * 256 + (u.pn & 1) * 128 + wc * 16 + fq * 4, row0 = u.orow + wr * 64 + fr;
        f32x4 vbr[2], vbi[2], vsp[2];
#pragma unroll
        for (int bj = 0; bj < 2; ++bj) { vbr[bj] = *(const f32x4*)(br + d * D + ch0 + bj * 64); vbi[bj] = *(const f32x4*)(bi + d * D + ch0 + bj * 64);
            const f32x4 l = *(const f32x4*)(lam + d * D + ch0 + bj * 64);
#pragma unroll
            for (int j = 0; j < 4; ++j) vsp[bj][j] = -8.0f * 1.4426950408889634f * log1pf(expf(-l[j])); }
        bf16_t* la = LA + (size_t)d * NTOK * D; bf16_t* gt = GT + (size_t)d * NTOK * D;
#pragma unroll
        for (int ai = 0; ai < 2; ++ai)
#pragma unroll
            for (int m = 0; m < 4; ++m) { const int row = row0 + ai * 128 + m * 16;
#pragma unroll
                for (int bj = 0; bj < 2; ++bj) { const size_t off = (size_t)row * D + ch0 + bj * 64;
                    const u32x2 uw = *(const u32x2*)(ub + off); const float uf[4] = {bf_lo(uw.x), bf_hi(uw.x), bf_lo(uw.y), bf_hi(uw.y)};
                    const f32x4 rl = acc[ai][bj][m][0] + vbr[bj], il = acc[ai][bj][m][1] + vbi[bj]; float l2[4], g[4];
#pragma unroll
                    for (int j = 0; j < 4; ++j) { l2[j] = fsigm(rl[j]) * vsp[bj][j]; const float a2 = __builtin_amdgcn_exp2f(2.0f * l2[j]); g[j] = sqrtf(fmaxf(1.0f - a2, 0.f)) * (fsigm(il[j]) * uf[j]); }
                    u32x2 w; w.x = pk2(l2[0], l2[1]); w.y = pk2(l2[2], l2[3]); *(u32x2*)(la + off) = w;
                    w.x = pk2(g[0], g[1]); w.y = pk2(g[2], g[3]); *(u32x2*)(gt + off) = w; }
                asm volatile("" ::: "memory"); __builtin_amdgcn_sched_barrier(0); }
    }
};
__device__ __forceinline__ void p10_conv_b(Frame& F, const bf16_t* U, const float* cw, const float* cb, bf16_t* ub) {
    const int gw = F.vcu * NWAVES + F.wave, NGW = F.G * NWAVES;
    for (int it = gw; it < 2048; it += NGW) {
        const int r0 = (it >> 1) * 16, c0 = (it & 1) * 512 + F.lane * 8, t0 = r0 % SEQ;
        float w0[8], w1[8], w2[8], w3[8], bb[8];
#pragma unroll
        for (int j = 0; j < 8; ++j) { w0[j] = cw[c0 + j]; w1[j] = cw[D + c0 + j]; w2[j] = cw[2 * D + c0 + j]; w3[j] = cw[3 * D + c0 + j]; bb[j] = cb[c0 + j]; }
        const bf16_t* up = U + (size_t)r0 * D + c0; bf16_t* op = ub + (size_t)r0 * D + c0;
        float x0[8], x1[8], x2[8], x3[8];
        if (t0 > 0) { unpack8(*(const GAS u32x4*)(up - 2 * D), x0); unpack8(*(const GAS u32x4*)(up - D), x1); } else {
#pragma unroll
            for (int j = 0; j < 8; ++j) { x0[j] = 0.f; x1[j] = 0.f; } }
        unpack8(*(const GAS u32x4*)up, x2);
#pragma unroll 4
        for (int r = 0; r < 16; ++r) {
            if (t0 + r + 1 < SEQ) unpack8(*(const GAS u32x4*)(up + (size_t)(r + 1) * D), x3); else {
#pragma unroll
                for (int j = 0; j < 8; ++j) x3[j] = 0.f; }
            float o[8];
#pragma unroll
            for (int j = 0; j < 8; ++j) { o[j] = bb[j] + w0[j] * x0[j] + w1[j] * x1[j] + w2[j] * x2[j] + w3[j] * x3[j]; x0[j] = x1[j]; x1[j] = x2[j]; x2[j] = x3[j]; }
            *(GAS u32x4*)(op + (size_t)r * D) = pack8(o);
        }
    }
}
__device__ __forceinline__ float h2f(bf16_t v) { return (float)__builtin_bit_cast(_Float16, v); }
__device__ __forceinline__ void p12_scan(Frame& F, const bf16_t* LA, bf16_t* GT) {
    LAS float* sA = (LAS float*)F.lds; LAS float* sS = sA + 512;
    for (int id = F.vcu; id < 256; id += F.G) {
        const int d = id >> 7, b = (id >> 4) & 7, cg = id & 15, ch = cg * 64 + F.lane, chunk = F.wave;
        const size_t base = ((size_t)d * NTOK + (size_t)b * SEQ + (size_t)chunk * 256) * D + ch;
        const GAS bf16_t* la = (const GAS bf16_t*)LA + base; GAS bf16_t* gt = (GAS bf16_t*)GT + base;
        float h = 0.f, lsum = 0.f;
#pragma unroll 16
        for (int s = 0; s < 256; ++s) { const int t = d ? 255 - s : s; const float l = h2f(la[(size_t)t * D]), g = h2f(gt[(size_t)t * D]); h = __builtin_amdgcn_exp2f(l) * h + g; lsum += l; }
        sA[chunk * 64 + F.lane] = __builtin_amdgcn_exp2f(lsum); sS[chunk * 64 + F.lane] = h;
        LDS_WAIT(); __syncthreads();
        float c = 0.f;
        if (d == 0) { for (int cc = 0; cc < chunk; ++cc) c = sA[cc * 64 + F.lane] * c + sS[cc * 64 + F.lane]; }
        else { for (int cc = 7; cc > chunk; --cc) c = sA[cc * 64 + F.lane] * c + sS[cc * 64 + F.lane]; }
        h = c;
#pragma unroll 16
        for (int s = 0; s < 256; ++s) { const int t = d ? 255 - s : s; const float l = h2f(la[(size_t)t * D]), g = h2f(gt[(size_t)t * D]); h = __builtin_amdgcn_exp2f(l) * h + g;
            gt[(size_t)t * D] = __builtin_bit_cast(bf16_t, (_Float16)h); }
        LDS_WAIT(); __syncthreads();
    }
}
__device__ __forceinline__ void p13_mul(Frame& F, const bf16_t* YB, const bf16_t* HS, bf16_t* A2) {
    const size_t n8 = (size_t)NTOK * D / 8, stride = (size_t)F.G * NWAVES * 64;
    for (size_t i = ((size_t)F.vcu * NWAVES + F.wave) * 64 + F.lane; i < n8; i += stride) {
        float y[8], a[8], b[8], o[8]; unpack8(((const GAS u32x4*)YB)[i], y); unpack8(((const GAS u32x4*)HS)[i], a); unpack8(((const GAS u32x4*)HS)[n8 + i], b);
#pragma unroll
        for (int j = 0; j < 8; ++j) o[j] = y[j] * (a[j] + b[j]);
        ((GAS u32x4*)A2)[i] = pack8(o);
    }
}
__device__ __forceinline__ void p20_final(Frame& F, float* Hf, const float* ssp, const float* g) {
    DenseSched S; S.init(4, F.G, (int)blockIdx.x, D);
    pg::Unit u;
    for (int i = 0; S.next(i, u); ++i) {
        const f32x4 gv = *(const GAS f32x4*)(g + u.pn * 256 + F.lane * 4);
        for (int rr = F.wave; rr < 256; rr += NWAVES) {
            const int row = u.orow + rr; const size_t off = (size_t)row * D + u.pn * 256 + F.lane * 4;
            const float s = row_rstd(ssp, row);
            f32x4 h = *(const GAS f32x4*)(Hf + off); h = h * s * gv; *(GAS f32x4*)(Hf + off) = h;
        }
    }
}
__global__ void __launch_bounds__(NWAVES * 64, 2) mk_fwd(Args args) {
    extern __shared__ __attribute__((aligned(16))) unsigned char lds_[];
    Frame F;
    F.lds = (LAS unsigned char*)lds_;
    F.MISC = (volatile LAS unsigned*)(F.lds + MISC_OFF);
    F.tid = threadIdx.x; F.lane = F.tid & 63; F.wave = __builtin_amdgcn_readfirstlane(F.tid >> 6);
    F.G = gridDim.x; { const int bx = blockIdx.x; F.vcu = (F.G % 8 == 0) ? (bx % 8) * (F.G / 8) + bx / 8 : bx; }
    unsigned char* ws = args.ws;
    unsigned* ctl = (unsigned*)(ws + WS_CTL);
    for (int u = F.tid; u < (LDS_BYTES - MISC_OFF) / 4; u += NWAVES * 64) ((LAS unsigned*)(F.lds + MISC_OFF))[u] = 0u;
    __syncthreads();
    const int lo = args.ph_lo, hi = args.ph_hi;
    XcdBarrier bar; bar.bar = ctl + CW_BAR; bar.x = 0; bar.st = nullptr;
    if (hi - lo > 1) bar = xcd_barrier_post(ctl + CW_BAR, F.MISC + 8);
#define IN(k) (lo <= (k) && (k) < hi)
#define SEAM(k) do { if (IN(k) && IN((k) + 1)) xcd_barrier(bar); { int t_ = threadIdx.x; asm volatile("" : "+v"(t_)); F.tid = t_; F.lane = t_ & 63; } } while (0)
    bf16_t* wsm = (bf16_t*)(ws + WS_WSM);
    float* rstd = (float*)(ws + WS_RSTD);
    float* ssp0 = (float*)(ws + WS_SSP); float* ssp1 = (float*)(ws + WS_SSP1);
    float* Hf = args.out; bf16_t* Hb = (bf16_t*)(ws + WS_HB); bf16_t* PW = (bf16_t*)(ws + WS_PW); const bf16_t* pb = (const bf16_t*)(ws + WS_PB);
    const int c = (int)blockIdx.x;

    if (IN(0)) { p0_prologue(F, args, 0, N_PREP_JOBS); }
    SEAM(0);
    {
            if (IN(1)) {
                { pg::GemmDesc g{(const bf16_t*)(ws + WS_R(0)), D, wsm + OFF_WINA / 2, D, D};
                  DenseSched S; S.init(12, F.G, c, D);
                  EpiInA E{(bf16_t*)(ws + WS_R(1)), (bf16_t*)(ws + WS_R(2)), rstd};
                  pg::gemm_phase<EpiInA, DenseSched, true>(F.lds, g, S, E); }
                { pg::GemmDesc g{pb, 256, wsm + OFF_WPLE / 2, 256, 256};
                  DenseSched S; S.init(4, F.G, c, 256);
                  EpiLin E{PW, PW, 99, 0, 0, nullptr};
                  pg::gemm_phase<EpiLin, DenseSched, true>(F.lds, g, S, E); }
            }
            SEAM(1);
            if (IN(2)) p2_conv_a(F, (const bf16_t*)(ws + WS_R(1)), (const bf16_t*)(ws + WS_R(2)), args.in[4], (bf16_t*)(ws + WS_R(3)));
            SEAM(2);
            if (IN(3)) {
                pg::GemmDesc g{(const bf16_t*)(ws + WS_R(3)), D, wsm + OFF_WOUTA / 2, D, D};
                DenseSched S; S.init(4, F.G, c, D);
                EpiResid E{args.in[0], Hf, Hb, ssp0};
                pg::gemm_phase<EpiResid, DenseSched, true>(F.lds, g, S, E);
            }
            SEAM(3);
    }
    {
        const int PB = 4;
        unsigned* gcnt = ctl + CW_CNT + 0;
        int* lslot = (int*)(ws + WS_LSLOT); float* lw = (float*)(ws + WS_LW);
        bf16_t* wmoe = (bf16_t*)(ws + WS_WMOE + (size_t)0 * 96 * MiB);
        bf16_t* HID = (bf16_t*)(ws + WS_R(0)); bf16_t* Y = (bf16_t*)(ws + WS_R(2));
        if (IN(PB)) p4_router(F, Hf, args.in[15] + 0 * D, args.in[16] + (size_t)0 * D * 4, args.in[17] + 0 * 4, args.in[18] + (size_t)0 * D * 32, args.in[19] + 0 * 32, gcnt, lslot, lw, rstd);
        SEAM(PB);
        if (IN(PB + 1)) {
            const int n = moe_setup(F, gcnt, lslot, lw, rstd, 0);
            MoeSched S{(LAS int*)(F.lds + TAB_OFF), n, (const LAS unsigned*)(F.lds + TAB_OFF + 128), 0, D * 2};
            pg::GemmDesc g{Hb, D, wmoe, D, D};
            EpiUp E{HID, (const LAS unsigned*)(F.lds + TAB_OFF + 128 + MAXU * 1024)};
            pg::gemm_phase<EpiUp, MoeSched, true>(F.lds, g, S, E);
        }
        SEAM(PB + 1);
        if (IN(PB + 2)) {
            const int n = moe_setup(F, gcnt, lslot, lw, rstd, 1);
            MoeSched S{(LAS int*)(F.lds + TAB_OFF), n, (const LAS unsigned*)(F.lds + TAB_OFF + 128), 1, FEXP * 2};
            pg::GemmDesc g{HID, FEXP, wmoe + (size_t)32 * 1024 * D, FEXP, FEXP};
            EpiDown E{Y, (const LAS unsigned*)(F.lds + TAB_OFF + 128), (const LAS unsigned*)(F.lds + TAB_OFF + 128 + MAXU * 1024)};
            pg::gemm_phase<EpiDown, MoeSched, true>(F.lds, g, S, E);
        }
        SEAM(PB + 2);
        if (IN(PB + 3)) p7_combine(F, Hf, Hb, Y, ssp0);
        SEAM(PB + 3);
        if (IN(PB + 4)) {
            pg::GemmDesc g{Hb, D, wsm + OFF_WPLEG / 2 + (size_t)0 * D * D, D, D};
            DenseSched S; S.init(4, F.G, c, D);
            EpiPle E{Hf, Hb, ssp0, ssp1, PW, args.in[26] + 0 * D};
            pg::gemm_phase<EpiPle, DenseSched, true>(F.lds, g, S, E);
        }
        SEAM(PB + 4);
    }
    {
            bf16_t* YB = (bf16_t*)(ws + WS_R(0)); bf16_t* Ub = (bf16_t*)(ws + WS_R(1)); bf16_t* ub = (bf16_t*)(ws + WS_R(2));
            bf16_t* LA = (bf16_t*)(ws + WS_WMOE); bf16_t* GT = (bf16_t*)(ws + WS_R(3)); bf16_t* A2 = (bf16_t*)(ws + WS_R(5));
            if (IN(9)) {
                { pg::GemmDesc g{Hb, D, wsm + OFF_WINB / 2, D, D};
                  DenseSched S; S.init(8, F.G, c, D);
                  EpiLin E{YB, Ub, 4, 1, 0, ssp1};
                  pg::gemm_phase<EpiLin, DenseSched, true>(F.lds, g, S, E); }
                { pg::GemmDesc g{pb + (size_t)NTOK * 256, 256, wsm + OFF_WPLE / 2 + (size_t)D * 256, 256, 256};
                  DenseSched S; S.init(4, F.G, c, 256);
                  EpiLin E{PW, PW, 99, 0, 0, nullptr};
                  pg::gemm_phase<EpiLin, DenseSched, true>(F.lds, g, S, E); }
            }
            SEAM(9);
            if (IN(10)) p10_conv_b(F, Ub, args.in[7], args.in[8], ub);
            SEAM(10);
            if (IN(11)) {
                pg::GemmDesc g{ub, D, wsm + OFF_WGATE / 2, 256, 256};
                GateSched S; S.init(F.G, c);
                EpiGate E{LA, GT, ub, args.in[10], args.in[12], args.in[13]};
                pg::gemm_phase<EpiGate, GateSched, true>(F.lds, g, S, E);
            }
            SEAM(11);
            if (IN(12)) p12_scan(F, LA, GT);
            SEAM(12);
            if (IN(13)) p13_mul(F, YB, GT, A2);
            SEAM(13);
            if (IN(14)) {
                pg::GemmDesc g{A2, D, wsm + OFF_WOUTB / 2, D, D};
                DenseSched S; S.init(4, F.G, c, D);
                EpiResid E{Hf, Hf, Hb, ssp0};
                pg::gemm_phase<EpiResid, DenseSched, true>(F.lds, g, S, E);
            }
            SEAM(14);
    }
    {
        const int PB = 15;
        unsigned* gcnt = ctl + CW_CNT + 64;
        int* lslot = (int*)(ws + WS_LSLOT); float* lw = (float*)(ws + WS_LW);
        bf16_t* wmoe = (bf16_t*)(ws + WS_WMOE + (size_t)1 * 96 * MiB);
        bf16_t* HID = (bf16_t*)(ws + WS_R(0)); bf16_t* Y = (bf16_t*)(ws + WS_R(2));
        if (IN(PB)) p4_router(F, Hf, args.in[15] + 1 * D, args.in[16] + (size_t)1 * D * 4, args.in[17] + 1 * 4, args.in[18] + (size_t)1 * D * 32, args.in[19] + 1 * 32, gcnt, lslot, lw, rstd);
        SEAM(PB);
        if (IN(PB + 1)) {
            const int n = moe_setup(F, gcnt, lslot, lw, rstd, 0);
            MoeSched S{(LAS int*)(F.lds + TAB_OFF), n, (const LAS unsigned*)(F.lds + TAB_OFF + 128), 0, D * 2};
            pg::GemmDesc g{Hb, D, wmoe, D, D};
            EpiUp E{HID, (const LAS unsigned*)(F.lds + TAB_OFF + 128 + MAXU * 1024)};
            pg::gemm_phase<EpiUp, MoeSched, true>(F.lds, g, S, E);
        }
        SEAM(PB + 1);
        if (IN(PB + 2)) {
            const int n = moe_setup(F, gcnt, lslot, lw, rstd, 1);
            MoeSched S{(LAS int*)(F.lds + TAB_OFF), n, (const LAS unsigned*)(F.lds + TAB_OFF + 128), 1, FEXP * 2};
            pg::GemmDesc g{HID, FEXP, wmoe + (size_t)32 * 1024 * D, FEXP, FEXP};
            EpiDown E{Y, (const LAS unsigned*)(F.lds + TAB_OFF + 128), (const LAS unsigned*)(F.lds + TAB_OFF + 128 + MAXU * 1024)};
            pg::gemm_phase<EpiDown, MoeSched, true>(F.lds, g, S, E);
        }
        SEAM(PB + 2);
        if (IN(PB + 3)) p7_combine(F, Hf, Hb, Y, ssp0);
        SEAM(PB + 3);
        if (IN(PB + 4)) {
            pg::GemmDesc g{Hb, D, wsm + OFF_WPLEG / 2 + (size_t)1 * D * D, D, D};
            DenseSched S; S.init(4, F.G, c, D);
            EpiPle E{Hf, Hb, ssp0, ssp1, PW, args.in[26] + 1 * D};
            pg::gemm_phase<EpiPle, DenseSched, true>(F.lds, g, S, E);
        }
        SEAM(PB + 4);
    }
    if (IN(20)) p20_final(F, Hf, ssp1, args.in[27]);
#undef IN
#undef SEAM
}
__global__ __launch_bounds__(256) void k_rmsnorm(const float* in, const float* __restrict__ g, float* out) {
    const int row = blockIdx.x, t = threadIdx.x;
    const float4 v = ((const float4*)(in + (size_t)row * D))[t];
    float s = v.x * v.x + v.y * v.y + v.z * v.z + v.w * v.w;
    for (int o = 1; o < 64; o <<= 1) s += __shfl_xor(s, o);
    __shared__ float red[4];
    if ((t & 63) == 0) red[t >> 6] = s;
    __syncthreads();
    s = red[0] + red[1] + red[2] + red[3];
    const float r = rsqrtf(s * (1.0f / D) + EPS);
    const float4 gg = ((const float4*)g)[t];
    float4 o; o.x = v.x * r * gg.x; o.y = v.y * r * gg.y; o.z = v.z * r * gg.z; o.w = v.w * r * gg.w;
    ((float4*)(out + (size_t)row * D))[t] = o;
}

__global__ __launch_bounds__(256) void k_gemm(const float* __restrict__ A, int lda, long aZ, const int* __restrict__ rowidx, long rZ, int agather, const int* __restrict__ cnt, int M,
                                              const float* __restrict__ B, int ldb, long bZ, float* __restrict__ C, float* __restrict__ C1, int ldc, long cZ, const int* __restrict__ cstart,
                                              const int* __restrict__ astart, int omode, const float* __restrict__ wl, int K) {
    const int z = blockIdx.z, m0 = blockIdx.y * 64, n0 = blockIdx.x * 64, tid = threadIdx.x;
    const int Mz = cnt ? cnt[z] : M;
    if (m0 >= Mz) return;
    __shared__ float As[16][68];
    __shared__ float Bs[16][68];
    const float* Az = A + z * aZ; const float* Bz = B + z * bZ;
    const int ar = tid >> 2, ak = (tid & 3) * 4;
    const int bk = tid >> 4, bn = (tid & 15) * 4;
    long arow = -1;
    if (m0 + ar < Mz) { if (agather) arow = rowidx[z * rZ + m0 + ar] >> 1; else arow = (astart ? astart[z] : 0) + m0 + ar; }
    const int ty = tid >> 4, tx = tid & 15;
    float acc[4][4] = {};
    for (int k0 = 0; k0 < K; k0 += 16) {
        float4 av = make_float4(0.f, 0.f, 0.f, 0.f);
        if (arow >= 0) av = *(const float4*)(Az + arow * lda + k0 + ak);
        const float4 bv = *(const float4*)(Bz + (size_t)(k0 + bk) * ldb + n0 + bn);
        As[ak + 0][ar] = av.x; As[ak + 1][ar] = av.y; As[ak + 2][ar] = av.z; As[ak + 3][ar] = av.w;
        *(float4*)&Bs[bk][bn] = bv;
        __syncthreads();
#pragma unroll
        for (int k = 0; k < 16; ++k) {
            const float4 a = *(const float4*)&As[k][ty * 4];
            const float4 b = *(const float4*)&Bs[k][tx * 4];
            const float aa[4] = {a.x, a.y, a.z, a.w}, bb[4] = {b.x, b.y, b.z, b.w};
#pragma unroll
            for (int i = 0; i < 4; ++i)
#pragma unroll
                for (int j = 0; j < 4; ++j) acc[i][j] += aa[i] * bb[j];
        }
        __syncthreads();
    }
#pragma unroll
    for (int i = 0; i < 4; ++i) {
        const int m = m0 + ty * 4 + i;
        if (m >= Mz) continue;
        float4 o = make_float4(acc[i][0], acc[i][1], acc[i][2], acc[i][3]);
        if (omode == 0) {
            const long orow = (cstart ? cstart[z] : 0) + m;
            *(float4*)(C + z * cZ + orow * ldc + n0 + tx * 4) = o;
        } else {
            const int s = rowidx[z * rZ + m]; const float w = wl[z * rZ + m];
            o.x *= w; o.y *= w; o.z *= w; o.w *= w;
            float* base = (s & 1) ? C1 : C;
            *(float4*)(base + (size_t)(s >> 1) * ldc + n0 + tx * 4) = o;
        }
    }
}

__global__ __launch_bounds__(256) void k_convA(const float* __restrict__ bch, const float* __restrict__ cw, float* __restrict__ out) {
    const int row = blockIdx.x, t = row % SEQ;
    for (int c = threadIdx.x; c < D; c += 256) {
        const float* r0 = bch + (size_t)row * 3 * D;
        float g1 = r0[D + c] * r0[2 * D + c], g0 = 0.f, g2 = 0.f;
        if (t > 0) { const float* rm = r0 - 3 * D; g0 = rm[D + c] * rm[2 * D + c]; }
        if (t < SEQ - 1) { const float* rp = r0 + 3 * D; g2 = rp[D + c] * rp[2 * D + c]; }
        out[(size_t)row * D + c] = r0[c] * (cw[c] * g0 + cw[D + c] * g1 + cw[2 * D + c] * g2);
    }
}
__global__ __launch_bounds__(256) void k_add(const float* a, const float* b, float* o, size_t n4) {
    for (size_t i = blockIdx.x * 256ull + threadIdx.x; i < n4; i += (size_t)gridDim.x * 256) {
        const float4 x = ((const float4*)a)[i], y = ((const float4*)b)[i];
        ((float4*)o)[i] = make_float4(x.x + y.x, x.y + y.y, x.z + y.z, x.w + y.w);
    }
}
__global__ __launch_bounds__(256) void k_add3(float* __restrict__ h, const float* __restrict__ a, const float* __restrict__ b, size_t n4) {
    for (size_t i = blockIdx.x * 256ull + threadIdx.x; i < n4; i += (size_t)gridDim.x * 256) {
        const float4 x = ((const float4*)h)[i], y = ((const float4*)a)[i], z = ((const float4*)b)[i];
        ((float4*)h)[i] = make_float4(x.x + y.x + z.x, x.y + y.y + z.y, x.z + y.z + z.z, x.w + y.w + z.w);
    }
}
__device__ __forceinline__ float sigm(float x) { return 1.0f / (1.0f + expf(-x)); }
__global__ __launch_bounds__(256) void k_ple(float* __restrict__ h, const float* __restrict__ gl, const float* __restrict__ bias, const float* __restrict__ pw) {
    const int row = blockIdx.x;
    for (int c = threadIdx.x; c < D; c += 256) { const size_t i = (size_t)row * D + c; h[i] += sigm(gl[i] + bias[c]) * pw[i]; }
}
__global__ __launch_bounds__(256) void k_router(const float* __restrict__ xf, const float* __restrict__ wg, const float* __restrict__ bg, const float* __restrict__ we, const float* __restrict__ be,
                                                int* __restrict__ cnt, int* __restrict__ lslot, float* __restrict__ lw) {
    const int tok = blockIdx.x * 4 + (threadIdx.x >> 6), lane = threadIdx.x & 63;
    float acc[36];
#pragma unroll
    for (int j = 0; j < 36; ++j) acc[j] = 0.f;
    for (int i = 0; i < 16; ++i) {
        const int k = lane + 64 * i; const float x = xf[(size_t)tok * D + k];
#pragma unroll
        for (int j = 0; j < 4; ++j) acc[j] += x * wg[k * 4 + j];
#pragma unroll
        for (int j = 0; j < 32; ++j) acc[4 + j] += x * we[k * 32 + j];
    }
#pragma unroll
    for (int j = 0; j < 36; ++j) for (int o = 1; o < 64; o <<= 1) acc[j] += __shfl_xor(acc[j], o);
    __shared__ float sl[4][40];
    float* L = sl[threadIdx.x >> 6];
    if (lane == 0) {
#pragma unroll
        for (int j = 0; j < 36; ++j) L[j] = acc[j];
        int g = 0;
        for (int j = 0; j < 4; ++j) L[j] += bg[j];
        for (int j = 1; j < 4; ++j) if (L[j] > L[g]) g = j;
        float sg = 0.f; for (int j = 0; j < 4; ++j) sg += expf(L[j] - L[g]);
        const float pg = 1.0f / sg;
        float* le = L + 4 + g * 8;
        for (int i = 0; i < 8; ++i) le[i] += be[g * 8 + i];
        int i0 = 0; for (int i = 1; i < 8; ++i) if (le[i] > le[i0]) i0 = i;
        int i1 = (i0 == 0) ? 1 : 0; for (int i = 0; i < 8; ++i) if (i != i0 && le[i] > le[i1]) i1 = i;
        const float e1 = expf(le[i1] - le[i0]); const float w0 = 1.0f / (1.0f + e1), w1 = e1 / (1.0f + e1);
        const int E0 = g * 8 + i0, E1 = g * 8 + i1;
        const int p0 = atomicAdd(&cnt[E0], 1); lslot[E0 * CAP + p0] = 2 * tok; lw[E0 * CAP + p0] = pg * w0;
        const int p1 = atomicAdd(&cnt[E1], 1); lslot[E1 * CAP + p1] = 2 * tok + 1; lw[E1 * CAP + p1] = pg * w1;
    }
}
__global__ void k_cstart(const int* __restrict__ cnt, int* __restrict__ cstart) {
    if (threadIdx.x == 0) { int s = 0; for (int e = 0; e < NEXP; ++e) { cstart[e] = s; s += (cnt[e] + 255) / 256 * 256; } }
}
__global__ __launch_bounds__(256) void k_silu_mul(float* __restrict__ g, const float* __restrict__ u, size_t n) {
    for (size_t i = blockIdx.x * 256ull + threadIdx.x; i < n; i += (size_t)gridDim.x * 256) { const float x = g[i]; g[i] = x * sigm(x) * u[i]; }
}
__global__ __launch_bounds__(256) void k_convB(const float* __restrict__ yu, const float* __restrict__ cw, const float* __restrict__ cb, float* __restrict__ out) {
    const int row = blockIdx.x, t = row % SEQ;
    for (int c = threadIdx.x; c < D; c += 256) {
        float s = cb[c];
#pragma unroll
        for (int k = 0; k < 4; ++k) { const int tt = t + k - 2; if (tt >= 0 && tt < SEQ) s += cw[k * D + c] * yu[(size_t)(row + k - 2) * 2 * D + D + c]; }
        out[(size_t)row * D + c] = s;
    }
}
__global__ __launch_bounds__(256) void k_scan(const float* __restrict__ rl, const float* __restrict__ il, const float* __restrict__ u, const float* __restrict__ br, const float* __restrict__ bi,
                                              const float* __restrict__ lam, float* __restrict__ hs, int rev) {
    const int idx = blockIdx.x * 256 + threadIdx.x, b = idx / D, c = idx % D;
    const float sp = log1pf(expf(-lam[c])), bR = br[c], bI = bi[c];
    float h = 0.f;
    for (int s = 0; s < SEQ; ++s) {
        const int t = rev ? SEQ - 1 - s : s; const size_t i = (size_t)(b * SEQ + t) * D + c;
        const float r = sigm(rl[i] + bR), ig = sigm(il[i] + bI);
        const float la = -8.0f * r * sp, a = expf(la);
        const float gt = sqrtf(-expm1f(2.0f * la)) * (ig * u[i]);
        h = a * h + gt;
        if (rev) hs[i] += h; else hs[i] = h;
    }
}
__device__ __forceinline__ float gelu_tanh(float x) { const float c = 0.7978845608028654f; return 0.5f * x * (1.0f + tanhf(c * (x + 0.044715f * x * x * x))); }
__global__ __launch_bounds__(256) void k_mulY(const float* __restrict__ yu, const float* __restrict__ hs, float* __restrict__ out) {
    const int row = blockIdx.x;
    for (int c = threadIdx.x; c < D; c += 256) out[(size_t)row * D + c] = gelu_tanh(yu[(size_t)row * 2 * D + c]) * hs[(size_t)row * D + c];
}

__global__ __launch_bounds__(256) void k_cvt(const bf16_t* __restrict__ src, float* __restrict__ dst, size_t n) {
    for (size_t i = blockIdx.x * 256ull + threadIdx.x; i < n; i += (size_t)gridDim.x * 256) dst[i] = (float)__builtin_bit_cast(_Float16, src[i]);
}
__global__ __launch_bounds__(256) void k_convA2(const float* __restrict__ bg, const float* __restrict__ g, const float* __restrict__ cw, float* __restrict__ out) {
    const int row = blockIdx.x, t = row % SEQ;
    for (int c = threadIdx.x; c < D; c += 256) {
        const size_t i = (size_t)row * D + c;
        const float g1 = g[i], g0 = t > 0 ? g[i - D] : 0.f, g2 = t < SEQ - 1 ? g[i + D] : 0.f;
        out[i] = bg[i] * (cw[c] * g0 + cw[D + c] * g1 + cw[2 * D + c] * g2);
    }
}
static void gemm(hipStream_t st, const float* A, int lda, const float* B, int ldb, float* C, int ldc, int M, int N, int K) {
    hipLaunchKernelGGL(k_gemm, dim3(N / 64, M / 64, 1), dim3(256), 0, st, A, lda, 0L, (const int*)nullptr, 0L, 0, (const int*)nullptr, M, B, ldb, 0L, C, (float*)nullptr, ldc, 0L,
                       (const int*)nullptr, (const int*)nullptr, 0, (const float*)nullptr, K);
}
static void launch_fast(hipStream_t stream, Args a, int lo, int hi, bool per_phase) {
    static bool attr = false;
    if (!attr) { (void)hipFuncSetAttribute((const void*)mk_fwd, hipFuncAttributeMaxDynamicSharedMemorySize, LDS_BYTES); attr = true; }
    if (per_phase) { for (int p = lo; p < hi; ++p) { a.ph_lo = p; a.ph_hi = p + 1; hipLaunchKernelGGL(mk_fwd, dim3(256), dim3(NWAVES * 64), LDS_BYTES, stream, a); } }
    else { a.ph_lo = lo; a.ph_hi = hi; hipLaunchKernelGGL(mk_fwd, dim3(256), dim3(NWAVES * 64), LDS_BYTES, stream, a); }
}
extern "C" void kernel_launch(void* const* d_in, const int* in_sizes, int n_in, void* d_out, int out_size, void* d_ws, size_t ws_size, hipStream_t stream) {
    const float* x = (const float*)d_in[0]; const float* p = (const float*)d_in[1]; const float* norm_mix = (const float*)d_in[2];
    const float* w_in_a = (const float*)d_in[3]; const float* conv_a = (const float*)d_in[4]; const float* w_out_a = (const float*)d_in[5];
    const float* w_in_b = (const float*)d_in[6]; const float* conv_b = (const float*)d_in[7]; const float* conv_bias_b = (const float*)d_in[8];
    const float* w_rgate = (const float*)d_in[9]; const float* b_rgate = (const float*)d_in[10]; const float* w_igate = (const float*)d_in[11]; const float* b_igate = (const float*)d_in[12];
    const float* lam = (const float*)d_in[13]; const float* w_out_b = (const float*)d_in[14]; const float* norm_ffn = (const float*)d_in[15];
    const float* w_rg = (const float*)d_in[16]; const float* b_rg = (const float*)d_in[17]; const float* w_re = (const float*)d_in[18]; const float* b_re = (const float*)d_in[19];
    const float* w_eg = (const float*)d_in[20]; const float* w_eu = (const float*)d_in[21]; const float* w_ed = (const float*)d_in[22];
    const float* norm_ple = (const float*)d_in[23]; const float* w_ple = (const float*)d_in[24]; const float* w_pleg = (const float*)d_in[25]; const float* b_pleg = (const float*)d_in[26];
    const float* norm_final = (const float*)d_in[27];
    (void)in_sizes; (void)n_in; (void)out_size;
    if (ws_size < WS_END) { fprintf(stderr, "ws too small: %zu < %zu\n", ws_size, (size_t)WS_END); return; }
    float* H = (float*)d_out;
    char* ws = (char*)d_ws;
    (void)hipMemsetAsync(ws + WS_CTL, 0, CTL_ZERO_BYTES, stream);
    Args a{};
    for (int i = 0; i < 28; ++i) a.in[i] = (const float*)d_in[i];
    a.out = (float*)d_out; a.ws = (unsigned char*)d_ws;
    launch_fast(stream, a, 0, HYB, HYB_PER_PHASE);
    const size_t SZ = (size_t)NTOK * D * 4;
    float* T1 = (float*)(ws + NV_T1); float* T2 = (float*)(ws + NV_T2); float* T3 = (float*)(ws + NV_T3); float* T4 = (float*)(ws + NV_T4);
    int* cnt = (int*)(ws + NV_MISC); int* cstart = cnt + 64; int* lslot = cnt + 128; float* lw = (float*)(lslot + NEXP * CAP);
    const size_t n4 = (size_t)NTOK * D / 4;
    (void)SZ;
    auto moe = [&](int L) {
        hipLaunchKernelGGL(k_rmsnorm, dim3(NTOK), dim3(256), 0, stream, H, norm_ffn + L * D, T2);
        const bool fastr = NV_FAST_ROUTER && L < NV_FAST_ROUTER_LAYERS;
        if (fastr) { cnt = (int*)(ws + WS_CTL) + CW_CNT + 64 * L; lslot = (int*)(ws + WS_LSLOT); lw = (float*)(ws + WS_LW); }
        else { cnt = (int*)(ws + NV_MISC); lslot = cnt + 128; lw = (float*)(lslot + NEXP * CAP); (void)hipMemsetAsync(cnt, 0, 256, stream); }
        if (!fastr) hipLaunchKernelGGL(k_router, dim3(NTOK / 4), dim3(256), 0, stream, T2, w_rg + (size_t)L * D * 4, b_rg + L * 4, w_re + (size_t)L * D * 32, b_re + L * 32, cnt, lslot, lw);
        hipLaunchKernelGGL(k_cstart, dim3(1), dim3(64), 0, stream, cnt, cstart);
        float* HG = T1; float* HU = T1 + (size_t)40960 * FEXP;
        const float* wg = w_eg + (size_t)L * NEXP * D * FEXP; const float* wu = w_eu + (size_t)L * NEXP * D * FEXP; const float* wd = w_ed + (size_t)L * NEXP * FEXP * D;
        hipLaunchKernelGGL(k_gemm, dim3(FEXP / 64, CAP / 64, NEXP), dim3(256), 0, stream, T2, D, 0L, lslot, (long)CAP, 1, cnt, 0, wg, FEXP, (long)D * FEXP, HG, (float*)nullptr, FEXP, 0L, cstart,
                           (const int*)nullptr, 0, (const float*)nullptr, D);
        hipLaunchKernelGGL(k_gemm, dim3(FEXP / 64, CAP / 64, NEXP), dim3(256), 0, stream, T2, D, 0L, lslot, (long)CAP, 1, cnt, 0, wu, FEXP, (long)D * FEXP, HU, (float*)nullptr, FEXP, 0L, cstart,
                           (const int*)nullptr, 0, (const float*)nullptr, D);
        hipLaunchKernelGGL(k_silu_mul, dim3(4096), dim3(256), 0, stream, HG, HU, (size_t)40960 * FEXP);
        hipLaunchKernelGGL(k_gemm, dim3(D / 64, CAP / 64, NEXP), dim3(256), 0, stream, HG, FEXP, 0L, lslot, (long)CAP, 0, cnt, 0, wd, D, (long)FEXP * D, T3, T4, D, 0L, (const int*)nullptr,
                           cstart, 1, lw, FEXP);
        hipLaunchKernelGGL(k_add3, dim3(4096), dim3(256), 0, stream, H, T3, T4, n4);
    };
    auto ple = [&](int L) {
        hipLaunchKernelGGL(k_rmsnorm, dim3(NTOK), dim3(256), 0, stream, H, norm_ple + L * D, T2);
        gemm(stream, T2, D, w_pleg + (size_t)L * D * D, D, T3, D, NTOK, D, D);
        gemm(stream, p + (size_t)L * NTOK * PLE, PLE, w_ple + (size_t)L * PLE * D, D, T4, D, NTOK, D, PLE);
        hipLaunchKernelGGL(k_ple, dim3(NTOK), dim3(256), 0, stream, H, T3, b_pleg + L * D, T4);
    };
    const int st = NV_START;
    if (st <= 1) { hipLaunchKernelGGL(k_rmsnorm, dim3(NTOK), dim3(256), 0, stream, x, norm_mix, T2); gemm(stream, T2, D, w_in_a, 3 * D, T1, 3 * D, NTOK, 3 * D, D); }
    if (st <= 2) {
        if (st == 2) {
            hipLaunchKernelGGL(k_cvt, dim3(4096), dim3(256), 0, stream, (const bf16_t*)(ws + WS_R(1)), T2, (size_t)NTOK * D);
            hipLaunchKernelGGL(k_cvt, dim3(4096), dim3(256), 0, stream, (const bf16_t*)(ws + WS_R(2)), T4, (size_t)NTOK * D);
            hipLaunchKernelGGL(k_convA2, dim3(NTOK), dim3(256), 0, stream, T4, T2, conv_a, T3);
        } else hipLaunchKernelGGL(k_convA, dim3(NTOK), dim3(256), 0, stream, T1, conv_a, T3);
    }
    if (st <= 3) { gemm(stream, T3, D, w_out_a, D, T2, D, NTOK, D, D); hipLaunchKernelGGL(k_add, dim3(4096), dim3(256), 0, stream, x, T2, H, n4); }
    if (st <= 4) moe(0);
    if (st <= 5) ple(0);
    float* HS = T1 + 2 * (size_t)NTOK * D;
    if (st <= 6) { hipLaunchKernelGGL(k_rmsnorm, dim3(NTOK), dim3(256), 0, stream, H, norm_mix + D, T2); gemm(stream, T2, D, w_in_b, 2 * D, T1, 2 * D, NTOK, 2 * D, D); }
    if (st <= 7) hipLaunchKernelGGL(k_convB, dim3(NTOK), dim3(256), 0, stream, T1, conv_b, conv_bias_b, T3);
    if (st <= 8) for (int d = 0; d < 2; ++d) {
        hipLaunchKernelGGL(k_gemm, dim3(256 / 64, NTOK / 64, 4), dim3(256), 0, stream, T3, D, 256L, (const int*)nullptr, 0L, 0, (const int*)nullptr, NTOK, w_rgate + (size_t)d * 4 * 256 * 256, 256,
                           256L * 256, T2, (float*)nullptr, D, 256L, (const int*)nullptr, (const int*)nullptr, 0, (const float*)nullptr, 256);
        hipLaunchKernelGGL(k_gemm, dim3(256 / 64, NTOK / 64, 4), dim3(256), 0, stream, T3, D, 256L, (const int*)nullptr, 0L, 0, (const int*)nullptr, NTOK, w_igate + (size_t)d * 4 * 256 * 256, 256,
                           256L * 256, T4, (float*)nullptr, D, 256L, (const int*)nullptr, (const int*)nullptr, 0, (const float*)nullptr, 256);
        hipLaunchKernelGGL(k_scan, dim3(BATCH * D / 256), dim3(256), 0, stream, T2, T4, T3, b_rgate + d * D, b_igate + d * D, lam + d * D, HS, d);
    }
    if (st <= 9) { hipLaunchKernelGGL(k_mulY, dim3(NTOK), dim3(256), 0, stream, T1, HS, T2); gemm(stream, T2, D, w_out_b, D, T3, D, NTOK, D, D); hipLaunchKernelGGL(k_add, dim3(4096), dim3(256), 0, stream, H, T3, H, n4); }
    if (st <= 10) moe(1);
    if (st <= 11) ple(1);
    if (st <= 12) hipLaunchKernelGGL(k_rmsnorm, dim3(NTOK), dim3(256), 0, stream, H, norm_final, H);
}
```

```cpp
#include <hip/hip_runtime.h>
#include <cstdio>
#include <cstdint>
constexpr int D = 1024, BATCH = 8, SEQ = 2048, NTOK = BATCH * SEQ, PLE = 256, NEXP = 32, FEXP = 512, CAP = NTOK;
constexpr float EPS = 1e-6f;
constexpr int HYB = 21; constexpr bool HYB_PER_PHASE = false; constexpr int NV_START = 13; constexpr bool NV_FAST_ROUTER = true; constexpr int NV_FAST_ROUTER_LAYERS = 2;
constexpr size_t NV_T1 = (size_t)8 << 20, NV_T2 = (size_t)200 << 20, NV_T3 = (size_t)264 << 20, NV_T4 = (size_t)328 << 20, NV_MISC = (size_t)400 << 20;
#define LAS __attribute__((address_space(3)))
#define GAS __attribute__((address_space(1)))
typedef unsigned short bf16_t;
typedef short bf16x8 __attribute__((ext_vector_type(8)));
typedef _Float16 half8 __attribute__((ext_vector_type(8)));
typedef _Float16 half2v __attribute__((ext_vector_type(2)));
typedef float f32x4 __attribute__((ext_vector_type(4)));
typedef float f32x2 __attribute__((ext_vector_type(2)));
typedef unsigned u32x4 __attribute__((ext_vector_type(4)));
typedef unsigned u32x2 __attribute__((ext_vector_type(2)));
namespace pg {
constexpr int BM = 256, BK = 64, HALF = 128, HTB = HALF * BK * 2, STAGE_BYTES = 8 * HTB, NXCD = 8, WGM = 8;
__host__ __device__ __forceinline__ int lds_byte(int r, int c) { const int st = (r >> 4) * 2 + (c >> 5), rr = r & 15, cc = c & 31, ob = rr * 64 + cc * 2; return st * 1024 + (ob ^ (((ob >> 9) & 1) << 5)); }
__host__ __device__ __forceinline__ void stage_rc(int b, int& R, int& C) { const int st = b / 1024, sb = b % 1024, swz = sb ^ (((sb >> 9) & 1) << 5); R = (st >> 1) * 16 + swz / 64; C = (st & 1) * 32 + (swz % 64) / 2; }

struct Unit { int arow, acol, brow, orow, pn, aux; };
struct GemmDesc { const bf16_t* A; int lda; const bf16_t* Bt; int ldb; int K; };

struct DenseOrder {
    int nM, nN, nwg, G, c;
    __device__ void init(int nM_, int nN_, int G_, int c_) { nM = nM_; nN = nN_; nwg = nM * nN; G = G_; c = c_; }
    __device__ bool tile(int i, int& pm, int& pn) const {
        const long L = (long)i * G + c; if (L >= nwg) return false;
        int wgid = (int)L; { const int q = nwg / NXCD, r = nwg % NXCD, xcd = wgid % NXCD, off = wgid / NXCD; wgid = (xcd < r ? xcd * (q + 1) : r * (q + 1) + (xcd - r) * q) + off; }
        const int nig = WGM * nN, gid = wgid / nig, fm = gid * WGM, gsz = (nM - fm) < WGM ? (nM - fm) : WGM;
        pm = fm + ((wgid % nig) % gsz); pn = (wgid % nig) / gsz; return true;
    }
};

__device__ __forceinline__ unsigned cvt_pk_bf16(float lo, float hi) { half2v v; v.x = (_Float16)lo; v.y = (_Float16)hi; return __builtin_bit_cast(unsigned, v); }

template <class Epi, class Sched, bool ALIGN_EPI>
__device__ __forceinline__ void gemm_phase(LAS unsigned char* lds, const GemmDesc g, const Sched& S, const Epi& E) {
    int tid_ = threadIdx.x; asm volatile("" : "+v"(tid_));
    const int tid = tid_, wid = __builtin_amdgcn_readfirstlane(tid >> 6), lane = tid & 63, wr = wid >> 2, wc = wid & 3, fr = lane & 15, fq = lane >> 4;
    const int K = g.K, nt = K / BK;
    int R0, C0; stage_rc(tid * 16, R0, C0);
    unsigned voffB[2]; voffB[0] = (unsigned)(R0 * g.ldb + C0) * 2u; voffB[1] = voffB[0] + (unsigned)(64 * g.ldb) * 2u;
    const unsigned c2 = (unsigned)C0 * 2u;
    const size_t kstep = (size_t)(BK * 2);
    const size_t hstepB = (size_t)HALF * g.ldb * 2;
    const unsigned ldsw = (unsigned)wid * 1024u;
    const int aoff = lds_byte(wr * 64 + fr, fq * 8), boff = lds_byte(wc * 32 + fr, fq * 8);
#define PG_SA(b, h) (((b) * 2 + (h)) * HTB)
#define PG_SB(b, h) ((4 + (b) * 2 + (h)) * HTB)
#define PG_STAGE(bufoff, gbase, voff) do { _Pragma("unroll") for (int _i = 0; _i < 2; ++_i) \
        __builtin_amdgcn_global_load_lds((const unsigned*)((const char*)(gbase) + (voff)[_i]), (LAS unsigned*)(lds + (bufoff) + ldsw + _i * 8192), 16, 0, 0); } while (0)
#define PG_LDA(dst, b, h) do { _Pragma("unroll") for (int m = 0; m < 4; ++m) _Pragma("unroll") for (int k = 0; k < 2; ++k) dst[m][k] = *(const LAS bf16x8*)(lds + PG_SA(b, h) + aoff + m * 2048 + k * 1024); } while (0)
#define PG_LDB(dst, b, h) do { _Pragma("unroll") for (int n = 0; n < 2; ++n) _Pragma("unroll") for (int k = 0; k < 2; ++k) dst[n][k] = *(const LAS bf16x8*)(lds + PG_SB(b, h) + boff + n * 2048 + k * 1024); } while (0)
#define PG_MMA(ai, bj, At, Bt) do { __builtin_amdgcn_s_setprio(1); _Pragma("unroll") for (int m = 0; m < 4; ++m) _Pragma("unroll") for (int n = 0; n < 2; ++n) _Pragma("unroll") for (int k = 0; k < 2; ++k) \
        acc[ai][bj][m][n] = __builtin_amdgcn_mfma_f32_16x16x32_f16(__builtin_bit_cast(half8, Bt[n][k]), __builtin_bit_cast(half8, At[m][k]), acc[ai][bj][m][n], 0, 0, 0); __builtin_amdgcn_s_setprio(0); } while (0)
#define PG_WAIT_V(n) asm volatile("s_waitcnt vmcnt(" #n ")" ::: "memory")
#define PG_WAIT_L(n) asm volatile("s_waitcnt lgkmcnt(" #n ")" ::: "memory")
#define PG_BAR __builtin_amdgcn_s_barrier()
#define PG_SCHED __builtin_amdgcn_sched_barrier(0)
    Unit cur, nxt; int ui = 0;
    if (!S.next(0, cur)) return;
    f32x4 acc[2][2][4][2];
#pragma unroll
    for (int a = 0; a < 2; ++a)
#pragma unroll
        for (int b = 0; b < 2; ++b)
#pragma unroll
            for (int m = 0; m < 4; ++m)
#pragma unroll
                for (int n = 0; n < 2; ++n) acc[a][b][m][n] = (f32x4){0.f, 0.f, 0.f, 0.f};
    bf16x8 At[4][2], B0[2][2], B1[2][2];
    unsigned offA[2][2];
    S.a_offs(cur, R0, c2, offA);
    const char* Ab = (const char*)g.A;
    const char* cB = (const char*)g.Bt + (size_t)cur.brow * g.ldb * 2;
    PG_STAGE(PG_SB(0, 0), cB, voffB); PG_STAGE(PG_SB(0, 1), cB + hstepB, voffB); PG_STAGE(PG_SA(0, 0), Ab, offA[0]); PG_STAGE(PG_SA(0, 1), Ab, offA[1]);
    if (wr == 1) PG_BAR;
    PG_WAIT_V(2); PG_BAR;
    PG_STAGE(PG_SB(1, 0), cB + kstep, voffB); PG_STAGE(PG_SA(1, 0), Ab + kstep, offA[0]); PG_STAGE(PG_SB(1, 1), cB + hstepB + kstep, voffB);
    PG_WAIT_V(6); PG_BAR;
    for (;;) {
        const bool has_next = S.next(ui + 1, nxt);
        const char* nB = has_next ? (const char*)g.Bt + (size_t)nxt.brow * g.ldb * 2 : cB;
        unsigned offN[2][2]; S.a_offs(has_next ? nxt : cur, R0, c2, offN);
#pragma clang loop unroll(disable)
        for (int t = 0; t < nt; t += 2) {
            const bool last = (t == nt - 2);
            const char* a1 = Ab + (size_t)(t + 1) * kstep;
            const char* a2 = last ? Ab : Ab + (size_t)(t + 2) * kstep; const char* b2 = last ? nB : cB + (size_t)(t + 2) * kstep;
            const char* a3 = a2 + kstep; const char* b3 = b2 + kstep;
            PG_LDB(B0, 0, 0); PG_LDB(B1, 0, 1); PG_SCHED; PG_LDA(At, 0, 0); PG_STAGE(PG_SA(1, 1), a1, offA[1]);
#pragma unroll
            for (int h_ = 0; h_ < 2; ++h_)
#pragma unroll
                for (int i_ = 0; i_ < 2; ++i_) offA[h_][i_] = last ? offN[h_][i_] : offA[h_][i_];
            PG_WAIT_V(8); PG_WAIT_L(0); PG_BAR; PG_MMA(0, 0, At, B0); PG_MMA(0, 1, At, B1); PG_BAR; PG_SCHED;
            PG_LDA(At, 0, 1); PG_STAGE(PG_SB(0, 0), b2, voffB); PG_STAGE(PG_SB(0, 1), b2 + hstepB, voffB); PG_STAGE(PG_SA(0, 0), a2, offA[0]);
            PG_WAIT_V(8); PG_WAIT_L(0); PG_BAR; PG_MMA(1, 0, At, B0); PG_MMA(1, 1, At, B1); PG_BAR; PG_SCHED;
            PG_LDB(B0, 1, 0); PG_LDB(B1, 1, 1); PG_SCHED; PG_LDA(At, 1, 0); PG_STAGE(PG_SA(0, 1), a2, offA[1]);
            PG_WAIT_V(8); PG_WAIT_L(0); PG_BAR; PG_MMA(0, 0, At, B0); PG_MMA(0, 1, At, B1); PG_BAR; PG_SCHED;
            PG_LDA(At, 1, 1); PG_STAGE(PG_SB(1, 0), b3, voffB); PG_STAGE(PG_SB(1, 1), b3 + hstepB, voffB); PG_STAGE(PG_SA(1, 0), a3, offA[0]);
            PG_WAIT_V(8); PG_WAIT_L(0); PG_BAR; PG_MMA(1, 0, At, B0); PG_MMA(1, 1, At, B1); PG_BAR; PG_SCHED;
        }
        if constexpr (ALIGN_EPI) { if (wr == 0) PG_BAR; }
        { int fr_e = fr, fq_e = fq; asm volatile("" : "+v"(fr_e), "+v"(fq_e));
          E(acc, cur, wr, wc, fr_e, fq_e); }
        __builtin_amdgcn_s_waitcnt(0x0F70);
        if (!has_next) break;
#pragma unroll
        for (int a = 0; a < 2; ++a)
#pragma unroll
            for (int b = 0; b < 2; ++b)
#pragma unroll
                for (int m = 0; m < 4; ++m)
#pragma unroll
                    for (int n = 0; n < 2; ++n) acc[a][b][m][n] = (f32x4){0.f, 0.f, 0.f, 0.f};
        cur = nxt; cB = nB; ++ui;
        if constexpr (ALIGN_EPI) { if (wr == 1) PG_BAR; }
    }
    PG_WAIT_V(0);
    if constexpr (!ALIGN_EPI) { if (wr == 0) PG_BAR; }
    PG_BAR;
#undef PG_SA
#undef PG_SB
#undef PG_STAGE
#undef PG_LDA
#undef PG_LDB
#undef PG_MMA
#undef PG_WAIT_V
#undef PG_WAIT_L
#undef PG_BAR
#undef PG_SCHED
}
}

typedef GAS unsigned gu32;
#define XB_TMO      128
#define XB_XCNT(j)  (256  + 64 * (j))
#define XB_XSUB(j)  (1280 + 64 * (j))
#define XB_XGEN(j)  (2304 + 64 * (j))
#define XB_TOP      3328
#define XB_TOPGEN   3392
#define XCD_BAR_WORDS 3456
#define XB_SPIN_CAP (1u << 18)
__device__ __forceinline__ unsigned xb_ld(unsigned* p)              { return __hip_atomic_load(p, __ATOMIC_RELAXED, __HIP_MEMORY_SCOPE_AGENT); }
__device__ __forceinline__ unsigned xb_add(unsigned* p, unsigned v) { return __hip_atomic_fetch_add(p, v, __ATOMIC_RELAXED, __HIP_MEMORY_SCOPE_AGENT); }
__device__ __forceinline__ unsigned xb_xcc_id() { return (unsigned)__builtin_amdgcn_s_getreg((3 << 11) | 20) & 0xFu; }
#define XB_SPIN(cond, bar) do { unsigned _sp = 0; while (cond) { __builtin_amdgcn_s_sleep(1); \
    if ((++_sp & 255u) == 0u) { if (xb_ld(&(bar)[XB_TMO])) break; if (_sp > XB_SPIN_CAP) { atomicAdd(&(bar)[XB_TMO], 1u); break; } } } } while (0)
struct XcdBarrier { unsigned* bar; unsigned x; volatile LAS unsigned* st; };
__device__ __forceinline__ XcdBarrier xcd_barrier_post(unsigned* bar, volatile LAS unsigned* st) {
    XcdBarrier b; b.bar = bar; b.x = xb_xcc_id(); b.st = st;
    if (threadIdx.x == 0) (void)xb_add(&bar[XB_XCNT(b.x)], 1u);
    return b;
}
__device__ __forceinline__ void xcd_barrier_complete(unsigned* bar, unsigned x, unsigned& nloc, unsigned& nx) {
    const unsigned G = gridDim.x * gridDim.y * gridDim.z;
    unsigned sum, cnt, mine, sp = 0u;
    for (;;) {
        sum = 0u; cnt = 0u; mine = 0u;
#pragma unroll
        for (unsigned j = 0; j < 16; ++j) { const unsigned c = xb_ld(&bar[XB_XCNT(j)]); sum += c; cnt += (c > 0u) ? 1u : 0u; mine = (j == x) ? c : mine; }
        if (sum == G) break;
        __builtin_amdgcn_s_sleep(1);
        if ((++sp & 255u) == 0u) { if (xb_ld(&bar[XB_TMO])) break; if (sp > XB_SPIN_CAP) { atomicAdd(&bar[XB_TMO], 1u); break; } }
    }
    nloc = mine > 0u ? mine : 1u; nx = cnt > 0u ? cnt : 1u;
}
__device__ __forceinline__ void xcd_barrier(const XcdBarrier& b) {
    asm volatile("s_waitcnt vmcnt(0)" ::: "memory");
    __syncthreads();
    if (threadIdx.x == 0) {
        unsigned* bar = b.bar;
        __builtin_amdgcn_s_waitcnt(0);
        unsigned nloc = b.st[0], nx = b.st[1];
        if (nloc == 0u) { xcd_barrier_complete(bar, b.x, nloc, nx); b.st[0] = nloc; b.st[1] = nx; }
        const unsigned old = xb_add(&bar[XB_XSUB(b.x)], 1u);
        const unsigned gen = old / nloc;
        if (old + 1u == (gen + 1u) * nloc) {
            __builtin_amdgcn_fence(__ATOMIC_RELEASE, "agent");
            asm volatile("s_waitcnt vmcnt(0)" ::: "memory");
            const unsigned og = xb_add(&bar[XB_TOP], 1u);
            const unsigned tg = og / nx;
            if (og + 1u == (tg + 1u) * nx) xb_add(&bar[XB_TOPGEN], 1u);
            else XB_SPIN(xb_ld(&bar[XB_TOPGEN]) == tg, bar);
            __builtin_amdgcn_fence(__ATOMIC_ACQUIRE, "agent");
            xb_add(&bar[XB_XGEN(b.x)], 1u);
            asm volatile("s_waitcnt vmcnt(0)" ::: "memory");
        } else {
            XB_SPIN(xb_ld(&bar[XB_XGEN(b.x)]) == gen, bar);
            __builtin_amdgcn_fence(__ATOMIC_ACQUIRE, "agent");
            asm volatile("s_waitcnt vmcnt(0)" ::: "memory");
        }
    }
    __syncthreads();
}
constexpr int NWAVES = 8;
constexpr size_t MiB = 1u << 20;
constexpr int LDS_BYTES = 147456;
constexpr int RING_BYTES = 131072;
constexpr int TAB_OFF = RING_BYTES;
constexpr int TAB_BYTES = 12288;
constexpr int MISC_OFF = TAB_OFF + TAB_BYTES;
constexpr size_t WS_CTL = 0;
constexpr size_t CTL_ZERO_BYTES = 64 * 1024;
constexpr int CW_BAR = 1024;
constexpr int CW_CNT = 8192;
constexpr size_t WS_SSP = 1 * MiB;
constexpr size_t WS_SSP1 = 6 * MiB + 512 * 1024;
constexpr size_t WS_RSTD = 2 * MiB;
constexpr size_t WS_LSLOT = 2 * MiB + 256 * 1024;
constexpr size_t WS_LW = WS_LSLOT + 2 * MiB;
constexpr size_t WS_WSM = 8 * MiB;
constexpr size_t OFF_WINA = 0, OFF_WOUTA = 6 * MiB, OFF_WINB = 8 * MiB, OFF_WGATE = 12 * MiB, OFF_WOUTB = 14 * MiB, OFF_WPLEG = 16 * MiB, OFF_WPLE = 20 * MiB;
constexpr size_t WS_WMOE = 30 * MiB;
constexpr size_t WS_HB = 222 * MiB;
constexpr size_t WS_PW = 254 * MiB;
constexpr size_t WS_PB = 286 * MiB;
constexpr size_t WS_R0 = 302 * MiB, RSZ = 32 * MiB;
constexpr size_t WS_END = WS_R0 + 6 * RSZ + 28 * MiB;
#define WS_R(i) (WS_R0 + (size_t)(i) * RSZ)

#define RLX_AGENT __ATOMIC_RELAXED, __HIP_MEMORY_SCOPE_AGENT
#define LDS_WAIT() asm volatile("s_waitcnt lgkmcnt(0)" ::: "memory")
#define VM_WAIT() asm volatile("s_waitcnt vmcnt(0)" ::: "memory")
__device__ __forceinline__ unsigned pk2(float lo, float hi) { return pg::cvt_pk_bf16(lo, hi); }
__device__ __forceinline__ float bf_lo(unsigned w) { return (float)__builtin_bit_cast(half2v, w).x; }
__device__ __forceinline__ float bf_hi(unsigned w) { return (float)__builtin_bit_cast(half2v, w).y; }
__device__ __forceinline__ float wave_sum(float v) {
#pragma unroll
    for (int o = 1; o < 64; o <<= 1) v += __shfl_xor(v, o);
    return v;
}
__device__ __forceinline__ float fsigm(float x) { return __builtin_amdgcn_rcpf(1.0f + __builtin_amdgcn_exp2f(-1.4426950408889634f * x)); }

__device__ __forceinline__ int map_lin8(int c) { const int q = c & 31; return (c & ~31) + 16 * ((q >> 2) & 1) + 4 * (q >> 3) + (q & 3); }
__device__ __forceinline__ int map_pair(int ch, int type) { return 256 * (ch >> 7) + 128 * ((ch >> 6) & 1) + 32 * ((ch >> 4) & 3) + 16 * type + (ch & 15); }

struct Args { const float* in[28]; float* out; unsigned char* ws; int ph_lo, ph_hi; };

struct Frame {
    LAS unsigned char* lds;
    volatile LAS unsigned* MISC;
    int tid, lane, wave, vcu, G;
};

struct PrepJob { const float* W; int ldw, K, ncols, nbatch; size_t sbs; const float* gain; bf16_t* dst; size_t dbs; int mode, type; };
__device__ __forceinline__ void prep_item(const PrepJob& J, LAS float* scr, int item, int lane) {
    const int nblk = J.ncols / 32, per = (J.K / 64) * nblk, b = item / per, r = item % per, kb = r / nblk, nb = r % nblk, k0 = 64 * kb, n0 = 32 * nb;
    const float* W = J.W + (size_t)b * J.sbs; bf16_t* WT = J.dst + (size_t)b * J.dbs;
#pragma unroll 8
    for (int i = 0; i < 32; ++i) { const int kk = 2 * i + (lane >> 5); float v = W[(size_t)(k0 + kk) * J.ldw + n0 + (lane & 31)]; if (J.gain) v *= J.gain[k0 + kk]; scr[kk * 33 + (lane & 31)] = v; }
    LDS_WAIT(); asm volatile("" ::: "memory");
    const int c = lane & 7;
#pragma unroll
    for (int j = 0; j < 4; ++j) { const int n = (lane >> 3) + 8 * j; const LAS float* s = scr + (8 * c) * 33 + n;
        u32x4 o; o.x = pk2(s[0 * 33], s[1 * 33]); o.y = pk2(s[2 * 33], s[3 * 33]); o.z = pk2(s[4 * 33], s[5 * 33]); o.w = pk2(s[6 * 33], s[7 * 33]);
        const int col = n0 + n; const int drow = (J.mode == 0) ? map_lin8(col) : map_pair(col, J.type);
        *(GAS u32x4*)(WT + (size_t)drow * J.K + k0 + 8 * c) = o; }
    LDS_WAIT(); asm volatile("" ::: "memory");
}
__device__ __forceinline__ bool prep_job(const Args& a, int j, PrepJob& J) {
    unsigned char* ws = a.ws; bf16_t* wsm = (bf16_t*)(ws + WS_WSM);
    const float* norm_mix = a.in[2]; const float* norm_ffn = a.in[15]; const float* norm_ple = a.in[23];
    J.sbs = 0; J.dbs = 0; J.nbatch = 1; J.gain = nullptr; J.type = 0; J.mode = 0;
    switch (j) {
    case 0: J = PrepJob{a.in[3], 3 * D, D, D, 1, 0, norm_mix, wsm + OFF_WINA / 2 + (size_t)2048 * D, 0, 0, 0}; return true;
    case 1: J = PrepJob{a.in[3] + D, 3 * D, D, D, 1, 0, norm_mix, wsm + OFF_WINA / 2, 0, 1, 0}; return true;
    case 2: J = PrepJob{a.in[3] + 2 * D, 3 * D, D, D, 1, 0, norm_mix, wsm + OFF_WINA / 2, 0, 1, 1}; return true;
    case 3: J = PrepJob{a.in[5], D, D, D, 1, 0, nullptr, wsm + OFF_WOUTA / 2, 0, 0, 0}; return true;
    case 4: J = PrepJob{a.in[6], 2 * D, D, 2 * D, 1, 0, norm_mix + D, wsm + OFF_WINB / 2, 0, 0, 0}; return true;
    case 5: J = PrepJob{a.in[9], 256, 256, 256, 8, (size_t)256 * 256, nullptr, wsm + OFF_WGATE / 2, (size_t)512 * 256, 1, 0}; return true;
    case 6: J = PrepJob{a.in[11], 256, 256, 256, 8, (size_t)256 * 256, nullptr, wsm + OFF_WGATE / 2, (size_t)512 * 256, 1, 1}; return true;
    case 7: J = PrepJob{a.in[14], D, D, D, 1, 0, nullptr, wsm + OFF_WOUTB / 2, 0, 0, 0}; return true;
    case 8: J = PrepJob{a.in[25], D, D, D, 1, 0, norm_ple, wsm + OFF_WPLEG / 2, 0, 0, 0}; return true;
    case 9: J = PrepJob{a.in[25] + (size_t)D * D, D, D, D, 1, 0, norm_ple + D, wsm + OFF_WPLEG / 2 + (size_t)D * D, 0, 0, 0}; return true;
    case 10: J = PrepJob{a.in[24], D, 256, D, 2, (size_t)256 * D, nullptr, wsm + OFF_WPLE / 2, (size_t)D * 256, 0, 0}; return true;
    case 11: case 12: { const int L = j - 11; bf16_t* base = (bf16_t*)(ws + WS_WMOE + (size_t)L * 96 * MiB);
        J = PrepJob{a.in[20] + (size_t)L * 32 * D * 512, 512, D, 512, 32, (size_t)D * 512, norm_ffn + L * D, base, (size_t)1024 * D, 1, 0}; return true; }
    case 13: case 14: { const int L = j - 13; bf16_t* base = (bf16_t*)(ws + WS_WMOE + (size_t)L * 96 * MiB);
        J = PrepJob{a.in[21] + (size_t)L * 32 * D * 512, 512, D, 512, 32, (size_t)D * 512, norm_ffn + L * D, base, (size_t)1024 * D, 1, 1}; return true; }
    case 15: case 16: { const int L = j - 15; bf16_t* base = (bf16_t*)(ws + WS_WMOE + (size_t)L * 96 * MiB + 64 * MiB);
        J = PrepJob{a.in[22] + (size_t)L * 32 * 512 * D, D, 512, D, 32, (size_t)512 * D, nullptr, base, (size_t)1024 * 512, 0, 0}; return true; }
    default: return false;
    }
}
constexpr int N_PREP_JOBS = 17;
__device__ __forceinline__ void p0_prologue(Frame& F, const Args& a, int job_lo, int job_hi) {
    LAS float* scr = (LAS float*)(F.lds + F.wave * 16384);
    const int gw = F.vcu * NWAVES + F.wave, NGW = F.G * NWAVES;
    for (int j = job_lo; j < job_hi; ++j) {
        PrepJob J; if (!prep_job(a, j, J)) break;
        const int items = J.nbatch * (J.K / 64) * (J.ncols / 32);
        for (int it = gw; it < items; it += NGW) prep_item(J, scr, it, F.lane);
    }
    const float* x = a.in[0]; bf16_t* xb = (bf16_t*)(a.ws + WS_R(0)); float* rstd = (float*)(a.ws + WS_RSTD);
    for (int m = gw; m < NTOK; m += NGW) {
        const GAS f32x4* xr = (const GAS f32x4*)(x + (size_t)m * D) + F.lane;
        f32x4 v[4]; float s = 0.f;
#pragma unroll
        for (int j = 0; j < 4; ++j) { v[j] = xr[64 * j]; s += (v[j].x * v[j].x + v[j].y * v[j].y) + (v[j].z * v[j].z + v[j].w * v[j].w); }
        s = wave_sum(s);
        GAS u32x2* o8 = (GAS u32x2*)(xb + (size_t)m * D) + F.lane;
#pragma unroll
        for (int j = 0; j < 4; ++j) { u32x2 w; w.x = pk2(v[j].x, v[j].y); w.y = pk2(v[j].z, v[j].w); o8[64 * j] = w; }
        if (F.lane == 0) rstd[m] = 1.0f / sqrtf(s * (1.0f / D) + EPS);
    }
    const GAS f32x4* p4 = (const GAS f32x4*)a.in[1]; GAS u32x2* pb = (GAS u32x2*)(a.ws + WS_PB);
    const size_t n4 = (size_t)2 * NTOK * 256 / 4;
    for (size_t i = (size_t)gw * 64 + F.lane; i < n4; i += (size_t)NGW * 64) { const f32x4 v = p4[i]; u32x2 w; w.x = pk2(v.x, v.y); w.y = pk2(v.z, v.w); pb[i] = w; }
}

struct DenseSched {
    pg::DenseOrder O; int lda2;
    __device__ void init(int nN, int G, int c, int lda) { O.init(NTOK / 256, nN, G, c); lda2 = lda * 2; }
    __device__ bool next(int i, pg::Unit& u) const { int pm, pn; if (!O.tile(i, pm, pn)) return false; u.arow = pm * 256; u.acol = 0; u.brow = pn * 256; u.orow = pm * 256; u.pn = pn; u.aux = 0; return true; }
    __device__ __forceinline__ void a_offs(const pg::Unit& u, int R0, unsigned c2, unsigned (&o)[2][2]) const {
#pragma unroll
        for (int h = 0; h < 2; ++h)
#pragma unroll
            for (int i = 0; i < 2; ++i) o[h][i] = (unsigned)(u.arow + h * 128 + i * 64 + R0) * (unsigned)lda2 + (unsigned)u.acol * 2u + c2;
    }
};

struct EpiInA {
    bf16_t* G; bf16_t* Bg; const float* rstd;
    __device__ __forceinline__ void operator()(const f32x4 (&acc)[2][2][4][2], const pg::Unit& u, int wr, int wc, int fr, int fq) const {
        const int row0 = u.orow + wr * 64 + fr;
        if (u.pn < 8) {
            const int col0 = u.pn * 128 + wc * 16 + fq * 4;
#pragma unroll
            for (int ai = 0; ai < 2; ++ai)
#pragma unroll
                for (int m = 0; m < 4; ++m) { const int row = row0 + ai * 128 + m * 16; const float s = rstd[row]; const float s2 = s * s;
#pragma unroll
                    for (int bj = 0; bj < 2; ++bj) { const f32x4 c = acc[ai][bj][m][0], h = acc[ai][bj][m][1];
                        u32x2 w; w.x = pg::cvt_pk_bf16(c[0] * h[0] * s2, c[1] * h[1] * s2); w.y = pg::cvt_pk_bf16(c[2] * h[2] * s2, c[3] * h[3] * s2);
                        *(u32x2*)(G + (size_t)row * D + col0 + bj * 64) = w; } }
        } else {
            const int col0 = (u.pn - 8) * 256 + wc * 32 + fq * 8;
#pragma unroll
            for (int ai = 0; ai < 2; ++ai)
#pragma unroll
                for (int m = 0; m < 4; ++m) { const int row = row0 + ai * 128 + m * 16; const float s = rstd[row];
#pragma unroll
                    for (int bj = 0; bj < 2; ++bj) { const f32x4 v0 = acc[ai][bj][m][0] * s, v1 = acc[ai][bj][m][1] * s;
                        u32x4 w; w.x = pg::cvt_pk_bf16(v0[0], v0[1]); w.y = pg::cvt_pk_bf16(v0[2], v0[3]); w.z = pg::cvt_pk_bf16(v1[0], v1[1]); w.w = pg::cvt_pk_bf16(v1[2], v1[3]);
                        *(u32x4*)(Bg + (size_t)row * D + col0 + bj * 128) = w; } }
        }
    }
};

struct EpiResid {
    const float* resid; float* Hf; bf16_t* Hb; float* ssp;
    __device__ __forceinline__ void operator()(const f32x4 (&acc)[2][2][4][2], const pg::Unit& u, int wr, int wc, int fr, int fq) const {
        const int row0 = u.orow + wr * 64 + fr, col0 = u.pn * 256 + wc * 32 + fq * 8;
#pragma unroll
        for (int ai = 0; ai < 2; ++ai)
#pragma unroll
            for (int m = 0; m < 4; ++m) { const int row = row0 + ai * 128 + m * 16; const size_t off = (size_t)row * D + col0; float ss = 0.f;
#pragma unroll
                for (int bj = 0; bj < 2; ++bj) {
                    const f32x4 r0 = *(const f32x4*)(resid + off + bj * 128), r1 = *(const f32x4*)(resid + off + bj * 128 + 4);
                    const f32x4 v0 = acc[ai][bj][m][0] + r0, v1 = acc[ai][bj][m][1] + r1;
                    ss += (v0[0] * v0[0] + v0[1] * v0[1]) + (v0[2] * v0[2] + v0[3] * v0[3]) + (v1[0] * v1[0] + v1[1] * v1[1]) + (v1[2] * v1[2] + v1[3] * v1[3]);
                    *(f32x4*)(Hf + off + bj * 128) = v0; *(f32x4*)(Hf + off + bj * 128 + 4) = v1;
                    u32x4 w; w.x = pk2(v0[0], v0[1]); w.y = pk2(v0[2], v0[3]); w.z = pk2(v1[0], v1[1]); w.w = pk2(v1[2], v1[3]);
                    *(u32x4*)(Hb + off + bj * 128) = w; }
                ss += __shfl_xor(ss, 16); ss += __shfl_xor(ss, 32);
                if (fq == 0) ssp[(size_t)row * 16 + u.pn * 4 + wc] = ss; }
    }
};

__device__ __forceinline__ void unpack8(const u32x4 w, float (&f)[8]) { f[0] = bf_lo(w.x); f[1] = bf_hi(w.x); f[2] = bf_lo(w.y); f[3] = bf_hi(w.y); f[4] = bf_lo(w.z); f[5] = bf_hi(w.z); f[6] = bf_lo(w.w); f[7] = bf_hi(w.w); }
__device__ __forceinline__ u32x4 pack8(const float (&f)[8]) { u32x4 w; w.x = pk2(f[0], f[1]); w.y = pk2(f[2], f[3]); w.z = pk2(f[4], f[5]); w.w = pk2(f[6], f[7]); return w; }
__device__ __forceinline__ void p2_conv_a(Frame& F, const bf16_t* G, const bf16_t* Bg, const float* cw, bf16_t* A2) {
    const int gw = F.vcu * NWAVES + F.wave, NGW = F.G * NWAVES;
    for (int it = gw; it < 2048; it += NGW) {
        const int r0 = (it >> 1) * 16, c0 = (it & 1) * 512 + F.lane * 8, t0 = r0 % SEQ;
        float w0[8], w1[8], w2[8];
#pragma unroll
        for (int j = 0; j < 8; ++j) { w0[j] = cw[c0 + j]; w1[j] = cw[D + c0 + j]; w2[j] = cw[2 * D + c0 + j]; }
        const bf16_t* gp = G + (size_t)r0 * D + c0; const bf16_t* bp = Bg + (size_t)r0 * D + c0; bf16_t* op = A2 + (size_t)r0 * D + c0;
        float gm[8], gc[8], gn[8];
        if (t0 > 0) unpack8(*(const GAS u32x4*)(gp - D), gm); else {
#pragma unroll
            for (int j = 0; j < 8; ++j) gm[j] = 0.f; }
        unpack8(*(const GAS u32x4*)gp, gc);
#pragma unroll 4
        for (int r = 0; r < 16; ++r) {
            if (t0 + r + 1 < SEQ) unpack8(*(const GAS u32x4*)(gp + (size_t)(r + 1) * D), gn); else {
#pragma unroll
                for (int j = 0; j < 8; ++j) gn[j] = 0.f; }
            float b[8], o[8]; unpack8(*(const GAS u32x4*)(bp + (size_t)r * D), b);
#pragma unroll
            for (int j = 0; j < 8; ++j) { o[j] = b[j] * (w0[j] * gm[j] + w1[j] * gc[j] + w2[j] * gn[j]); gm[j] = gc[j]; gc[j] = gn[j]; }
            *(GAS u32x4*)(op + (size_t)r * D) = pack8(o);
        }
    }
}

__device__ __forceinline__ void p4_router(Frame& F, const float* Hf, const float* gain, const float* wg, const float* bg, const float* we, const float* be,
                                          unsigned* gcnt, int* lslot, float* lw, float* rstd_out) {
    LAS float* sL = (LAS float*)F.lds + F.wave * 40;
    LAS int* s_e = (LAS int*)(F.lds + 2048); LAS float* s_w = (LAS float*)(F.lds + 2560); LAS int* s_rank = (LAS int*)(F.lds + 3072);
    LAS unsigned* lcnt = (LAS unsigned*)(F.lds + 3584); LAS unsigned* lbase = (LAS unsigned*)(F.lds + 3712);
    for (int blk = F.vcu; blk < NTOK / 64; blk += F.G) {
        if (F.tid < 32) lcnt[F.tid] = 0u;
        __syncthreads();
        for (int q = 0; q < 8; ++q) {
            const int ts = F.wave * 8 + q, tok = blk * 64 + ts;
            float acc[36]; float ss = 0.f;
#pragma unroll
            for (int j = 0; j < 36; ++j) acc[j] = 0.f;
#pragma unroll 2
            for (int i = 0; i < 16; ++i) {
                const int k = F.lane + 64 * i; const float x = Hf[(size_t)tok * D + k]; ss += x * x; const float xg = x * gain[k];
                const f32x4 g4 = *(const f32x4*)(wg + (size_t)k * 4);
                acc[0] += xg * g4[0]; acc[1] += xg * g4[1]; acc[2] += xg * g4[2]; acc[3] += xg * g4[3];
#pragma unroll
                for (int jj = 0; jj < 8; ++jj) { const f32x4 e4 = *(const f32x4*)(we + (size_t)k * 32 + 4 * jj);
                    acc[4 + 4 * jj] += xg * e4[0]; acc[5 + 4 * jj] += xg * e4[1]; acc[6 + 4 * jj] += xg * e4[2]; acc[7 + 4 * jj] += xg * e4[3]; }
            }
            ss = wave_sum(ss); const float rs = 1.0f / sqrtf(ss * (1.0f / D) + EPS);
#pragma unroll
            for (int j = 0; j < 36; ++j) acc[j] = wave_sum(acc[j]);
            if (F.lane == 0) {
#pragma unroll
                for (int j = 0; j < 4; ++j) sL[j] = acc[j] * rs + bg[j];
#pragma unroll
                for (int j = 0; j < 32; ++j) sL[4 + j] = acc[4 + j] * rs + be[j];
                int g = 0;
                for (int j = 1; j < 4; ++j) if (sL[j] > sL[g]) g = j;
                float sg = 0.f; for (int j = 0; j < 4; ++j) sg += expf(sL[j] - sL[g]);
                const float pgt = 1.0f / sg;
                LAS float* le = sL + 4 + g * 8;
                int i0 = 0; for (int i = 1; i < 8; ++i) if (le[i] > le[i0]) i0 = i;
                int i1 = (i0 == 0) ? 1 : 0; for (int i = 0; i < 8; ++i) if (i != i0 && le[i] > le[i1]) i1 = i;
                const float e1 = expf(le[i1] - le[i0]); const float w0 = 1.0f / (1.0f + e1), w1 = e1 / (1.0f + e1);
                const int E0 = g * 8 + i0, E1 = g * 8 + i1;
                s_e[2 * ts] = E0; s_e[2 * ts + 1] = E1; s_w[2 * ts] = pgt * w0; s_w[2 * ts + 1] = pgt * w1;
                s_rank[2 * ts] = (int)__hip_atomic_fetch_add(&lcnt[E0], 1u, __ATOMIC_RELAXED, __HIP_MEMORY_SCOPE_WORKGROUP);
                s_rank[2 * ts + 1] = (int)__hip_atomic_fetch_add(&lcnt[E1], 1u, __ATOMIC_RELAXED, __HIP_MEMORY_SCOPE_WORKGROUP);
                rstd_out[tok] = rs;
            }
        }
        __syncthreads();
        if (F.tid < 32) lbase[F.tid] = __hip_atomic_fetch_add(gcnt + F.tid, lcnt[F.tid], __ATOMIC_RELAXED, __HIP_MEMORY_SCOPE_AGENT);
        __syncthreads();
        if (F.tid < 128) { const int s = F.tid, E = s_e[s]; const unsigned pos = lbase[E] + (unsigned)s_rank[s]; const int tok = blk * 64 + (s >> 1);
            lslot[(size_t)E * CAP + pos] = 2 * tok + (s & 1); lw[(size_t)E * CAP + pos] = s_w[s]; }
        __syncthreads();
    }
}

constexpr int MAXU = 5;
struct MoeSched {
    LAS int* ud; int n; const LAS unsigned* tabA; int mode; int lda2;
    __device__ bool next(int i, pg::Unit& u) const { if (i >= n) return false; const int e = ud[4 * i], pn = ud[4 * i + 2], rbg = ud[4 * i + 3];
        u.arow = mode == 0 ? i * 256 : rbg * 256; u.acol = 0; u.brow = e * 1024 + pn * 256; u.orow = rbg * 256; u.pn = pn; u.aux = i; return true; }
    __device__ __forceinline__ void a_offs(const pg::Unit& u, int R0, unsigned c2, unsigned (&o)[2][2]) const {
#pragma unroll
        for (int h = 0; h < 2; ++h)
#pragma unroll
            for (int i = 0; i < 2; ++i) { const int r = h * 128 + i * 64 + R0;
                o[h][i] = (mode == 0 ? tabA[u.arow + r] : (unsigned)(u.arow + r) * (unsigned)lda2) + c2; }
    }
};
__device__ __forceinline__ int moe_setup(Frame& F, const unsigned* gcnt, const int* lslot, const float* lw, const float* rstd, int which) {
    LAS int* ud = (LAS int*)(F.lds + TAB_OFF); LAS unsigned* tabA = (LAS unsigned*)(F.lds + TAB_OFF + 128); LAS unsigned* tabB = (LAS unsigned*)(F.lds + TAB_OFF + 128 + MAXU * 1024);
    __syncthreads();
    if (F.tid == 0) {
        int n = 0, rbg = 0; const int c = F.vcu;
        for (int e = 0; e < NEXP; ++e) { const int nrb = ((int)gcnt[e] + 255) >> 8;
            for (int rb = 0; rb < nrb; ++rb, ++rbg)
                for (int pn = 0; pn < 4; ++pn) { const int L = 4 * rbg + pn; if ((L % F.G) == c && n < MAXU) { ud[4 * n] = e; ud[4 * n + 1] = rb; ud[4 * n + 2] = pn; ud[4 * n + 3] = rbg; ++n; } } }
        ud[4 * MAXU] = n;
    }
    __syncthreads();
    const int n = ud[4 * MAXU];
    for (int i = 0; i < n; ++i) {
        if (F.tid < 256) { const int e = ud[4 * i], rb = ud[4 * i + 1], idx = rb * 256 + F.tid; const bool ok = idx < (int)gcnt[e];
            const int slot = ok ? lslot[(size_t)e * CAP + idx] : 0;
            if (which == 0) { tabA[i * 256 + F.tid] = (unsigned)(slot >> 1) * (unsigned)(D * 2); tabB[i * 256 + F.tid] = __builtin_bit_cast(unsigned, rstd[slot >> 1]); }
            else { tabA[i * 256 + F.tid] = ok ? (unsigned)slot : 0xffffffffu; tabB[i * 256 + F.tid] = ok ? __builtin_bit_cast(unsigned, lw[(size_t)e * CAP + idx]) : 0u; } }
    }
    VM_WAIT(); LDS_WAIT();
    __syncthreads();
    return n;
}
struct EpiUp {
    bf16_t* HID; const LAS unsigned* tabB;
    __device__ __forceinline__ void operator()(const f32x4 (&acc)[2][2][4][2], const pg::Unit& u, int wr, int wc, int fr, int fq) const {
        const int r0 = wr * 64 + fr, col0 = u.pn * 128 + wc * 16 + fq * 4;
#pragma unroll
        for (int ai = 0; ai < 2; ++ai)
#pragma unroll
            for (int m = 0; m < 4; ++m) { const int r = r0 + ai * 128 + m * 16; const float s = __builtin_bit_cast(float, tabB[u.aux * 256 + r]);
#pragma unroll
                for (int bj = 0; bj < 2; ++bj) { const f32x4 g = acc[ai][bj][m][0] * s, v = acc[ai][bj][m][1] * s; float o[4];
#pragma unroll
                    for (int j = 0; j < 4; ++j) o[j] = g[j] * fsigm(g[j]) * v[j];
                    u32x2 w; w.x = pk2(o[0], o[1]); w.y = pk2(o[2], o[3]);
                    *(u32x2*)(HID + (size_t)(u.orow + r) * FEXP + col0 + bj * 64) = w; } }
    }
};
struct EpiDown {
    bf16_t* Y; const LAS unsigned* tabA; const LAS unsigned* tabB;
    __device__ __forceinline__ void operator()(const f32x4 (&acc)[2][2][4][2], const pg::Unit& u, int wr, int wc, int fr, int fq) const {
        const int r0 = wr * 64 + fr, col0 = u.pn * 256 + wc * 32 + fq * 8;
#pragma unroll
        for (int ai = 0; ai < 2; ++ai)
#pragma unroll
            for (int m = 0; m < 4; ++m) { const int r = r0 + ai * 128 + m * 16; const unsigned slot = tabA[u.aux * 256 + r]; const float w = __builtin_bit_cast(float, tabB[u.aux * 256 + r]);
                if (slot != 0xffffffffu) {
#pragma unroll
                    for (int bj = 0; bj < 2; ++bj) { const f32x4 v0 = acc[ai][bj][m][0] * w, v1 = acc[ai][bj][m][1] * w;
                        u32x4 o; o.x = pk2(v0[0], v0[1]); o.y = pk2(v0[2], v0[3]); o.z = pk2(v1[0], v1[1]); o.w = pk2(v1[2], v1[3]);
                        *(u32x4*)(Y + (size_t)slot * D + col0 + bj * 128) = o; } } }
    }
};
__device__ __forceinline__ void p7_combine(Frame& F, float* Hf, bf16_t* Hb, const bf16_t* Y, float* ssp) {
    DenseSched S; S.init(4, F.G, (int)blockIdx.x, D);
    pg::Unit u;
    for (int i = 0; S.next(i, u); ++i) {
        for (int rr = F.wave; rr < 256; rr += NWAVES) {
            const int row = u.orow + rr, col = u.pn * 256 + F.lane * 4; const size_t off = (size_t)row * D + col;
            f32x4 h = *(const GAS f32x4*)(Hf + off);
            const u32x2 y0 = *(const GAS u32x2*)(Y + (size_t)(2 * row) * D + col), y1 = *(const GAS u32x2*)(Y + (size_t)(2 * row + 1) * D + col);
            h[0] += bf_lo(y0.x) + bf_lo(y1.x); h[1] += bf_hi(y0.x) + bf_hi(y1.x); h[2] += bf_lo(y0.y) + bf_lo(y1.y); h[3] += bf_hi(y0.y) + bf_hi(y1.y);
            *(GAS f32x4*)(Hf + off) = h;
            u32x2 w; w.x = pk2(h[0], h[1]); w.y = pk2(h[2], h[3]); *(GAS u32x2*)(Hb + off) = w;
            const float ss = wave_sum((h[0] * h[0] + h[1] * h[1]) + (h[2] * h[2] + h[3] * h[3]));
            if (F.lane < 4) ssp[(size_t)row * 16 + u.pn * 4 + F.lane] = F.lane == 0 ? ss : 0.f;
        }
    }
}

__device__ __forceinline__ float row_rstd(const float* ssp, int row) {
    const f32x4* p = (const f32x4*)(ssp + (size_t)row * 16); const f32x4 a = p[0], b = p[1], c = p[2], d = p[3];
    const float ss = ((a[0] + a[1]) + (a[2] + a[3])) + ((b[0] + b[1]) + (b[2] + b[3])) + ((c[0] + c[1]) + (c[2] + c[3])) + ((d[0] + d[1]) + (d[2] + d[3]));
    return 1.0f / sqrtf(ss * (1.0f / D) + EPS);
}
__device__ __forceinline__ float gelu_t(float x) {
    const float z = 1.5957691216057308f * (x + 0.044715f * x * x * x); return x * fsigm(z);
}
struct EpiLin {
    bf16_t* O0; bf16_t* O1; int split, act0, act1; const float* ssp;
    __device__ __forceinline__ void operator()(const f32x4 (&acc)[2][2][4][2], const pg::Unit& u, int wr, int wc, int fr, int fq) const {
        const bool first = u.pn < split; bf16_t* O = first ? O0 : O1; const int act = first ? act0 : act1;
        const int row0 = u.orow + wr * 64 + fr, col0 = (first ? u.pn : u.pn - split) * 256 + wc * 32 + fq * 8;
#pragma unroll
        for (int ai = 0; ai < 2; ++ai)
#pragma unroll
            for (int m = 0; m < 4; ++m) { const int row = row0 + ai * 128 + m * 16; const float s = ssp ? row_rstd(ssp, row) : 1.0f;
#pragma unroll
                for (int bj = 0; bj < 2; ++bj) { f32x4 v0 = acc[ai][bj][m][0] * s, v1 = acc[ai][bj][m][1] * s;
                    if (act == 1) {
#pragma unroll
                        for (int j = 0; j < 4; ++j) { v0[j] = gelu_t(v0[j]); v1[j] = gelu_t(v1[j]); } }
                    u32x4 w; w.x = pk2(v0[0], v0[1]); w.y = pk2(v0[2], v0[3]); w.z = pk2(v1[0], v1[1]); w.w = pk2(v1[2], v1[3]);
                    *(u32x4*)(O + (size_t)row * D + col0 + bj * 128) = w; }
                asm volatile("" ::: "memory"); __builtin_amdgcn_sched_barrier(0); }
    }
};
struct EpiPle {
    float* Hf; bf16_t* Hb; const float* ssp; float* ssp_out; const bf16_t* PW; const float* bias;
    __device__ __forceinline__ void operator()(const f32x4 (&acc)[2][2][4][2], const pg::Unit& u, int wr, int wc, int fr, int fq) const {
        const int row0 = u.orow + wr * 64 + fr, col0 = u.pn * 256 + wc * 32 + fq * 8;
        f32x4 bv[2][2];
#pragma unroll
        for (int bj = 0; bj < 2; ++bj) { bv[bj][0] = *(const f32x4*)(bias + col0 + bj * 128); bv[bj][1] = *(const f32x4*)(bias + col0 + bj * 128 + 4); }
#pragma unroll
        for (int ai = 0; ai < 2; ++ai)
#pragma unroll
            for (int m = 0; m < 4; ++m) { const int row = row0 + ai * 128 + m * 16; const size_t off = (size_t)row * D + col0; const float s = row_rstd(ssp, row); float ss = 0.f;
#pragma unroll
                for (int bj = 0; bj < 2; ++bj) {
                    f32x4 h0 = *(const f32x4*)(Hf + off + bj * 128), h1 = *(const f32x4*)(Hf + off + bj * 128 + 4);
                    const u32x4 pw = *(const u32x4*)(PW + off + bj * 128); float pf[8]; unpack8(pw, pf);
                    const f32x4 a0 = acc[ai][bj][m][0] * s + bv[bj][0], a1 = acc[ai][bj][m][1] * s + bv[bj][1];
#pragma unroll
                    for (int j = 0; j < 4; ++j) { h0[j] += fsigm(a0[j]) * pf[j]; h1[j] += fsigm(a1[j]) * pf[4 + j]; }
                    ss += (h0[0] * h0[0] + h0[1] * h0[1]) + (h0[2] * h0[2] + h0[3] * h0[3]) + (h1[0] * h1[0] + h1[1] * h1[1]) + (h1[2] * h1[2] + h1[3] * h1[3]);
                    *(f32x4*)(Hf + off + bj * 128) = h0; *(f32x4*)(Hf + off + bj * 128 + 4) = h1;
                    u32x4 w; w.x = pk2(h0[0], h0[1]); w.y = pk2(h0[2], h0[3]); w.z = pk2(h1[0], h1[1]); w.w = pk2(h1[2], h1[3]);
                    *(u32x4*)(Hb + off + bj * 128) = w; }
                ss += __shfl_xor(ss, 16); ss += __shfl_xor(ss, 32);
                if (fq == 0) ssp_out[(size_t)row * 16 + u.pn * 4 + wc] = ss;
                asm volatile("" ::: "memory"); __builtin_amdgcn_sched_barrier(0); }
    }
};
struct GateSched {
    pg::DenseOrder O;
    __device__ void init(int G, int c) { O.init(NTOK / 256, 16, G, c); }
    __device__ bool next(int i, pg::Unit& u) const { int pm, pn; if (!O.tile(i, pm, pn)) return false; u.arow = pm * 256; u.acol = ((pn >> 1) & 3) * 256; u.brow = pn * 256; u.orow = pm * 256; u.pn = pn; u.aux = 0; return true; }
    __device__ __forceinline__ void a_offs(const pg::Unit& u, int R0, unsigned c2, unsigned (&o)[2][2]) const {
#pragma unroll
        for (int h = 0; h < 2; ++h)
#pragma unroll
            for (int i = 0; i < 2; ++i) o[h][i] = (unsigned)(u.arow + h * 128 + i * 64 + R0) * (unsigned)(D * 2) + (unsigned)u.acol * 2u + c2;
    }
};
struct EpiGate {
    bf16_t* LA; bf16_t* GT; const bf16_t* ub; const float* br; const float* bi; const float* lam;
    __device__ __forceinline__ void operator()(const f32x4 (&acc)[2][2][4][2], const pg::Unit& u, int wr, int wc, int fr, int fq) const {
        const int d = u.pn >> 3, ch0 = ((u.pn >> 1) & 3) * 256 + (u.pn & 1) * 128 + wc * 16 + fq * 4, row0 = u.orow + wr * 64 + fr;
        f32x4 vbr[2], vbi[2], vsp[2];
#pragma unroll
        for (int bj = 0; bj < 2; ++bj) { vbr[bj] = *(const f32x4*)(br + d * D + ch0 + bj * 64); vbi[bj] = *(const f32x4*)(bi + d * D + ch0 + bj * 64);
            const f32x4 l = *(const f32x4*)(lam + d * D + ch0 + bj * 64);
#pragma unroll
            for (int j = 0; j < 4; ++j) vsp[bj][j] = -8.0f * 1.4426950408889634f * log1pf(expf(-l[j])); }
        bf16_t* la = LA + (size_t)d * NTOK * D; bf16_t* gt = GT + (size_t)d * NTOK * D;
#pragma unroll
        for (int ai = 0; ai < 2; ++ai)
#pragma unroll
            for (int m = 0; m < 4; ++m) { const int row = row0 + ai * 128 + m * 16;
#pragma unroll
                for (int bj = 0; bj < 2; ++bj) { const size_t off = (size_t)row * D + ch0 + bj * 64;
                    const u32x2 uw = *(const u32x2*)(ub + off); const float uf[4] = {bf_lo(uw.x), bf_hi(uw.x), bf_lo(uw.y), bf_hi(uw.y)};
                    const f32x4 rl = acc[ai][bj][m][0] + vbr[bj], il = acc[ai][bj][m][1] + vbi[bj]; float l2[4], g[4];
#pragma unroll
                    for (int j = 0; j < 4; ++j) { l2[j] = fsigm(rl[j]) * vsp[bj][j]; const float a2 = __builtin_amdgcn_exp2f(2.0f * l2[j]); g[j] = sqrtf(fmaxf(1.0f - a2, 0.f)) * (fsigm(il[j]) * uf[j]); }
                    u32x2 w; w.x = pk2(l2[0], l2[1]); w.y = pk2(l2[2], l2[3]); *(u32x2*)(la + off) = w;
                    w.x = pk2(g[0], g[1]); w.y = pk2(g[2], g[3]); *(u32x2*)(gt + off) = w; }
                asm volatile("" ::: "memory"); __builtin_amdgcn_sched_barrier(0); }
    }
};
__device__ __forceinline__ void p10_conv_b(Frame& F, const bf16_t* U, const float* cw, const float* cb, bf16_t* ub) {
    const int gw = F.vcu * NWAVES + F.wave, NGW = F.G * NWAVES;
    for (int it = gw; it < 2048; it += NGW) {
        const int r0 = (it >> 1) * 16, c0 = (it & 1) * 512 + F.lane * 8, t0 = r0 % SEQ;
        float w0[8], w1[8], w2[8], w3[8], bb[8];
#pragma unroll
        for (int j = 0; j < 8; ++j) { w0[j] = cw[c0 + j]; w1[j] = cw[D + c0 + j]; w2[j] = cw[2 * D + c0 + j]; w3[j] = cw[3 * D + c0 + j]; bb[j] = cb[c0 + j]; }
        const bf16_t* up = U + (size_t)r0 * D + c0; bf16_t* op = ub + (size_t)r0 * D + c0;
        float x0[8], x1[8], x2[8], x3[8];
        if (t0 > 0) { unpack8(*(const GAS u32x4*)(up - 2 * D), x0); unpack8(*(const GAS u32x4*)(up - D), x1); } else {
#pragma unroll
            for (int j = 0; j < 8; ++j) { x0[j] = 0.f; x1[j] = 0.f; } }
        unpack8(*(const GAS u32x4*)up, x2);
#pragma unroll 4
        for (int r = 0; r < 16; ++r) {
            if (t0 + r + 1 < SEQ) unpack8(*(const GAS u32x4*)(up + (size_t)(r + 1) * D), x3); else {
#pragma unroll
                for (int j = 0; j < 8; ++j) x3[j] = 0.f; }
            float o[8];
#pragma unroll
            for (int j = 0; j < 8; ++j) { o[j] = bb[j] + w0[j] * x0[j] + w1[j] * x1[j] + w2[j] * x2[j] + w3[j] * x3[j]; x0[j] = x1[j]; x1[j] = x2[j]; x2[j] = x3[j]; }
            *(GAS u32x4*)(op + (size_t)r * D) = pack8(o);
        }
    }
}
__device__ __forceinline__ float h2f(bf16_t v) { return (float)__builtin_bit_cast(_Float16, v); }
__device__ __forceinline__ void p12_scan(Frame& F, const bf16_t* LA, bf16_t* GT) {
    LAS float* sA = (LAS float*)F.lds; LAS float* sS = sA + 512;
    for (int id = F.vcu; id < 256; id += F.G) {
        const int d = id >> 7, b = (id >> 4) & 7, cg = id & 15, ch = cg * 64 + F.lane, chunk = F.wave;
        const size_t base = ((size_t)d * NTOK + (size_t)b * SEQ + (size_t)chunk * 256) * D + ch;
        const GAS bf16_t* la = (const GAS bf16_t*)LA + base; GAS bf16_t* gt = (GAS bf16_t*)GT + base;
        float h = 0.f, lsum = 0.f;
#pragma unroll 16
        for (int s = 0; s < 256; ++s) { const int t = d ? 255 - s : s; const float l = h2f(la[(size_t)t * D]), g = h2f(gt[(size_t)t * D]); h = __builtin_amdgcn_exp2f(l) * h + g; lsum += l; }
        sA[chunk * 64 + F.lane] = __builtin_amdgcn_exp2f(lsum); sS[chunk * 64 + F.lane] = h;
        LDS_WAIT(); __syncthreads();
        float c = 0.f;
        if (d == 0) { for (int cc = 0; cc < chunk; ++cc) c = sA[cc * 64 + F.lane] * c + sS[cc * 64 + F.lane]; }
        else { for (int cc = 7; cc > chunk; --cc) c = sA[cc * 64 + F.lane] * c + sS[cc * 64 + F.lane]; }
        h = c;
#pragma unroll 16
        for (int s = 0; s < 256; ++s) { const int t = d ? 255 - s : s; const float l = h2f(la[(size_t)t * D]), g = h2f(gt[(size_t)t * D]); h = __builtin_amdgcn_exp2f(l) * h + g;
            gt[(size_t)t * D] = __builtin_bit_cast(bf16_t, (_Float16)h); }
        LDS_WAIT(); __syncthreads();
    }
}
__device__ __forceinline__ void p13_mul(Frame& F, const bf16_t* YB, const bf16_t* HS, bf16_t* A2) {
    const size_t n8 = (size_t)NTOK * D / 8, stride = (size_t)F.G * NWAVES * 64;
    for (size_t i = ((size_t)F.vcu * NWAVES + F.wave) * 64 + F.lane; i < n8; i += stride) {
        float y[8], a[8], b[8], o[8]; unpack8(((const GAS u32x4*)YB)[i], y); unpack8(((const GAS u32x4*)HS)[i], a); unpack8(((const GAS u32x4*)HS)[n8 + i], b);
#pragma unroll
        for (int j = 0; j < 8; ++j) o[j] = y[j] * (a[j] + b[j]);
        ((GAS u32x4*)A2)[i] = pack8(o);
    }
}
__device__ __forceinline__ void p20_final(Frame& F, float* Hf, const float* ssp, const float* g) {
    DenseSched S; S.init(4, F.G, (int)blockIdx.x, D);
    pg::Unit u;
    for (int i = 0; S.next(i, u); ++i) {
        const f32x4 gv = *(const GAS f32x4*)(g + u.pn * 256 + F.lane * 4);
        for (int rr = F.wave; rr < 256; rr += NWAVES) {
            const int row = u.orow + rr; const size_t off = (size_t)row * D + u.pn * 256 + F.lane * 4;
            const float s = row_rstd(ssp, row);
            f32x4 h = *(const GAS f32x4*)(Hf + off); h = h * s * gv; *(GAS f32x4*)(Hf + off) = h;
        }
    }
}
__global__ void __launch_bounds__(NWAVES * 64, 2) mk_fwd(Args args) {
    extern __shared__ __attribute__((aligned(16))) unsigned char lds_[];
    Frame F;
    F.lds = (LAS unsigned char*)lds_;
    F.MISC = (volatile LAS unsigned*)(F.lds + MISC_OFF);
    F.tid = threadIdx.x; F.lane = F.tid & 63; F.wave = __builtin_amdgcn_readfirstlane(F.tid >> 6);
    F.G = gridDim.x; { const int bx = blockIdx.x; F.vcu = (F.G % 8 == 0) ? (bx % 8) * (F.G / 8) + bx / 8 : bx; }
    unsigned char* ws = args.ws;
    unsigned* ctl = (unsigned*)(ws + WS_CTL);
    for (int u = F.tid; u < (LDS_BYTES - MISC_OFF) / 4; u += NWAVES * 64) ((LAS unsigned*)(F.lds + MISC_OFF))[u] = 0u;
    __syncthreads();
    const int lo = args.ph_lo, hi = args.ph_hi;
    XcdBarrier bar; bar.bar = ctl + CW_BAR; bar.x = 0; bar.st = nullptr;
    if (hi - lo > 1) bar = xcd_barrier_post(ctl + CW_BAR, F.MISC + 8);
#define IN(k) (lo <= (k) && (k) < hi)
#define SEAM(k) do { if (IN(k) && IN((k) + 1)) xcd_barrier(bar); { int t_ = threadIdx.x; asm volatile("" : "+v"(t_)); F.tid = t_; F.lane = t_ & 63; } } while (0)
    bf16_t* wsm = (bf16_t*)(ws + WS_WSM);
    float* rstd = (float*)(ws + WS_RSTD);
    float* ssp0 = (float*)(ws + WS_SSP); float* ssp1 = (float*)(ws + WS_SSP1);
    float* Hf = args.out; bf16_t* Hb = (bf16_t*)(ws + WS_HB); bf16_t* PW = (bf16_t*)(ws + WS_PW); const bf16_t* pb = (const bf16_t*)(ws + WS_PB);
    const int c = (int)blockIdx.x;

    if (IN(0)) { p0_prologue(F, args, 0, N_PREP_JOBS); }
    SEAM(0);
    {
            if (IN(1)) {
                { pg::GemmDesc g{(const bf16_t*)(ws + WS_R(0)), D, wsm + OFF_WINA / 2, D, D};
                  DenseSched S; S.init(12, F.G, c, D);
                  EpiInA E{(bf16_t*)(ws + WS_R(1)), (bf16_t*)(ws + WS_R(2)), rstd};
                  pg::gemm_phase<EpiInA, DenseSched, true>(F.lds, g, S, E); }
                { pg::GemmDesc g{pb, 256, wsm + OFF_WPLE / 2, 256, 256};
                  DenseSched S; S.init(4, F.G, c, 256);
                  EpiLin E{PW, PW, 99, 0, 0, nullptr};
                  pg::gemm_phase<EpiLin, DenseSched, true>(F.lds, g, S, E); }
            }
            SEAM(1);
            if (IN(2)) p2_conv_a(F, (const bf16_t*)(ws + WS_R(1)), (const bf16_t*)(ws + WS_R(2)), args.in[4], (bf16_t*)(ws + WS_R(3)));
            SEAM(2);
            if (IN(3)) {
                pg::GemmDesc g{(const bf16_t*)(ws + WS_R(3)), D, wsm + OFF_WOUTA / 2, D, D};
                DenseSched S; S.init(4, F.G, c, D);
                EpiResid E{args.in[0], Hf, Hb, ssp0};
                pg::gemm_phase<EpiResid, DenseSched, true>(F.lds, g, S, E);
            }
            SEAM(3);
    }
    {
        const int PB = 4;
        unsigned* gcnt = ctl + CW_CNT + 0;
        int* lslot = (int*)(ws + WS_LSLOT); float* lw = (float*)(ws + WS_LW);
        bf16_t* wmoe = (bf16_t*)(ws + WS_WMOE + (size_t)0 * 96 * MiB);
        bf16_t* HID = (bf16_t*)(ws + WS_R(0)); bf16_t* Y = (bf16_t*)(ws + WS_R(2));
        if (IN(PB)) p4_router(F, Hf, args.in[15] + 0 * D, args.in[16] + (size_t)0 * D * 4, args.in[17] + 0 * 4, args.in[18] + (size_t)0 * D * 32, args.in[19] + 0 * 32, gcnt, lslot, lw, rstd);
        SEAM(PB);
        if (IN(PB + 1)) {
            const int n = moe_setup(F, gcnt, lslot, lw, rstd, 0);
            MoeSched S{(LAS int*)(F.lds + TAB_OFF), n, (const LAS unsigned*)(F.lds + TAB_OFF + 128), 0, D * 2};
            pg::GemmDesc g{Hb, D, wmoe, D, D};
            EpiUp E{HID, (const LAS unsigned*)(F.lds + TAB_OFF + 128 + MAXU * 1024)};
            pg::gemm_phase<EpiUp, MoeSched, true>(F.lds, g, S, E);
        }
        SEAM(PB + 1);
        if (IN(PB + 2)) {
            const int n = moe_setup(F, gcnt, lslot, lw, rstd, 1);
            MoeSched S{(LAS int*)(F.lds + TAB_OFF), n, (const LAS unsigned*)(F.lds + TAB_OFF + 128), 1, FEXP * 2};
            pg::GemmDesc g{HID, FEXP, wmoe + (size_t)32 * 1024 * D, FEXP, FEXP};
            EpiDown E{Y, (const LAS unsigned*)(F.lds + TAB_OFF + 128), (const LAS unsigned*)(F.lds + TAB_OFF + 128 + MAXU * 1024)};
            pg::gemm_phase<EpiDown, MoeSched, true>(F.lds, g, S, E);
        }
        SEAM(PB + 2);
        if (IN(PB + 3)) p7_combine(F, Hf, Hb, Y, ssp0);
        SEAM(PB + 3);
        if (IN(PB + 4)) {
            pg::GemmDesc g{Hb, D, wsm + OFF_WPLEG / 2 + (size_t)0 * D * D, D, D};
            DenseSched S; S.init(4, F.G, c, D);
            EpiPle E{Hf, Hb, ssp0, ssp1, PW, args.in[26] + 0 * D};
            pg::gemm_phase<EpiPle, DenseSched, true>(F.lds, g, S, E);
        }
        SEAM(PB + 4);
    }
    {
            bf16_t* YB = (bf16_t*)(ws + WS_R(0)); bf16_t* Ub = (bf16_t*)(ws + WS_R(1)); bf16_t* ub = (bf16_t*)(ws + WS_R(2));
            bf16_t* LA = (bf16_t*)(ws + WS_WMOE); bf16_t* GT = (bf16_t*)(ws + WS_R(3)); bf16_t* A2 = (bf16_t*)(ws + WS_R(5));
            if (IN(9)) {
                { pg::GemmDesc g{Hb, D, wsm + OFF_WINB / 2, D, D};
                  DenseSched S; S.init(8, F.G, c, D);
                  EpiLin E{YB, Ub, 4, 1, 0, ssp1};
                  pg::gemm_phase<EpiLin, DenseSched, true>(F.lds, g, S, E); }
                { pg::GemmDesc g{pb + (size_t)NTOK * 256, 256, wsm + OFF_WPLE / 2 + (size_t)D * 256, 256, 256};
                  DenseSched S; S.init(4, F.G, c, 256);
                  EpiLin E{PW, PW, 99, 0, 0, nullptr};
                  pg::gemm_phase<EpiLin, DenseSched, true>(F.lds, g, S, E); }
            }
            SEAM(9);
            if (IN(10)) p10_conv_b(F, Ub, args.in[7], args.in[8], ub);
            SEAM(10);
            if (IN(11)) {
                pg::GemmDesc g{ub, D, wsm + OFF_WGATE / 2, 256, 256};
                GateSched S; S.init(F.G, c);
                EpiGate E{LA, GT, ub, args.in[10], args.in[12], args.in[13]};
                pg::gemm_phase<EpiGate, GateSched, true>(F.lds, g, S, E);
            }
            SEAM(11);
            if (IN(12)) p12_scan(F, LA, GT);
            SEAM(12);
            if (IN(13)) p13_mul(F, YB, GT, A2);
            SEAM(13);
            if (IN(14)) {
                pg::GemmDesc g{A2, D, wsm + OFF_WOUTB / 2, D, D};
                DenseSched S; S.init(4, F.G, c, D);
                EpiResid E{Hf, Hf, Hb, ssp0};
                pg::gemm_phase<EpiResid, DenseSched, true>(F.lds, g, S, E);
            }
            SEAM(14);
    }
    {
        const int PB = 15;
        unsigned* gcnt = ctl + CW_CNT + 64;
        int* lslot = (int*)(ws + WS_LSLOT); float* lw = (float*)(ws + WS_LW);
        bf16_t* wmoe = (bf16_t*)(ws + WS_WMOE + (size_t)1 * 96 * MiB);
        bf16_t* HID = (bf16_t*)(ws + WS_R(0)); bf16_t* Y = (bf16_t*)(ws + WS_R(2));
        if (IN(PB)) p4_router(F, Hf, args.in[15] + 1 * D, args.in[16] + (size_t)1 * D * 4, args.in[17] + 1 * 4, args.in[18] + (size_t)1 * D * 32, args.in[19] + 1 * 32, gcnt, lslot, lw, rstd);
        SEAM(PB);
        if (IN(PB + 1)) {
            const int n = moe_setup(F, gcnt, lslot, lw, rstd, 0);
            MoeSched S{(LAS int*)(F.lds + TAB_OFF), n, (const LAS unsigned*)(F.lds + TAB_OFF + 128), 0, D * 2};
            pg::GemmDesc g{Hb, D, wmoe, D, D};
            EpiUp E{HID, (const LAS unsigned*)(F.lds + TAB_OFF + 128 + MAXU * 1024)};
            pg::gemm_phase<EpiUp, MoeSched, true>(F.lds, g, S, E);
        }
        SEAM(PB + 1);
        if (IN(PB + 2)) {
            const int n = moe_setup(F, gcnt, lslot, lw, rstd, 1);
            MoeSched S{(LAS int*)(F.lds + TAB_OFF), n, (const LAS unsigned*)(F.lds + TAB_OFF + 128), 1, FEXP * 2};
            pg::GemmDesc g{HID, FEXP, wmoe + (size_t)32 * 1024 * D, FEXP, FEXP};
            EpiDown E{Y, (const LAS unsigned*)(F.lds + TAB_OFF + 128), (const LAS unsigned*)(F.lds + TAB_OFF + 128 + MAXU * 1024)};
            pg::gemm_phase<EpiDown, MoeSched, true>(F.lds, g, S, E);
        }
        SEAM(PB + 2);
        if (IN(PB + 3)) p7_combine(F, Hf, Hb, Y, ssp0);
        SEAM(PB + 3);
        if (IN(PB + 4)) {
            pg::GemmDesc g{Hb, D, wsm + OFF_WPLEG / 2 + (size_t)1 * D * D, D, D};
            DenseSched S; S.init(4, F.G, c, D);
            EpiPle E{Hf, Hb, ssp0, ssp1, PW, args.in[26] + 1 * D};
            pg::gemm_phase<EpiPle, DenseSched, true>(F.lds, g, S, E);
        }
        SEAM(PB + 4);
    }
    if (IN(20)) p20_final(F, Hf, ssp1, args.in[27]);
#undef IN
#undef SEAM
}
__global__ __launch_bounds__(256) void k_rmsnorm(const float* in, const float* __restrict__ g, float* out) {
    const int row = blockIdx.x, t = threadIdx.x;
    const float4 v = ((const float4*)(in + (size_t)row * D))[t];
    float s = v.x * v.x + v.y * v.y + v.z * v.z + v.w * v.w;
    for (int o = 1; o < 64; o <<= 1) s += __shfl_xor(s, o);
    __shared__ float red[4];
    if ((t & 63) == 0) red[t >> 6] = s;
    __syncthreads();
    s = red[0] + red[1] + red[2] + red[3];
    const float r = rsqrtf(s * (1.0f / D) + EPS);
    const float4 gg = ((const float4*)g)[t];
    float4 o; o.x = v.x * r * gg.x; o.y = v.y * r * gg.y; o.z = v.z * r * gg.z; o.w = v.w * r * gg.w;
    ((float4*)(out + (size_t)row * D))[t] = o;
}

__global__ __launch_bounds__(256) void k_gemm(const float* __restrict__ A, int lda, long aZ, const int* __restrict__ rowidx, long rZ, int agather, const int* __restrict__ cnt, int M,
                                              const float* __restrict__ B, int ldb, long bZ, float* __restrict__ C, float* __restrict__ C1, int ldc, long cZ, const int* __restrict__ cstart,
                                              const int* __restrict__ astart, int omode, const float* __restrict__ wl, int K) {
    const int z = blockIdx.z, m0 = blockIdx.y * 64, n0 = blockIdx.x * 64, tid = threadIdx.x;
    const int Mz = cnt ? cnt[z] : M;
    if (m0 >= Mz) return;
    __shared__ float As[16][68];
    __shared__ float Bs[16][68];
    const float* Az = A + z * aZ; const float* Bz = B + z * bZ;
    const int ar = tid >> 2, ak = (tid & 3) * 4;
    const int bk = tid >> 4, bn = (tid & 15) * 4;
    long arow = -1;
    if (m0 + ar < Mz) { if (agather) arow = rowidx[z * rZ + m0 + ar] >> 1; else arow = (astart ? astart[z] : 0) + m0 + ar; }
    const int ty = tid >> 4, tx = tid & 15;
    float acc[4][4] = {};
    for (int k0 = 0; k0 < K; k0 += 16) {
        float4 av = make_float4(0.f, 0.f, 0.f, 0.f);
        if (arow >= 0) av = *(const float4*)(Az + arow * lda + k0 + ak);
        const float4 bv = *(const float4*)(Bz + (size_t)(k0 + bk) * ldb + n0 + bn);
        As[ak + 0][ar] = av.x; As[ak + 1][ar] = av.y; As[ak + 2][ar] = av.z; As[ak + 3][ar] = av.w;
        *(float4*)&Bs[bk][bn] = bv;
        __syncthreads();
#pragma unroll
        for (int k = 0; k < 16; ++k) {
            const float4 a = *(const float4*)&As[k][ty * 4];
            const float4 b = *(const float4*)&Bs[k][tx * 4];
            const float aa[4] = {a.x, a.y, a.z, a.w}, bb[4] = {b.x, b.y, b.z, b.w};
#pragma unroll
            for (int i = 0; i < 4; ++i)
#pragma unroll
                for (int j = 0; j < 4; ++j) acc[i][j] += aa[i] * bb[j];
        }
        __syncthreads();
    }
#pragma unroll
    for (int i = 0; i < 4; ++i) {
        const int m = m0 + ty * 4 + i;
        if (m >= Mz) continue;
        float4 o = make_float4(acc[i][0], acc[i][1], acc[i][2], acc[i][3]);
        if (omode == 0) {
            const long orow = (cstart ? cstart[z] : 0) + m;
            *(float4*)(C + z * cZ + orow * ldc + n0 + tx * 4) = o;
        } else {
            const int s = rowidx[z * rZ + m]; const float w = wl[z * rZ + m];
            o.x *= w; o.y *= w; o.z *= w; o.w *= w;
            float* base = (s & 1) ? C1 : C;
            *(float4*)(base + (size_t)(s >> 1) * ldc + n0 + tx * 4) = o;
        }
    }
}

__global__ __launch_bounds__(256) void k_convA(const float* __restrict__ bch, const float* __restrict__ cw, float* __restrict__ out) {
    const int row = blockIdx.x, t = row % SEQ;
    for (int c = threadIdx.x; c < D; c += 256) {
        const float* r0 = bch + (size_t)row * 3 * D;
        float g1 = r0[D + c] * r0[2 * D + c], g0 = 0.f, g2 = 0.f;
        if (t > 0) { const float* rm = r0 - 3 * D; g0 = rm[D + c] * rm[2 * D + c]; }
        if (t < SEQ - 1) { const float* rp = r0 + 3 * D; g2 = rp[D + c] * rp[2 * D + c]; }
        out[(size_t)row * D + c] = r0[c] * (cw[c] * g0 + cw[D + c] * g1 + cw[2 * D + c] * g2);
    }
}
__global__ __launch_bounds__(256) void k_add(const float* a, const float* b, float* o, size_t n4) {
    for (size_t i = blockIdx.x * 256ull + threadIdx.x; i < n4; i += (size_t)gridDim.x * 256) {
        const float4 x = ((const float4*)a)[i], y = ((const float4*)b)[i];
        ((float4*)o)[i] = make_float4(x.x + y.x, x.y + y.y, x.z + y.z, x.w + y.w);
    }
}
__global__ __launch_bounds__(256) void k_add3(float* __restrict__ h, const float* __restrict__ a, const float* __restrict__ b, size_t n4) {
    for (size_t i = blockIdx.x * 256ull + threadIdx.x; i < n4; i += (size_t)gridDim.x * 256) {
        const float4 x = ((const float4*)h)[i], y = ((const float4*)a)[i], z = ((const float4*)b)[i];
        ((float4*)h)[i] = make_float4(x.x + y.x + z.x, x.y + y.y + z.y, x.z + y.z + z.z, x.w + y.w + z.w);
    }
}
__device__ __forceinline__ float sigm(float x) { return 1.0f / (1.0f + expf(-x)); }
__global__ __launch_bounds__(256) void k_ple(float* __restrict__ h, const float* __restrict__ gl, const float* __restrict__ bias, const float* __restrict__ pw) {
    const int row = blockIdx.x;
    for (int c = threadIdx.x; c < D; c += 256) { const size_t i = (size_t)row * D + c; h[i] += sigm(gl[i] + bias[c]) * pw[i]; }
}
__global__ __launch_bounds__(256) void k_router(const float* __restrict__ xf, const float* __restrict__ wg, const float* __restrict__ bg, const float* __restrict__ we, const float* __restrict__ be,
                                                int* __restrict__ cnt, int* __restrict__ lslot, float* __restrict__ lw) {
    const int tok = blockIdx.x * 4 + (threadIdx.x >> 6), lane = threadIdx.x & 63;
    float acc[36];
#pragma unroll
    for (int j = 0; j < 36; ++j) acc[j] = 0.f;
    for (int i = 0; i < 16; ++i) {
        const int k = lane + 64 * i; const float x = xf[(size_t)tok * D + k];
#pragma unroll
        for (int j = 0; j < 4; ++j) acc[j] += x * wg[k * 4 + j];
#pragma unroll
        for (int j = 0; j < 32; ++j) acc[4 + j] += x * we[k * 32 + j];
    }
#pragma unroll
    for (int j = 0; j < 36; ++j) for (int o = 1; o < 64; o <<= 1) acc[j] += __shfl_xor(acc[j], o);
    __shared__ float sl[4][40];
    float* L = sl[threadIdx.x >> 6];
    if (lane == 0) {
#pragma unroll
        for (int j = 0; j < 36; ++j) L[j] = acc[j];
        int g = 0;
        for (int j = 0; j < 4; ++j) L[j] += bg[j];
        for (int j = 1; j < 4; ++j) if (L[j] > L[g]) g = j;
        float sg = 0.f; for (int j = 0; j < 4; ++j) sg += expf(L[j] - L[g]);
        const float pg = 1.0f / sg;
        float* le = L + 4 + g * 8;
        for (int i = 0; i < 8; ++i) le[i] += be[g * 8 + i];
        int i0 = 0; for (int i = 1; i < 8; ++i) if (le[i] > le[i0]) i0 = i;
        int i1 = (i0 == 0) ? 1 : 0; for (int i = 0; i < 8; ++i) if (i != i0 && le[i] > le[i1]) i1 = i;
        const float e1 = expf(le[i1] - le[i0]); const float w0 = 1.0f / (1.0f + e1), w1 = e1 / (1.0f + e1);
        const int E0 = g * 8 + i0, E1 = g * 8 + i1;
        const int p0 = atomicAdd(&cnt[E0], 1); lslot[E0 * CAP + p0] = 2 * tok; lw[E0 * CAP + p0] = pg * w0;
        const int p1 = atomicAdd(&cnt[E1], 1); lslot[E1 * CAP + p1] = 2 * tok + 1; lw[E1 * CAP + p1] = pg * w1;
    }
}
__global__ void k_cstart(const int* __restrict__ cnt, int* __restrict__ cstart) {
    if (threadIdx.x == 0) { int s = 0; for (int e = 0; e < NEXP; ++e) { cstart[e] = s; s += (cnt[e] + 255) / 256 * 256; } }
}
__global__ __launch_bounds__(256) void k_silu_mul(float* __restrict__ g, const float* __restrict__ u, size_t n) {
    for (size_t i = blockIdx.x * 256ull + threadIdx.x; i < n; i += (size_t)gridDim.x * 256) { const float x = g[i]; g[i] = x * sigm(x) * u[i]; }
}
__global__ __launch_bounds__(256) void k_convB(const float* __restrict__ yu, const float* __restrict__ cw, const float* __restrict__ cb, float* __restrict__ out) {
    const int row = blockIdx.x, t = row % SEQ;
    for (int c = threadIdx.x; c < D; c += 256) {
        float s = cb[c];
#pragma unroll
        for (int k = 0; k < 4; ++k) { const int tt = t + k - 2; if (tt >= 0 && tt < SEQ) s += cw[k * D + c] * yu[(size_t)(row + k - 2) * 2 * D + D + c]; }
        out[(size_t)row * D + c] = s;
    }
}
__global__ __launch_bounds__(256) void k_scan(const float* __restrict__ rl, const float* __restrict__ il, const float* __restrict__ u, const float* __restrict__ br, const float* __restrict__ bi,
                                              const float* __restrict__ lam, float* __restrict__ hs, int rev) {
    const int idx = blockIdx.x * 256 + threadIdx.x, b = idx / D, c = idx % D;
    const float sp = log1pf(expf(-lam[c])), bR = br[c], bI = bi[c];
    float h = 0.f;
    for (int s = 0; s < SEQ; ++s) {
        const int t = rev ? SEQ - 1 - s : s; const size_t i = (size_t)(b * SEQ + t) * D + c;
        const float r = sigm(rl[i] + bR), ig = sigm(il[i] + bI);
        const float la = -8.0f * r * sp, a = expf(la);
        const float gt = sqrtf(-expm1f(2.0f * la)) * (ig * u[i]);
        h = a * h + gt;
        if (rev) hs[i] += h; else hs[i] = h;
    }
}
__device__ __forceinline__ float gelu_tanh(float x) { const float c = 0.7978845608028654f; return 0.5f * x * (1.0f + tanhf(c * (x + 0.044715f * x * x * x))); }
__global__ __launch_bounds__(256) void k_mulY(const float* __restrict__ yu, const float* __restrict__ hs, float* __restrict__ out) {
    const int row = blockIdx.x;
    for (int c = threadIdx.x; c < D; c += 256) out[(size_t)row * D + c] = gelu_tanh(yu[(size_t)row * 2 * D + c]) * hs[(size_t)row * D + c];
}

__global__ __launch_bounds__(256) void k_cvt(const bf16_t* __restrict__ src, float* __restrict__ dst, size_t n) {
    for (size_t i = blockIdx.x * 256ull + threadIdx.x; i < n; i += (size_t)gridDim.x * 256) dst[i] = (float)__builtin_bit_cast(_Float16, src[i]);
}
__global__ __launch_bounds__(256) void k_convA2(const float* __restrict__ bg, const float* __restrict__ g, const float* __restrict__ cw, float* __restrict__ out) {
    const int row = blockIdx.x, t = row % SEQ;
    for (int c = threadIdx.x; c < D; c += 256) {
        const size_t i = (size_t)row * D + c;
        const float g1 = g[i], g0 = t > 0 ? g[i - D] : 0.f, g2 = t < SEQ - 1 ? g[i + D] : 0.f;
        out[i] = bg[i] * (cw[c] * g0 + cw[D + c] * g1 + cw[2 * D + c] * g2);
    }
}
static void gemm(hipStream_t st, const float* A, int lda, const float* B, int ldb, float* C, int ldc, int M, int N, int K) {
    hipLaunchKernelGGL(k_gemm, dim3(N / 64, M / 64, 1), dim3(256), 0, st, A, lda, 0L, (const int*)nullptr, 0L, 0, (const int*)nullptr, M, B, ldb, 0L, C, (float*)nullptr, ldc, 0L,
                       (const int*)nullptr, (const int*)nullptr, 0, (const float*)nullptr, K);
}
static void launch_fast(hipStream_t stream, Args a, int lo, int hi, bool per_phase) {
    static bool attr = false;
    if (!attr) { (void)hipFuncSetAttribute((const void*)mk_fwd, hipFuncAttributeMaxDynamicSharedMemorySize, LDS_BYTES); attr = true; }
    if (per_phase) { for (int p = lo; p < hi; ++p) { a.ph_lo = p; a.ph_hi = p + 1; hipLaunchKernelGGL(mk_fwd, dim3(256), dim3(NWAVES * 64), LDS_BYTES, stream, a); } }
    else { a.ph_lo = lo; a.ph_hi = hi; hipLaunchKernelGGL(mk_fwd, dim3(256), dim3(NWAVES * 64), LDS_BYTES, stream, a); }
}
extern "C" void kernel_launch(void* const* d_in, const int* in_sizes, int n_in, void* d_out, int out_size, void* d_ws, size_t ws_size, hipStream_t stream) {
    const float* x = (const float*)d_in[0]; const float* p = (const float*)d_in[1]; const float* norm_mix = (const float*)d_in[2];
    const float* w_in_a = (const float*)d_in[3]; const float* conv_a = (const float*)d_in[4]; const float* w_out_a = (const float*)d_in[5];
    const float* w_in_b = (const float*)d_in[6]; const float* conv_b = (const float*)d_in[7]; const float* conv_bias_b = (const float*)d_in[8];
    const float* w_rgate = (const float*)d_in[9]; const float* b_rgate = (const float*)d_in[10]; const float* w_igate = (const float*)d_in[11]; const float* b_igate = (const float*)d_in[12];
    const float* lam = (const float*)d_in[13]; const float* w_out_b = (const float*)d_in[14]; const float* norm_ffn = (const float*)d_in[15];
    const float* w_rg = (const float*)d_in[16]; const float* b_rg = (const float*)d_in[17]; const float* w_re = (const float*)d_in[18]; const float* b_re = (const float*)d_in[19];
    const float* w_eg = (const float*)d_in[20]; const float* w_eu = (const float*)d_in[21]; const float* w_ed = (const float*)d_in[22];
    const float* norm_ple = (const float*)d_in[23]; const float* w_ple = (const float*)d_in[24]; const float* w_pleg = (const float*)d_in[25]; const float* b_pleg = (const float*)d_in[26];
    const float* norm_final = (const float*)d_in[27];
    (void)in_sizes; (void)n_in; (void)out_size;
    if (ws_size < WS_END) { fprintf(stderr, "ws too small: %zu < %zu\n", ws_size, (size_t)WS_END); return; }
    float* H = (float*)d_out;
    char* ws = (char*)d_ws;
    (void)hipMemsetAsync(ws + WS_CTL, 0, CTL_ZERO_BYTES, stream);
    Args a{};
    for (int i = 0; i < 28; ++i) a.in[i] = (const float*)d_in[i];
    a.out = (float*)d_out; a.ws = (unsigned char*)d_ws;
    launch_fast(stream, a, 0, HYB, HYB_PER_PHASE);
    const size_t SZ = (size_t)NTOK * D * 4;
    float* T1 = (float*)(ws + NV_T1); float* T2 = (float*)(ws + NV_T2); float* T3 = (float*)(ws + NV_T3); float* T4 = (float*)(ws + NV_T4);
    int* cnt = (int*)(ws + NV_MISC); int* cstart = cnt + 64; int* lslot = cnt + 128; float* lw = (float*)(lslot + NEXP * CAP);
    const size_t n4 = (size_t)NTOK * D / 4;
    (void)SZ;
    auto moe = [&](int L) {
        hipLaunchKernelGGL(k_rmsnorm, dim3(NTOK), dim3(256), 0, stream, H, norm_ffn + L * D, T2);
        const bool fastr = NV_FAST_ROUTER && L < NV_FAST_ROUTER_LAYERS;
        if (fastr) { cnt = (int*)(ws + WS_CTL) + CW_CNT + 64 * L; lslot = (int*)(ws + WS_LSLOT); lw = (float*)(ws + WS_LW); }
        else { cnt = (int*)(ws + NV_MISC); lslot = cnt + 128; lw = (float*)(lslot + NEXP * CAP); (void)hipMemsetAsync(cnt, 0, 256, stream); }
        if (!fastr) hipLaunchKernelGGL(k_router, dim3(NTOK / 4), dim3(256), 0, stream, T2, w_rg + (size_t)L * D * 4, b_rg + L * 4, w_re + (size_t)L * D * 32, b_re + L * 32, cnt, lslot, lw);
        hipLaunchKernelGGL(k_cstart, dim3(1), dim3(64), 0, stream, cnt, cstart);
        float* HG = T1; float* HU = T1 + (size_t)40960 * FEXP;
        const float* wg = w_eg + (size_t)L * NEXP * D * FEXP; const float* wu = w_eu + (size_t)L * NEXP * D * FEXP; const float* wd = w_ed + (size_t)L * NEXP * FEXP * D;
        hipLaunchKernelGGL(k_gemm, dim3(FEXP / 64, CAP / 64, NEXP), dim3(256), 0, stream, T2, D, 0L, lslot, (long)CAP, 1, cnt, 0, wg, FEXP, (long)D * FEXP, HG, (float*)nullptr, FEXP, 0L, cstart,
                           (const int*)nullptr, 0, (const float*)nullptr, D);
        hipLaunchKernelGGL(k_gemm, dim3(FEXP / 64, CAP / 64, NEXP), dim3(256), 0, stream, T2, D, 0L, lslot, (long)CAP, 1, cnt, 0, wu, FEXP, (long)D * FEXP, HU, (float*)nullptr, FEXP, 0L, cstart,
                           (const int*)nullptr, 0, (const float*)nullptr, D);
        hipLaunchKernelGGL(k_silu_mul, dim3(4096), dim3(256), 0, stream, HG, HU, (size_t)40960 * FEXP);
        hipLaunchKernelGGL(k_gemm, dim3(D / 64, CAP / 64, NEXP), dim3(256), 0, stream, HG, FEXP, 0L, lslot, (long)CAP, 0, cnt, 0, wd, D, (long)FEXP * D, T3, T4, D, 0L, (const int*)nullptr,
                           cstart, 1, lw, FEXP);
        hipLaunchKernelGGL(k_add3, dim3(4096), dim3(256), 0, stream, H, T3, T4, n4);
    };
    auto ple = [&](int L) {
        hipLaunchKernelGGL(k_rmsnorm, dim3(NTOK), dim3(256), 0, stream, H, norm_ple + L * D, T2);
        gemm(stream, T2, D, w_pleg + (size_t)L * D * D, D, T3, D, NTOK, D, D);
        gemm(stream, p + (size_t)L * NTOK * PLE, PLE, w_ple + (size_t)L * PLE * D, D, T4, D, NTOK, D, PLE);
        hipLaunchKernelGGL(k_ple, dim3(NTOK), dim3(256), 0, stream, H, T3, b_pleg + L * D, T4);
    };
    const int st = NV_START;
    if (st <= 1) { hipLaunchKernelGGL(k_rmsnorm, dim3(NTOK), dim3(256), 0, stream, x, norm_mix, T2); gemm(stream, T2, D, w_in_a, 3 * D, T1, 3 * D, NTOK, 3 * D, D); }
    if (st <= 2) {
        if (st == 2) {
            hipLaunchKernelGGL(k_cvt, dim3(4096), dim3(256), 0, stream, (const bf16_t*)(ws + WS_R(1)), T2, (size_t)NTOK * D);
            hipLaunchKernelGGL(k_cvt, dim3(4096), dim3(256), 0, stream, (const bf16_t*)(ws + WS_R(2)), T4, (size_t)NTOK * D);
            hipLaunchKernelGGL(k_convA2, dim3(NTOK), dim3(256), 0, stream, T4, T2, conv_a, T3);
        } else hipLaunchKernelGGL(k_convA, dim3(NTOK), dim3(256), 0, stream, T1, conv_a, T3);
    }
    if (st <= 3) { gemm(stream, T3, D, w_out_a, D, T2, D, NTOK, D, D); hipLaunchKernelGGL(k_add, dim3(4096), dim3(256), 0, stream, x, T2, H, n4); }
    if (st <= 4) moe(0);
    if (st <= 5) ple(0);
    float* HS = T1 + 2 * (size_t)NTOK * D;
    if (st <= 6) { hipLaunchKernelGGL(k_rmsnorm, dim3(NTOK), dim3(256), 0, stream, H, norm_mix + D, T2); gemm(stream, T2, D, w_in_b, 2 * D, T1, 2 * D, NTOK, 2 * D, D); }
    if (st <= 7) hipLaunchKernelGGL(k_convB, dim3(NTOK), dim3(256), 0, stream, T1, conv_b, conv_bias_b, T3);
    if (st <= 8) for (int d = 0; d < 2; ++d) {
        hipLaunchKernelGGL(k_gemm, dim3(256 / 64, NTOK / 64, 4), dim3(256), 0, stream, T3, D, 256L, (const int*)nullptr, 0L, 0, (const int*)nullptr, NTOK, w_rgate + (size_t)d * 4 * 256 * 256, 256,
                           256L * 256, T2, (float*)nullptr, D, 256L, (const int*)nullptr, (const int*)nullptr, 0, (const float*)nullptr, 256);
        hipLaunchKernelGGL(k_gemm, dim3(256 / 64, NTOK / 64, 4), dim3(256), 0, stream, T3, D, 256L, (const int*)nullptr, 0L, 0, (const int*)nullptr, NTOK, w_igate + (size_t)d * 4 * 256 * 256, 256,
                           256L * 256, T4, (float*)nullptr, D, 256L, (const int*)nullptr, (const int*)nullptr, 0, (const float*)nullptr, 256);
        hipLaunchKernelGGL(k_scan, dim3(BATCH * D / 256), dim3(256), 0, stream, T2, T4, T3, b_rgate + d * D, b_igate + d * D, lam + d * D, HS, d);
    }
    if (st <= 9) { hipLaunchKernelGGL(k_mulY, dim3(NTOK), dim3(256), 0, stream, T1, HS, T2); gemm(stream, T2, D, w_out_b, D, T3, D, NTOK, D, D); hipLaunchKernelGGL(k_add, dim3(4096), dim3(256), 0, stream, H, T3, H, n4); }
    if (st <= 10) moe(1);
    if (st <= 11) ple(1);
    if (st <= 12) hipLaunchKernelGGL(k_rmsnorm, dim3(NTOK), dim3(256), 0, stream, H, norm_final, H);
}
```

```cpp
#include <hip/hip_runtime.h>
#include <cstdio>
#include <cstdint>
constexpr int D = 1024, BATCH = 8, SEQ = 2048, NTOK = BATCH * SEQ, PLE = 256, NEXP = 32, FEXP = 512, CAP = NTOK;
constexpr float EPS = 1e-6f;
constexpr unsigned REP_MASK = 0u;
#define LAS __attribute__((address_space(3)))
#define GAS __attribute__((address_space(1)))
typedef unsigned short bf16_t;
typedef short bf16x8 __attribute__((ext_vector_type(8)));
typedef _Float16 half8 __attribute__((ext_vector_type(8)));
typedef _Float16 half2v __attribute__((ext_vector_type(2)));
typedef float f32x4 __attribute__((ext_vector_type(4)));
typedef float f32x2 __attribute__((ext_vector_type(2)));
typedef unsigned u32x4 __attribute__((ext_vector_type(4)));
typedef unsigned u32x2 __attribute__((ext_vector_type(2)));
namespace pg {
constexpr int BM = 256, BK = 64, HALF = 128, HTB = HALF * BK * 2, STAGE_BYTES = 8 * HTB, NXCD = 8, WGM = 8;
__host__ __device__ __forceinline__ int lds_byte(int r, int c) { const int st = (r >> 4) * 2 + (c >> 5), rr = r & 15, cc = c & 31, ob = rr * 64 + cc * 2; return st * 1024 + (ob ^ (((ob >> 9) & 1) << 5)); }
__host__ __device__ __forceinline__ void stage_rc(int b, int& R, int& C) { const int st = b / 1024, sb = b % 1024, swz = sb ^ (((sb >> 9) & 1) << 5); R = (st >> 1) * 16 + swz / 64; C = (st & 1) * 32 + (swz % 64) / 2; }

struct Unit { int arow, acol, brow, orow, pn, aux; };
struct GemmDesc { const bf16_t* A; int lda; const bf16_t* Bt; int ldb; int K; };

struct DenseOrder {
    int nM, nN, nwg, G, c;
    __device__ void init(int nM_, int nN_, int G_, int c_) { nM = nM_; nN = nN_; nwg = nM * nN; G = G_; c = c_; }
    __device__ bool tile(int i, int& pm, int& pn) const {
        const long L = (long)i * G + c; if (L >= nwg) return false;
        int wgid = (int)L; { const int q = nwg / NXCD, r = nwg % NXCD, xcd = wgid % NXCD, off = wgid / NXCD; wgid = (xcd < r ? xcd * (q + 1) : r * (q + 1) + (xcd - r) * q) + off; }
        const int nig = WGM * nN, gid = wgid / nig, fm = gid * WGM, gsz = (nM - fm) < WGM ? (nM - fm) : WGM;
        pm = fm + ((wgid % nig) % gsz); pn = (wgid % nig) / gsz; return true;
    }
};

__device__ __forceinline__ unsigned cvt_pk_bf16(float lo, float hi) { half2v v; v.x = (_Float16)lo; v.y = (_Float16)hi; return __builtin_bit_cast(unsigned, v); }

template <class Epi, class Sched, bool ALIGN_EPI>
__device__ __forceinline__ void gemm_phase(LAS unsigned char* lds, const GemmDesc g, const Sched& S, const Epi& E) {
    int tid_ = threadIdx.x; asm volatile("" : "+v"(tid_));
    const int tid = tid_, wid = __builtin_amdgcn_readfirstlane(tid >> 6), lane = tid & 63, wr = wid >> 2, wc = wid & 3, fr = lane & 15, fq = lane >> 4;
    const int K = g.K, nt = K / BK;
    int R0, C0; stage_rc(tid * 16, R0, C0);
    unsigned voffB[2]; voffB[0] = (unsigned)(R0 * g.ldb + C0) * 2u; voffB[1] = voffB[0] + (unsigned)(64 * g.ldb) * 2u;
    const unsigned c2 = (unsigned)C0 * 2u;
    const size_t kstep = (size_t)(BK * 2);
    const size_t hstepB = (size_t)HALF * g.ldb * 2;
    const unsigned ldsw = (unsigned)wid * 1024u;
    const int aoff = lds_byte(wr * 64 + fr, fq * 8), boff = lds_byte(wc * 32 + fr, fq * 8);
#define PG_SA(b, h) (((b) * 2 + (h)) * HTB)
#define PG_SB(b, h) ((4 + (b) * 2 + (h)) * HTB)
#define PG_STAGE(bufoff, gbase, voff) do { _Pragma("unroll") for (int _i = 0; _i < 2; ++_i) \
        __builtin_amdgcn_global_load_lds((const unsigned*)((const char*)(gbase) + (voff)[_i]), (LAS unsigned*)(lds + (bufoff) + ldsw + _i * 8192), 16, 0, 0); } while (0)
#define PG_LDA(dst, b, h) do { _Pragma("unroll") for (int m = 0; m < 4; ++m) _Pragma("unroll") for (int k = 0; k < 2; ++k) dst[m][k] = *(const LAS bf16x8*)(lds + PG_SA(b, h) + aoff + m * 2048 + k * 1024); } while (0)
#define PG_LDB(dst, b, h) do { _Pragma("unroll") for (int n = 0; n < 2; ++n) _Pragma("unroll") for (int k = 0; k < 2; ++k) dst[n][k] = *(const LAS bf16x8*)(lds + PG_SB(b, h) + boff + n * 2048 + k * 1024); } while (0)
#define PG_MMA(ai, bj, At, Bt) do { __builtin_amdgcn_s_setprio(1); _Pragma("unroll") for (int m = 0; m < 4; ++m) _Pragma("unroll") for (int n = 0; n < 2; ++n) _Pragma("unroll") for (int k = 0; k < 2; ++k) \
        acc[ai][bj][m][n] = __builtin_amdgcn_mfma_f32_16x16x32_f16(__builtin_bit_cast(half8, Bt[n][k]), __builtin_bit_cast(half8, At[m][k]), acc[ai][bj][m][n], 0, 0, 0); __builtin_amdgcn_s_setprio(0); } while (0)
#define PG_WAIT_V(n) asm volatile("s_waitcnt vmcnt(" #n ")" ::: "memory")
#define PG_WAIT_L(n) asm volatile("s_waitcnt lgkmcnt(" #n ")" ::: "memory")
#define PG_BAR __builtin_amdgcn_s_barrier()
#define PG_SCHED __builtin_amdgcn_sched_barrier(0)
    Unit cur, nxt; int ui = 0;
    if (!S.next(0, cur)) return;
    f32x4 acc[2][2][4][2];
#pragma unroll
    for (int a = 0; a < 2; ++a)
#pragma unroll
        for (int b = 0; b < 2; ++b)
#pragma unroll
            for (int m = 0; m < 4; ++m)
#pragma unroll
                for (int n = 0; n < 2; ++n) acc[a][b][m][n] = (f32x4){0.f, 0.f, 0.f, 0.f};
    bf16x8 At[4][2], B0[2][2], B1[2][2];
    unsigned offA[2][2];
    S.a_offs(cur, R0, c2, offA);
    const char* Ab = (const char*)g.A;
    const char* cB = (const char*)g.Bt + (size_t)cur.brow * g.ldb * 2;
    PG_STAGE(PG_SB(0, 0), cB, voffB); PG_STAGE(PG_SB(0, 1), cB + hstepB, voffB); PG_STAGE(PG_SA(0, 0), Ab, offA[0]); PG_STAGE(PG_SA(0, 1), Ab, offA[1]);
    if (wr == 1) PG_BAR;
    PG_WAIT_V(2); PG_BAR;
    PG_STAGE(PG_SB(1, 0), cB + kstep, voffB); PG_STAGE(PG_SA(1, 0), Ab + kstep, offA[0]); PG_STAGE(PG_SB(1, 1), cB + hstepB + kstep, voffB);
    PG_WAIT_V(6); PG_BAR;
    for (;;) {
        const bool has_next = S.next(ui + 1, nxt);
        const char* nB = has_next ? (const char*)g.Bt + (size_t)nxt.brow * g.ldb * 2 : cB;
        unsigned offN[2][2]; S.a_offs(has_next ? nxt : cur, R0, c2, offN);
#pragma clang loop unroll(disable)
        for (int t = 0; t < nt; t += 2) {
            const bool last = (t == nt - 2);
            const char* a1 = Ab + (size_t)(t + 1) * kstep;
            const char* a2 = last ? Ab : Ab + (size_t)(t + 2) * kstep; const char* b2 = last ? nB : cB + (size_t)(t + 2) * kstep;
            const char* a3 = a2 + kstep; const char* b3 = b2 + kstep;
            PG_LDB(B0, 0, 0); PG_LDB(B1, 0, 1); PG_SCHED; PG_LDA(At, 0, 0); PG_STAGE(PG_SA(1, 1), a1, offA[1]);
#pragma unroll
            for (int h_ = 0; h_ < 2; ++h_)
#pragma unroll
                for (int i_ = 0; i_ < 2; ++i_) offA[h_][i_] = last ? offN[h_][i_] : offA[h_][i_];
            PG_WAIT_V(8); PG_WAIT_L(0); PG_BAR; PG_MMA(0, 0, At, B0); PG_MMA(0, 1, At, B1); PG_BAR; PG_SCHED;
            PG_LDA(At, 0, 1); PG_STAGE(PG_SB(0, 0), b2, voffB); PG_STAGE(PG_SB(0, 1), b2 + hstepB, voffB); PG_STAGE(PG_SA(0, 0), a2, offA[0]);
            PG_WAIT_V(8); PG_WAIT_L(0); PG_BAR; PG_MMA(1, 0, At, B0); PG_MMA(1, 1, At, B1); PG_BAR; PG_SCHED;
            PG_LDB(B0, 1, 0); PG_LDB(B1, 1, 1); PG_SCHED; PG_LDA(At, 1, 0); PG_STAGE(PG_SA(0, 1), a2, offA[1]);
            PG_WAIT_V(8); PG_WAIT_L(0); PG_BAR; PG_MMA(0, 0, At, B0); PG_MMA(0, 1, At, B1); PG_BAR; PG_SCHED;
            PG_LDA(At, 1, 1); PG_STAGE(PG_SB(1, 0), b3, voffB); PG_STAGE(PG_SB(1, 1), b3 + hstepB, voffB); PG_STAGE(PG_SA(1, 0), a3, offA[0]);
            PG_WAIT_V(8); PG_WAIT_L(0); PG_BAR; PG_MMA(1, 0, At, B0); PG_MMA(1, 1, At, B1); PG_BAR; PG_SCHED;
        }
        if constexpr (ALIGN_EPI) { if (wr == 0) PG_BAR; }
        { int fr_e = fr, fq_e = fq; asm volatile("" : "+v"(fr_e), "+v"(fq_e));
          E(acc, cur, wr, wc, fr_e, fq_e); }
        __builtin_amdgcn_s_waitcnt(0x0F70);
        if (!has_next) break;
#pragma unroll
        for (int a = 0; a < 2; ++a)
#pragma unroll
            for (int b = 0; b < 2; ++b)
#pragma unroll
                for (int m = 0; m < 4; ++m)
#pragma unroll
                    for (int n = 0; n < 2; ++n) acc[a][b][m][n] = (f32x4){0.f, 0.f, 0.f, 0.f};
        cur = nxt; cB = nB; ++ui;
        if constexpr (ALIGN_EPI) { if (wr == 1) PG_BAR; }
    }
    PG_WAIT_V(0);
    if constexpr (!ALIGN_EPI) { if (wr == 0) PG_BAR; }
    PG_BAR;
#undef PG_SA
#undef PG_SB
#undef PG_STAGE
#undef PG_LDA
#undef PG_LDB
#undef PG_MMA
#undef PG_WAIT_V
#undef PG_WAIT_L
#undef PG_BAR
#undef PG_SCHED
}
}

typedef GAS unsigned gu32;
#define XB_TMO      128
#define XB_XCNT(j)  (256  + 64 * (j))
#define XB_XSUB(j)  (1280 + 64 * (j))
#define XB_XGEN(j)  (2304 + 64 * (j))
#define XB_TOP      3328
#define XB_TOPGEN   3392
#define XCD_BAR_WORDS 3456
#define XB_SPIN_CAP (1u << 18)
__device__ __forceinline__ unsigned xb_ld(unsigned* p)              { return __hip_atomic_load(p, __ATOMIC_RELAXED, __HIP_MEMORY_SCOPE_AGENT); }
__device__ __forceinline__ unsigned xb_add(unsigned* p, unsigned v) { return __hip_atomic_fetch_add(p, v, __ATOMIC_RELAXED, __HIP_MEMORY_SCOPE_AGENT); }
__device__ __forceinline__ unsigned xb_xcc_id() { return (unsigned)__builtin_amdgcn_s_getreg((3 << 11) | 20) & 0xFu; }
#define XB_SPIN(cond, bar) do { unsigned _sp = 0; while (cond) { __builtin_amdgcn_s_sleep(1); \
    if ((++_sp & 255u) == 0u) { if (xb_ld(&(bar)[XB_TMO])) break; if (_sp > XB_SPIN_CAP) { atomicAdd(&(bar)[XB_TMO], 1u); break; } } } } while (0)
struct XcdBarrier { unsigned* bar; unsigned x; volatile LAS unsigned* st; };
__device__ __forceinline__ XcdBarrier xcd_barrier_post(unsigned* bar, volatile LAS unsigned* st) {
    XcdBarrier b; b.bar = bar; b.x = xb_xcc_id(); b.st = st;
    if (threadIdx.x == 0) (void)xb_add(&bar[XB_XCNT(b.x)], 1u);
    return b;
}
__device__ __forceinline__ void xcd_barrier_complete(unsigned* bar, unsigned x, unsigned& nloc, unsigned& nx) {
    const unsigned G = gridDim.x * gridDim.y * gridDim.z;
    unsigned sum, cnt, mine, sp = 0u;
    for (;;) {
        sum = 0u; cnt = 0u; mine = 0u;
#pragma unroll
        for (unsigned j = 0; j < 16; ++j) { const unsigned c = xb_ld(&bar[XB_XCNT(j)]); sum += c; cnt += (c > 0u) ? 1u : 0u; mine = (j == x) ? c : mine; }
        if (sum == G) break;
        __builtin_amdgcn_s_sleep(1);
        if ((++sp & 255u) == 0u) { if (xb_ld(&bar[XB_TMO])) break; if (sp > XB_SPIN_CAP) { atomicAdd(&bar[XB_TMO], 1u); break; } }
    }
    nloc = mine > 0u ? mine : 1u; nx = cnt > 0u ? cnt : 1u;
}
__device__ __forceinline__ void xcd_barrier(const XcdBarrier& b) {
    asm volatile("s_waitcnt vmcnt(0)" ::: "memory");
    __syncthreads();
    if (threadIdx.x == 0) {
        unsigned* bar = b.bar;
        __builtin_amdgcn_s_waitcnt(0);
        unsigned nloc = b.st[0], nx = b.st[1];
        if (nloc == 0u) { xcd_barrier_complete(bar, b.x, nloc, nx); b.st[0] = nloc; b.st[1] = nx; }
        const unsigned old = xb_add(&bar[XB_XSUB(b.x)], 1u);
        const unsigned gen = old / nloc;
        if (old + 1u == (gen + 1u) * nloc) {
            __builtin_amdgcn_fence(__ATOMIC_RELEASE, "agent");
            asm volatile("s_waitcnt vmcnt(0)" ::: "memory");
            const unsigned og = xb_add(&bar[XB_TOP], 1u);
            const unsigned tg = og / nx;
            if (og + 1u == (tg + 1u) * nx) xb_add(&bar[XB_TOPGEN], 1u);
            else XB_SPIN(xb_ld(&bar[XB_TOPGEN]) == tg, bar);
            __builtin_amdgcn_fence(__ATOMIC_ACQUIRE, "agent");
            xb_add(&bar[XB_XGEN(b.x)], 1u);
            asm volatile("s_waitcnt vmcnt(0)" ::: "memory");
        } else {
            XB_SPIN(xb_ld(&bar[XB_XGEN(b.x)]) == gen, bar);
            __builtin_amdgcn_fence(__ATOMIC_ACQUIRE, "agent");
            asm volatile("s_waitcnt vmcnt(0)" ::: "memory");
        }
    }
    __syncthreads();
}
constexpr int NWAVES = 8;
constexpr size_t MiB = 1u << 20;
constexpr int LDS_BYTES = 147456;
constexpr int RING_BYTES = 131072;
constexpr int TAB_OFF = RING_BYTES;
constexpr int TAB_BYTES = 12288;
constexpr int MISC_OFF = TAB_OFF + TAB_BYTES;
constexpr size_t WS_CTL = 0;
constexpr size_t CTL_ZERO_BYTES = 64 * 1024;
constexpr int CW_BAR = 1024;
constexpr int CW_CNT = 8192;
constexpr size_t WS_SSP = 1 * MiB;
constexpr size_t WS_SSP1 = 6 * MiB + 512 * 1024;
constexpr size_t WS_RSTD = 2 * MiB;
constexpr size_t WS_LSLOT = 2 * MiB + 256 * 1024;
constexpr size_t WS_LW = WS_LSLOT + 2 * MiB;
constexpr size_t WS_WRT = 7 * MiB + 512 * 1024;
constexpr size_t WS_WSM = 8 * MiB;
constexpr size_t OFF_WINA = 0, OFF_WOUTA = 6 * MiB, OFF_WINB = 8 * MiB, OFF_WGATE = 12 * MiB, OFF_WOUTB = 14 * MiB, OFF_WPLEG = 16 * MiB, OFF_WPLE = 20 * MiB;
constexpr size_t WS_WMOE = 30 * MiB;
constexpr size_t WS_HB = 222 * MiB;
constexpr size_t WS_PW = 254 * MiB;
constexpr size_t WS_PB = 286 * MiB;
constexpr size_t WS_R0 = 302 * MiB, RSZ = 32 * MiB;
constexpr size_t WS_END = WS_R0 + 6 * RSZ + 28 * MiB;
#define WS_R(i) (WS_R0 + (size_t)(i) * RSZ)

#define RLX_AGENT __ATOMIC_RELAXED, __HIP_MEMORY_SCOPE_AGENT
#define LDS_WAIT() asm volatile("s_waitcnt lgkmcnt(0)" ::: "memory")
#define VM_WAIT() asm volatile("s_waitcnt vmcnt(0)" ::: "memory")
__device__ __forceinline__ unsigned pk2(float lo, float hi) { return pg::cvt_pk_bf16(lo, hi); }
__device__ __forceinline__ float bf_lo(unsigned w) { return (float)__builtin_bit_cast(half2v, w).x; }
__device__ __forceinline__ float bf_hi(unsigned w) { return (float)__builtin_bit_cast(half2v, w).y; }
__device__ __forceinline__ float wave_sum(float v) {
#pragma unroll
    for (int o = 1; o < 64; o <<= 1) v += __shfl_xor(v, o);
    return v;
}
__device__ __forceinline__ float fsigm(float x) { return __builtin_amdgcn_rcpf(1.0f + __builtin_amdgcn_exp2f(-1.4426950408889634f * x)); }

__device__ __forceinline__ int map_lin8(int c) { const int q = c & 31; return (c & ~31) + 16 * ((q >> 2) & 1) + 4 * (q >> 3) + (q & 3); }
__device__ __forceinline__ int map_pair(int ch, int type) { return 256 * (ch >> 7) + 128 * ((ch >> 6) & 1) + 32 * ((ch >> 4) & 3) + 16 * type + (ch & 15); }

struct Args { const float* in[28]; float* out; unsigned char* ws; int ph_lo, ph_hi; };

struct Frame {
    LAS unsigned char* lds;
    volatile LAS unsigned* MISC;
    int tid, lane, wave, vcu, G;
};

struct PrepJob { const float* W; int ldw, K, ncols, nbatch; size_t sbs; const float* gain; bf16_t* dst; size_t dbs; int mode, type; };
__device__ __forceinline__ void prep_item(const PrepJob& J, LAS float* scr, int item, int lane) {
    const int nblk = J.ncols / 64, per = (J.K / 64) * nblk, b = item / per, r = item % per, kb = r / nblk, nb = r % nblk, k0 = 64 * kb, n0 = 64 * nb;
    const float* W = J.W + (size_t)b * J.sbs; bf16_t* WT = J.dst + (size_t)b * J.dbs;
    const int kr = lane >> 4, nq = lane & 15;
    f32x4 v[16];
#pragma unroll
    for (int i = 0; i < 16; ++i) v[i] = *(const GAS f32x4*)(W + (size_t)(k0 + 4 * i + kr) * J.ldw + n0 + 4 * nq);
    if (J.gain) {
#pragma unroll
        for (int i = 0; i < 16; ++i) v[i] = v[i] * J.gain[k0 + 4 * i + kr]; }
#pragma unroll
    for (int i = 0; i < 16; ++i) { LAS float* d = scr + (4 * i + kr) * 65 + 4 * nq; d[0] = v[i][0]; d[1] = v[i][1]; d[2] = v[i][2]; d[3] = v[i][3]; }
    LDS_WAIT(); asm volatile("" ::: "memory");
    const int c = lane & 7;
#pragma unroll
    for (int j = 0; j < 8; ++j) { const int n = (lane >> 3) + 8 * j; const LAS float* s = scr + (8 * c) * 65 + n;
        u32x4 o; o.x = pk2(s[0 * 65], s[1 * 65]); o.y = pk2(s[2 * 65], s[3 * 65]); o.z = pk2(s[4 * 65], s[5 * 65]); o.w = pk2(s[6 * 65], s[7 * 65]);
        const int col = n0 + n; const int drow = (J.mode == 0) ? map_lin8(col) : map_pair(col, J.type);
        *(GAS u32x4*)(WT + (size_t)drow * J.K + k0 + 8 * c) = o; }
    LDS_WAIT(); asm volatile("" ::: "memory");
}
__device__ __forceinline__ bool prep_job(const Args& a, int j, PrepJob& J) {
    unsigned char* ws = a.ws; bf16_t* wsm = (bf16_t*)(ws + WS_WSM);
    const float* norm_mix = a.in[2]; const float* norm_ffn = a.in[15]; const float* norm_ple = a.in[23];
    J.sbs = 0; J.dbs = 0; J.nbatch = 1; J.gain = nullptr; J.type = 0; J.mode = 0;
    switch (j) {
    case 0: J = PrepJob{a.in[3], 3 * D, D, D, 1, 0, norm_mix, wsm + OFF_WINA / 2 + (size_t)2048 * D, 0, 0, 0}; return true;
    case 1: J = PrepJob{a.in[3] + D, 3 * D, D, D, 1, 0, norm_mix, wsm + OFF_WINA / 2, 0, 1, 0}; return true;
    case 2: J = PrepJob{a.in[3] + 2 * D, 3 * D, D, D, 1, 0, norm_mix, wsm + OFF_WINA / 2, 0, 1, 1}; return true;
    case 3: J = PrepJob{a.in[5], D, D, D, 1, 0, nullptr, wsm + OFF_WOUTA / 2, 0, 0, 0}; return true;
    case 4: J = PrepJob{a.in[6], 2 * D, D, 2 * D, 1, 0, norm_mix + D, wsm + OFF_WINB / 2, 0, 0, 0}; return true;
    case 5: J = PrepJob{a.in[9], 256, 256, 256, 8, (size_t)256 * 256, nullptr, wsm + OFF_WGATE / 2, (size_t)512 * 256, 1, 0}; return true;
    case 6: J = PrepJob{a.in[11], 256, 256, 256, 8, (size_t)256 * 256, nullptr, wsm + OFF_WGATE / 2, (size_t)512 * 256, 1, 1}; return true;
    case 7: J = PrepJob{a.in[14], D, D, D, 1, 0, nullptr, wsm + OFF_WOUTB / 2, 0, 0, 0}; return true;
    case 8: J = PrepJob{a.in[25], D, D, D, 1, 0, norm_ple, wsm + OFF_WPLEG / 2, 0, 0, 0}; return true;
    case 9: J = PrepJob{a.in[25] + (size_t)D * D, D, D, D, 1, 0, norm_ple + D, wsm + OFF_WPLEG / 2 + (size_t)D * D, 0, 0, 0}; return true;
    case 10: J = PrepJob{a.in[24], D, 256, D, 2, (size_t)256 * D, nullptr, wsm + OFF_WPLE / 2, (size_t)D * 256, 0, 0}; return true;
    case 11: case 12: { const int L = j - 11; bf16_t* base = (bf16_t*)(ws + WS_WMOE + (size_t)L * 96 * MiB);
        J = PrepJob{a.in[20] + (size_t)L * 32 * D * 512, 512, D, 512, 32, (size_t)D * 512, norm_ffn + L * D, base, (size_t)1024 * D, 1, 0}; return true; }
    case 13: case 14: { const int L = j - 13; bf16_t* base = (bf16_t*)(ws + WS_WMOE + (size_t)L * 96 * MiB);
        J = PrepJob{a.in[21] + (size_t)L * 32 * D * 512, 512, D, 512, 32, (size_t)D * 512, norm_ffn + L * D, base, (size_t)1024 * D, 1, 1}; return true; }
    case 15: case 16: { const int L = j - 15; bf16_t* base = (bf16_t*)(ws + WS_WMOE + (size_t)L * 96 * MiB + 64 * MiB);
        J = PrepJob{a.in[22] + (size_t)L * 32 * 512 * D, D, 512, D, 32, (size_t)512 * D, nullptr, base, (size_t)1024 * 512, 0, 0}; return true; }
    default: return false;
    }
}
constexpr int N_PREP_JOBS = 17;
__device__ __forceinline__ void p0_prologue(Frame& F, const Args& a, int job_lo, int job_hi) {
    LAS float* scr = (LAS float*)(F.lds + F.wave * 16640);
    const int gw = F.vcu * NWAVES + F.wave, NGW = F.G * NWAVES;
    for (int j = job_lo; j < job_hi; ++j) {
        PrepJob J; if (!prep_job(a, j, J)) break;
        const int items = J.nbatch * (J.K / 64) * (J.ncols / 64);
        for (int it = gw; it < items; it += NGW) prep_item(J, scr, it, F.lane);
    }
    {
        float* wrt = (float*)(a.ws + WS_WRT);
        for (int i = gw * 64 + F.lane; i < 2 * 48 * D; i += NGW * 64) { const int L = i / (48 * D), r = (i / D) % 48, k = i % D; const float g = a.in[15][L * D + k];
            wrt[i] = r < 4 ? g * a.in[16][((size_t)L * D + k) * 4 + r] : (r < 36 ? g * a.in[18][((size_t)L * D + k) * 32 + (r - 4)] : 0.f); }
    }
    const float* x = a.in[0]; bf16_t* xb = (bf16_t*)(a.ws + WS_R(0)); float* rstd = (float*)(a.ws + WS_RSTD);
    for (int m = gw; m < NTOK; m += NGW) {
        const GAS f32x4* xr = (const GAS f32x4*)(x + (size_t)m * D) + F.lane;
        f32x4 v[4]; float s = 0.f;
#pragma unroll
        for (int j = 0; j < 4; ++j) { v[j] = xr[64 * j]; s += (v[j].x * v[j].x + v[j].y * v[j].y) + (v[j].z * v[j].z + v[j].w * v[j].w); }
        s = wave_sum(s);
        GAS u32x2* o8 = (GAS u32x2*)(xb + (size_t)m * D) + F.lane;
#pragma unroll
        for (int j = 0; j < 4; ++j) { u32x2 w; w.x = pk2(v[j].x, v[j].y); w.y = pk2(v[j].z, v[j].w); o8[64 * j] = w; }
        if (F.lane == 0) rstd[m] = 1.0f / sqrtf(s * (1.0f / D) + EPS);
    }
    const GAS f32x4* p4 = (const GAS f32x4*)a.in[1]; GAS u32x2* pb = (GAS u32x2*)(a.ws + WS_PB);
    const size_t n4 = (size_t)2 * NTOK * 256 / 4;
    for (size_t i = (size_t)gw * 64 + F.lane; i < n4; i += (size_t)NGW * 64) { const f32x4 v = p4[i]; u32x2 w; w.x = pk2(v.x, v.y); w.y = pk2(v.z, v.w); pb[i] = w; }
}

struct DenseSched {
    pg::DenseOrder O; int lda2;
    __device__ void init(int nN, int G, int c, int lda) { O.init(NTOK / 256, nN, G, c); lda2 = lda * 2; }
    __device__ bool next(int i, pg::Unit& u) const { int pm, pn; if (!O.tile(i, pm, pn)) return false; u.arow = pm * 256; u.acol = 0; u.brow = pn * 256; u.orow = pm * 256; u.pn = pn; u.aux = 0; return true; }
    __device__ __forceinline__ void a_offs(const pg::Unit& u, int R0, unsigned c2, unsigned (&o)[2][2]) const {
#pragma unroll
        for (int h = 0; h < 2; ++h)
#pragma unroll
            for (int i = 0; i < 2; ++i) o[h][i] = (unsigned)(u.arow + h * 128 + i * 64 + R0) * (unsigned)lda2 + (unsigned)u.acol * 2u + c2;
    }
};

struct EpiInA {
    bf16_t* G; bf16_t* Bg; const float* rstd;
    __device__ __forceinline__ void operator()(const f32x4 (&acc)[2][2][4][2], const pg::Unit& u, int wr, int wc, int fr, int fq) const {
        const int row0 = u.orow + wr * 64 + fr;
        if (u.pn < 8) {
            const int col0 = u.pn * 128 + wc * 16 + fq * 4;
#pragma unroll
            for (int ai = 0; ai < 2; ++ai)
#pragma unroll
                for (int m = 0; m < 4; ++m) { const int row = row0 + ai * 128 + m * 16; const float s = rstd[row]; const float s2 = s * s;
#pragma unroll
                    for (int bj = 0; bj < 2; ++bj) { const f32x4 c = acc[ai][bj][m][0], h = acc[ai][bj][m][1];
                        u32x2 w; w.x = pg::cvt_pk_bf16(c[0] * h[0] * s2, c[1] * h[1] * s2); w.y = pg::cvt_pk_bf16(c[2] * h[2] * s2, c[3] * h[3] * s2);
                        *(u32x2*)(G + (size_t)row * D + col0 + bj * 64) = w; } }
        } else {
            const int col0 = (u.pn - 8) * 256 + wc * 32 + fq * 8;
#pragma unroll
            for (int ai = 0; ai < 2; ++ai)
#pragma unroll
                for (int m = 0; m < 4; ++m) { const int row = row0 + ai * 128 + m * 16; const float s = rstd[row];
#pragma unroll
                    for (int bj = 0; bj < 2; ++bj) { const f32x4 v0 = acc[ai][bj][m][0] * s, v1 = acc[ai][bj][m][1] * s;
                        u32x4 w; w.x = pg::cvt_pk_bf16(v0[0], v0[1]); w.y = pg::cvt_pk_bf16(v0[2], v0[3]); w.z = pg::cvt_pk_bf16(v1[0], v1[1]); w.w = pg::cvt_pk_bf16(v1[2], v1[3]);
                        *(u32x4*)(Bg + (size_t)row * D + col0 + bj * 128) = w; } }
        }
    }
};

struct EpiResid {
    const float* resid; float* Hf; bf16_t* Hb; float* ssp;
    __device__ __forceinline__ void operator()(const f32x4 (&acc)[2][2][4][2], const pg::Unit& u, int wr, int wc, int fr, int fq) const {
        const int row0 = u.orow + wr * 64 + fr, col0 = u.pn * 256 + wc * 32 + fq * 8;
#pragma unroll
        for (int ai = 0; ai < 2; ++ai)
#pragma unroll
            for (int m = 0; m < 4; ++m) { const int row = row0 + ai * 128 + m * 16; const size_t off = (size_t)row * D + col0; float ss = 0.f;
#pragma unroll
                for (int bj = 0; bj < 2; ++bj) {
                    const f32x4 r0 = *(const f32x4*)(resid + off + bj * 128), r1 = *(const f32x4*)(resid + off + bj * 128 + 4);
                    const f32x4 v0 = acc[ai][bj][m][0] + r0, v1 = acc[ai][bj][m][1] + r1;
                    ss += (v0[0] * v0[0] + v0[1] * v0[1]) + (v0[2] * v0[2] + v0[3] * v0[3]) + (v1[0] * v1[0] + v1[1] * v1[1]) + (v1[2] * v1[2] + v1[3] * v1[3]);
                    *(f32x4*)(Hf + off + bj * 128) = v0; *(f32x4*)(Hf + off + bj * 128 + 4) = v1;
                    u32x4 w; w.x = pk2(v0[0], v0[1]); w.y = pk2(v0[2], v0[3]); w.z = pk2(v1[0], v1[1]); w.w = pk2(v1[2], v1[3]);
                    *(u32x4*)(Hb + off + bj * 128) = w; }
                ss += __shfl_xor(ss, 16); ss += __shfl_xor(ss, 32);
                if (fq == 0) ssp[(size_t)row * 16 + u.pn * 4 + wc] = ss; }
    }
};

__device__ __forceinline__ void unpack8(const u32x4 w, float (&f)[8]) { f[0] = bf_lo(w.x); f[1] = bf_hi(w.x); f[2] = bf_lo(w.y); f[3] = bf_hi(w.y); f[4] = bf_lo(w.z); f[5] = bf_hi(w.z); f[6] = bf_lo(w.w); f[7] = bf_hi(w.w); }
__device__ __forceinline__ u32x4 pack8(const float (&f)[8]) { u32x4 w; w.x = pk2(f[0], f[1]); w.y = pk2(f[2], f[3]); w.z = pk2(f[4], f[5]); w.w = pk2(f[6], f[7]); return w; }
__device__ __forceinline__ void p2_conv_a(Frame& F, const bf16_t* G, const bf16_t* Bg, const float* cw, bf16_t* A2) {
    const int gw = F.vcu * NWAVES + F.wave, NGW = F.G * NWAVES;
    for (int it = gw; it < 2048; it += NGW) {
        const int r0 = (it >> 1) * 16, c0 = (it & 1) * 512 + F.lane * 8, t0 = r0 % SEQ;
        float w0[8], w1[8], w2[8];
#pragma unroll
        for (int j = 0; j < 8; ++j) { w0[j] = cw[c0 + j]; w1[j] = cw[D + c0 + j]; w2[j] = cw[2 * D + c0 + j]; }
        const bf16_t* gp = G + (size_t)r0 * D + c0; const bf16_t* bp = Bg + (size_t)r0 * D + c0; bf16_t* op = A2 + (size_t)r0 * D + c0;
        float gm[8], gc[8], gn[8];
        if (t0 > 0) unpack8(*(const GAS u32x4*)(gp - D), gm); else {
#pragma unroll
            for (int j = 0; j < 8; ++j) gm[j] = 0.f; }
        unpack8(*(const GAS u32x4*)gp, gc);
#pragma unroll 4
        for (int r = 0; r < 16; ++r) {
            if (t0 + r + 1 < SEQ) unpack8(*(const GAS u32x4*)(gp + (size_t)(r + 1) * D), gn); else {
#pragma unroll
                for (int j = 0; j < 8; ++j) gn[j] = 0.f; }
            float b[8], o[8]; unpack8(*(const GAS u32x4*)(bp + (size_t)r * D), b);
#pragma unroll
            for (int j = 0; j < 8; ++j) { o[j] = b[j] * (w0[j] * gm[j] + w1[j] * gc[j] + w2[j] * gn[j]); gm[j] = gc[j]; gc[j] = gn[j]; }
            *(GAS u32x4*)(op + (size_t)r * D) = pack8(o);
        }
    }
}

__device__ __forceinline__ void p4_router(Frame& F, const float* Hf, const float* wrt, const float* bg, const float* be, unsigned* gcnt, int* lslot, float* lw, float* rstd_out) {
    LAS float* Lg = (LAS float*)F.lds; LAS float* ssL = (LAS float*)(F.lds + 24576);
    LAS int* s_e = (LAS int*)(F.lds + 25088); LAS float* s_w = (LAS float*)(F.lds + 25600); LAS int* s_rank = (LAS int*)(F.lds + 26112);
    LAS unsigned* lcnt = (LAS unsigned*)(F.lds + 26624); LAS unsigned* lbase = (LAS unsigned*)(F.lds + 26752);
    const int tg = F.wave & 3, kh = F.wave >> 2, t = F.lane & 15, q = F.lane >> 4;
    for (int blk = F.vcu; blk < NTOK / 64; blk += F.G) {
        if (F.tid < 32) lcnt[F.tid] = 0u;
        const GAS float* xrow = (const GAS float*)Hf + (size_t)(blk * 64 + 16 * tg + t) * D + kh * 512 + 4 * q;
        const GAS float* wrow = (const GAS float*)wrt + (size_t)t * D + kh * 512 + 4 * q;
        f32x4 acc0 = {0.f, 0.f, 0.f, 0.f}, acc1 = acc0, acc2 = acc0; float ss = 0.f;
#pragma unroll 4
        for (int st = 0; st < 32; ++st) {
            const f32x4 xv = *(const GAS f32x4*)(xrow + 16 * st);
            const f32x4 w0 = *(const GAS f32x4*)(wrow + 16 * st), w1 = *(const GAS f32x4*)(wrow + 16 * D + 16 * st), w2 = *(const GAS f32x4*)(wrow + 32 * D + 16 * st);
            ss += (xv[0] * xv[0] + xv[1] * xv[1]) + (xv[2] * xv[2] + xv[3] * xv[3]);
#pragma unroll
            for (int s = 0; s < 4; ++s) {
                acc0 = __builtin_amdgcn_mfma_f32_16x16x4f32(w0[s], xv[s], acc0, 0, 0, 0);
                acc1 = __builtin_amdgcn_mfma_f32_16x16x4f32(w1[s], xv[s], acc1, 0, 0, 0);
                acc2 = __builtin_amdgcn_mfma_f32_16x16x4f32(w2[s], xv[s], acc2, 0, 0, 0); }
        }
        ss += __shfl_xor(ss, 16); ss += __shfl_xor(ss, 32);
        { LAS float* L = Lg + ((kh * 64) + 16 * tg + t) * 48 + 4 * q;
          *(LAS f32x4*)(L) = acc0; *(LAS f32x4*)(L + 16) = acc1; *(LAS f32x4*)(L + 32) = acc2;
          if (q == 0) ssL[kh * 64 + 16 * tg + t] = ss; }
        LDS_WAIT(); __syncthreads();
        if (F.tid < 64) {
            const int ts = F.tid, tok = blk * 64 + ts; LAS float* L0 = Lg + ts * 48; const LAS float* L1 = Lg + (64 + ts) * 48;
            const float rs = 1.0f / sqrtf((ssL[ts] + ssL[64 + ts]) * (1.0f / D) + EPS);
            for (int j = 0; j < 4; ++j) L0[j] = (L0[j] + L1[j]) * rs + bg[j];
            for (int j = 0; j < 32; ++j) L0[4 + j] = (L0[4 + j] + L1[4 + j]) * rs + be[j];
            int g = 0;
            for (int j = 1; j < 4; ++j) if (L0[j] > L0[g]) g = j;
            float sg = 0.f; for (int j = 0; j < 4; ++j) sg += expf(L0[j] - L0[g]);
            const float pgt = 1.0f / sg;
            LAS float* le = L0 + 4 + g * 8;
            int i0 = 0; for (int i = 1; i < 8; ++i) if (le[i] > le[i0]) i0 = i;
            int i1 = (i0 == 0) ? 1 : 0; for (int i = 0; i < 8; ++i) if (i != i0 && le[i] > le[i1]) i1 = i;
            const float e1 = expf(le[i1] - le[i0]); const float w0 = 1.0f / (1.0f + e1), w1 = e1 / (1.0f + e1);
            const int E0 = g * 8 + i0, E1 = g * 8 + i1;
            s_e[2 * ts] = E0; s_e[2 * ts + 1] = E1; s_w[2 * ts] = pgt * w0; s_w[2 * ts + 1] = pgt * w1;
            s_rank[2 * ts] = (int)__hip_atomic_fetch_add(&lcnt[E0], 1u, __ATOMIC_RELAXED, __HIP_MEMORY_SCOPE_WORKGROUP);
            s_rank[2 * ts + 1] = (int)__hip_atomic_fetch_add(&lcnt[E1], 1u, __ATOMIC_RELAXED, __HIP_MEMORY_SCOPE_WORKGROUP);
            rstd_out[tok] = rs;
        }
        LDS_WAIT(); __syncthreads();
        if (F.tid < 32) lbase[F.tid] = __hip_atomic_fetch_add(gcnt + F.tid, lcnt[F.tid], __ATOMIC_RELAXED, __HIP_MEMORY_SCOPE_AGENT);
        LDS_WAIT(); __syncthreads();
        if (F.tid < 128) { const int s = F.tid, E = s_e[s]; const unsigned pos = lbase[E] + (unsigned)s_rank[s]; const int tok = blk * 64 + (s >> 1);
            lslot[(size_t)E * CAP + pos] = 2 * tok + (s & 1); lw[(size_t)E * CAP + pos] = s_w[s]; }
        LDS_WAIT(); __syncthreads();
    }
}

constexpr int MAXU = 5;
struct MoeSched {
    LAS int* ud; int n; const LAS unsigned* tabA; int mode; int lda2;
    __device__ bool next(int i, pg::Unit& u) const { if (i >= n) return false; const int e = ud[4 * i], pn = ud[4 * i + 2], rbg = ud[4 * i + 3];
        u.arow = mode == 0 ? i * 256 : rbg * 256; u.acol = 0; u.brow = e * 1024 + pn * 256; u.orow = rbg * 256; u.pn = pn; u.aux = i; return true; }
    __device__ __forceinline__ void a_offs(const pg::Unit& u, int R0, unsigned c2, unsigned (&o)[2][2]) const {
#pragma unroll
        for (int h = 0; h < 2; ++h)
#pragma unroll
            for (int i = 0; i < 2; ++i) { const int r = h * 128 + i * 64 + R0;
                o[h][i] = (mode == 0 ? tabA[u.arow + r] : (unsigned)(u.arow + r) * (unsigned)lda2) + c2; }
    }
};
__device__ __forceinline__ int moe_setup(Frame& F, const unsigned* gcnt, const int* lslot, const float* lw, const float* rstd, int which) {
    LAS int* ud = (LAS int*)(F.lds + TAB_OFF); LAS unsigned* tabA = (LAS unsigned*)(F.lds + TAB_OFF + 128); LAS unsigned* tabB = (LAS unsigned*)(F.lds + TAB_OFF + 128 + MAXU * 1024);
    __syncthreads();
    if (F.tid == 0) {
        int n = 0, rbg = 0; const int c = F.vcu;
        for (int e = 0; e < NEXP; ++e) { const int nrb = ((int)gcnt[e] + 255) >> 8;
            for (int rb = 0; rb < nrb; ++rb, ++rbg)
                for (int pn = 0; pn < 4; ++pn) { const int L = 4 * rbg + pn; if ((L % F.G) == c && n < MAXU) { ud[4 * n] = e; ud[4 * n + 1] = rb; ud[4 * n + 2] = pn; ud[4 * n + 3] = rbg; ++n; } } }
        ud[4 * MAXU] = n;
    }
    __syncthreads();
    const int n = ud[4 * MAXU];
    for (int i = 0; i < n; ++i) {
        if (F.tid < 256) { const int e = ud[4 * i], rb = ud[4 * i + 1], idx = rb * 256 + F.tid; const bool ok = idx < (int)gcnt[e];
            const int slot = ok ? lslot[(size_t)e * CAP + idx] : 0;
            if (which == 0) { tabA[i * 256 + F.tid] = (unsigned)(slot >> 1) * (unsigned)(D * 2); tabB[i * 256 + F.tid] = __builtin_bit_cast(unsigned, rstd[slot >> 1]); }
            else { tabA[i * 256 + F.tid] = ok ? (unsigned)slot : 0xffffffffu; tabB[i * 256 + F.tid] = ok ? __builtin_bit_cast(unsigned, lw[(size_t)e * CAP + idx]) : 0u; } }
    }
    VM_WAIT(); LDS_WAIT();
    __syncthreads();
    return n;
}
struct EpiUp {
    bf16_t* HID; const LAS unsigned* tabB;
    __device__ __forceinline__ void operator()(const f32x4 (&acc)[2][2][4][2], const pg::Unit& u, int wr, int wc, int fr, int fq) const {
        const int r0 = wr * 64 + fr, col0 = u.pn * 128 + wc * 16 + fq * 4;
#pragma unroll
        for (int ai = 0; ai < 2; ++ai)
#pragma unroll
            for (int m = 0; m < 4; ++m) { const int r = r0 + ai * 128 + m * 16; const float s = __builtin_bit_cast(float, tabB[u.aux * 256 + r]);
#pragma unroll
                for (int bj = 0; bj < 2; ++bj) { const f32x4 g = acc[ai][bj][m][0] * s, v = acc[ai][bj][m][1] * s; float o[4];
#pragma unroll
                    for (int j = 0; j < 4; ++j) o[j] = g[j] * fsigm(g[j]) * v[j];
                    u32x2 w; w.x = pk2(o[0], o[1]); w.y = pk2(o[2], o[3]);
                    *(u32x2*)(HID + (size_t)(u.orow + r) * FEXP + col0 + bj * 64) = w; } }
    }
};
struct EpiDown {
    bf16_t* Y; const LAS unsigned* tabA; const LAS unsigned* tabB;
    __device__ __forceinline__ void operator()(const f32x4 (&acc)[2][2][4][2], const pg::Unit& u, int wr, int wc, int fr, int fq) const {
        const int r0 = wr * 64 + fr, col0 = u.pn * 256 + wc * 32 + fq * 8;
#pragma unroll
        for (int ai = 0; ai < 2; ++ai)
#pragma unroll
            for (int m = 0; m < 4; ++m) { const int r = r0 + ai * 128 + m * 16; const unsigned slot = tabA[u.aux * 256 + r]; const float w = __builtin_bit_cast(float, tabB[u.aux * 256 + r]);
                if (slot != 0xffffffffu) {
#pragma unroll
                    for (int bj = 0; bj < 2; ++bj) { const f32x4 v0 = acc[ai][bj][m][0] * w, v1 = acc[ai][bj][m][1] * w;
                        u32x4 o; o.x = pk2(v0[0], v0[1]); o.y = pk2(v0[2], v0[3]); o.z = pk2(v1[0], v1[1]); o.w = pk2(v1[2], v1[3]);
                        *(u32x4*)(Y + (size_t)slot * D + col0 + bj * 128) = o; } } }
    }
};
__device__ __forceinline__ void p7_combine(Frame& F, float* Hf, bf16_t* Hb, const bf16_t* Y, float* ssp) {
    DenseSched S; S.init(4, F.G, (int)blockIdx.x, D);
    pg::Unit u;
    for (int i = 0; S.next(i, u); ++i) {
        for (int rr = F.wave; rr < 256; rr += NWAVES) {
            const int row = u.orow + rr, col = u.pn * 256 + F.lane * 4; const size_t off = (size_t)row * D + col;
            f32x4 h = *(const GAS f32x4*)(Hf + off);
            const u32x2 y0 = *(const GAS u32x2*)(Y + (size_t)(2 * row) * D + col), y1 = *(const GAS u32x2*)(Y + (size_t)(2 * row + 1) * D + col);
            h[0] += bf_lo(y0.x) + bf_lo(y1.x); h[1] += bf_hi(y0.x) + bf_hi(y1.x); h[2] += bf_lo(y0.y) + bf_lo(y1.y); h[3] += bf_hi(y0.y) + bf_hi(y1.y);
            *(GAS f32x4*)(Hf + off) = h;
            u32x2 w; w.x = pk2(h[0], h[1]); w.y = pk2(h[2], h[3]); *(GAS u32x2*)(Hb + off) = w;
            const float ss = wave_sum((h[0] * h[0] + h[1] * h[1]) + (h[2] * h[2] + h[3] * h[3]));
            if (F.lane < 4) ssp[(size_t)row * 16 + u.pn * 4 + F.lane] = F.lane == 0 ? ss : 0.f;
        }
    }
}

__device__ __forceinline__ float row_rstd(const float* ssp, int row) {
    const f32x4* p = (const f32x4*)(ssp + (size_t)row * 16); const f32x4 a = p[0], b = p[1], c = p[2], d = p[3];
    const float ss = ((a[0] + a[1]) + (a[2] + a[3])) + ((b[0] + b[1]) + (b[2] + b[3])) + ((c[0] + c[1]) + (c[2] + c[3])) + ((d[0] + d[1]) + (d[2] + d[3]));
    return 1.0f / sqrtf(ss * (1.0f / D) + EPS);
}
__device__ __forceinline__ float gelu_t(float x) {
    const float z = 1.5957691216057308f * (x + 0.044715f * x * x * x); return x * fsigm(z);
}
struct EpiLin {
    bf16_t* O0; bf16_t* O1; int split, act0, act1; const float* ssp;
    __device__ __forceinline__ void operator()(const f32x4 (&acc)[2][2][4][2], const pg::Unit& u, int wr, int wc, int fr, int fq) const {
        const bool first = u.pn < split; bf16_t* O = first ? O0 : O1; const int act = first ? act0 : act1;
        const int row0 = u.orow + wr * 64 + fr, col0 = (first ? u.pn : u.pn - split) * 256 + wc * 32 + fq * 8;
#pragma unroll
        for (int ai = 0; ai < 2; ++ai)
#pragma unroll
            for (int m = 0; m < 4; ++m) { const int row = row0 + ai * 128 + m * 16; const float s = ssp ? row_rstd(ssp, row) : 1.0f;
#pragma unroll
                for (int bj = 0; bj < 2; ++bj) { f32x4 v0 = acc[ai][bj][m][0] * s, v1 = acc[ai][bj][m][1] * s;
                    if (act == 1) {
#pragma unroll
                        for (int j = 0; j < 4; ++j) { v0[j] = gelu_t(v0[j]); v1[j] = gelu_t(v1[j]); } }
                    u32x4 w; w.x = pk2(v0[0], v0[1]); w.y = pk2(v0[2], v0[3]); w.z = pk2(v1[0], v1[1]); w.w = pk2(v1[2], v1[3]);
                    *(u32x4*)(O + (size_t)row * D + col0 + bj * 128) = w; }
                asm volatile("" ::: "memory"); __builtin_amdgcn_sched_barrier(0); }
    }
};
struct EpiPle {
    float* Hf; bf16_t* Hb; const float* ssp; float* ssp_out; const bf16_t* PW; const float* bias;
    __device__ __forceinline__ void operator()(const f32x4 (&acc)[2][2][4][2], const pg::Unit& u, int wr, int wc, int fr, int fq) const {
        const int row0 = u.orow + wr * 64 + fr, col0 = u.pn * 256 + wc * 32 + fq * 8;
        f32x4 bv[2][2];
#pragma unroll
        for (int bj = 0; bj < 2; ++bj) { bv[bj][0] = *(const f32x4*)(bias + col0 + bj * 128); bv[bj][1] = *(const f32x4*)(bias + col0 + bj * 128 + 4); }
#pragma unroll
        for (int ai = 0; ai < 2; ++ai)
#pragma unroll
            for (int m = 0; m < 4; ++m) { const int row = row0 + ai * 128 + m * 16; const size_t off = (size_t)row * D + col0; const float s = row_rstd(ssp, row); float ss = 0.f;
#pragma unroll
                for (int bj = 0; bj < 2; ++bj) {
                    f32x4 h0 = *(const f32x4*)(Hf + off + bj * 128), h1 = *(const f32x4*)(Hf + off + bj * 128 + 4);
                    const u32x4 pw = *(const u32x4*)(PW + off + bj * 128); float pf[8]; unpack8(pw, pf);
                    const f32x4 a0 = acc[ai][bj][m][0] * s + bv[bj][0], a1 = acc[ai][bj][m][1] * s + bv[bj][1];
#pragma unroll
                    for (int j = 0; j < 4; ++j) { h0[j] += fsigm(a0[j]) * pf[j]; h1[j] += fsigm(a1[j]) * pf[4 + j]; }
                    ss += (h0[0] * h0[0] + h0[1] * h0[1]) + (h0[2] * h0[2] + h0[3] * h0[3]) + (h1[0] * h1[0] + h1[1] * h1[1]) + (h1[2] * h1[2] + h1[3] * h1[3]);
                    *(f32x4*)(Hf + off + bj * 128) = h0; *(f32x4*)(Hf + off + bj * 128 + 4) = h1;
                    u32x4 w; w.x = pk2(h0[0], h0[1]); w.y = pk2(h0[2], h0[3]); w.z = pk2(h1[0], h1[1]); w.w = pk2(h1[2], h1[3]);
                    *(u32x4*)(Hb + off + bj * 128) = w; }
                ss += __shfl_xor(ss, 16); ss += __shfl_xor(ss, 32);
                if (fq == 0) ssp_out[(size_t)row * 16 + u.pn * 4 + wc] = ss;
                asm volatile("" ::: "memory"); __builtin_amdgcn_sched_barrier(0); }
    }
};
struct GateSched {
    pg::DenseOrder O;
    __device__ void init(int G, int c) { O.init(NTOK / 256, 16, G, c); }
    __device__ bool next(int i, pg::Unit& u) const { int pm, pn; if (!O.tile(i, pm, pn)) return false; u.arow = pm * 256; u.acol = ((pn >> 1) & 3) * 256; u.brow = pn * 256; u.orow = pm * 256; u.pn = pn; u.aux = 0; return true; }
    __device__ __forceinline__ void a_offs(const pg::Unit& u, int R0, unsigned c2, unsigned (&o)[2][2]) const {
#pragma unroll
        for (int h = 0; h < 2; ++h)
#pragma unroll
            for (int i = 0; i < 2; ++i) o[h][i] = (unsigned)(u.arow + h * 128 + i * 64 + R0) * (unsigned)(D * 2) + (unsigned)u.acol * 2u + c2;
    }
};
struct EpiGate {
    bf16_t* LA; bf16_t* GT; const bf16_t* ub; const float* br; const float* bi; const float* lam;
    __device__ __forceinline__ void operator()(const f32x4 (&acc)[2][2][4][2], const pg::Unit& u, int wr, int wc, int fr, int fq) const {
        const int d = u.pn >> 3, ch0 = ((u.pn >> 1) & 3) * 256 + (u.pn & 1) * 128 + wc * 16 + fq * 4, row0 = u.orow + wr * 64 + fr;
        f32x4 vbr[2], vbi[2], vsp[2];
#pragma unroll
        for (int bj = 0; bj < 2; ++bj) { vbr[bj] = *(const f32x4*)(br + d * D + ch0 + bj * 64); vbi[bj] = *(const f32x4*)(bi + d * D + ch0 + bj * 64);
            const f32x4 l = *(const f32x4*)(lam + d * D + ch0 + bj * 64);
#pragma unroll
            for (int j = 0; j < 4; ++j) vsp[bj][j] = -8.0f * 1.4426950408889634f * log1pf(expf(-l[j])); }
        bf16_t* la = LA + (size_t)d * NTOK * D; bf16_t* gt = GT + (size_t)d * NTOK * D;
#pragma unroll
        for (int ai = 0; ai < 2; ++ai)
#pragma unroll
            for (int m = 0; m < 4; ++m) { const int row = row0 + ai * 128 + m * 16;
#pragma unroll
                for (int bj = 0; bj < 2; ++bj) { const size_t off = (size_t)row * D + ch0 + bj * 64;
                    const u32x2 uw = *(const u32x2*)(ub + off); const float uf[4] = {bf_lo(uw.x), bf_hi(uw.x), bf_lo(uw.y), bf_hi(uw.y)};
                    const f32x4 rl = acc[ai][bj][m][0] + vbr[bj], il = acc[ai][bj][m][1] + vbi[bj]; float l2[4], g[4];
#pragma unroll
                    for (int j = 0; j < 4; ++j) { l2[j] = fsigm(rl[j]) * vsp[bj][j]; const float a2 = __builtin_amdgcn_exp2f(2.0f * l2[j]); g[j] = sqrtf(fmaxf(1.0f - a2, 0.f)) * (fsigm(il[j]) * uf[j]); }
                    u32x2 w; w.x = pk2(l2[0], l2[1]); w.y = pk2(l2[2], l2[3]); *(u32x2*)(la + off) = w;
                    w.x = pk2(g[0], g[1]); w.y = pk2(g[2], g[3]); *(u32x2*)(gt + off) = w; }
                asm volatile("" ::: "memory"); __builtin_amdgcn_sched_barrier(0); }
    }
};
__device__ __forceinline__ void p10_conv_b(Frame& F, const bf16_t* U, const float* cw, const float* cb, bf16_t* ub) {
    const int gw = F.vcu * NWAVES + F.wave, NGW = F.G * NWAVES;
    for (int it = gw; it < 2048; it += NGW) {
        const int r0 = (it >> 1) * 16, c0 = (it & 1) * 512 + F.lane * 8, t0 = r0 % SEQ;
        float w0[8], w1[8], w2[8], w3[8], bb[8];
#pragma unroll
        for (int j = 0; j < 8; ++j) { w0[j] = cw[c0 + j]; w1[j] = cw[D + c0 + j]; w2[j] = cw[2 * D + c0 + j]; w3[j] = cw[3 * D + c0 + j]; bb[j] = cb[c0 + j]; }
        const bf16_t* up = U + (size_t)r0 * D + c0; bf16_t* op = ub + (size_t)r0 * D + c0;
        float x0[8], x1[8], x2[8], x3[8];
        if (t0 > 0) { unpack8(*(const GAS u32x4*)(up - 2 * D), x0); unpack8(*(const GAS u32x4*)(up - D), x1); } else {
#pragma unroll
            for (int j = 0; j < 8; ++j) { x0[j] = 0.f; x1[j] = 0.f; } }
        unpack8(*(const GAS u32x4*)up, x2);
#pragma unroll 4
        for (int r = 0; r < 16; ++r) {
            if (t0 + r + 1 < SEQ) unpack8(*(const GAS u32x4*)(up + (size_t)(r + 1) * D), x3); else {
#pragma unroll
                for (int j = 0; j < 8; ++j) x3[j] = 0.f; }
            float o[8];
#pragma unroll
            for (int j = 0; j < 8; ++j) { o[j] = bb[j] + w0[j] * x0[j] + w1[j] * x1[j] + w2[j] * x2[j] + w3[j] * x3[j]; x0[j] = x1[j]; x1[j] = x2[j]; x2[j] = x3[j]; }
            *(GAS u32x4*)(op + (size_t)r * D) = pack8(o);
        }
    }
}
__device__ __forceinline__ float h2f(bf16_t v) { return (float)__builtin_bit_cast(_Float16, v); }
template <bool WRITE>
__device__ __forceinline__ void scan_pass(const GAS bf16_t* la, GAS bf16_t* gt, int d, LAS bf16_t* tl, LAS bf16_t* tg, int lane, float& h, float& lsum) {
    const int rr = lane >> 3, c8 = (lane & 7) * 8;
    u32x4 rl[4], rg[4];
    { const int b0 = d ? 7 : 0;
#pragma unroll
      for (int i = 0; i < 4; ++i) { const size_t o = (size_t)(b0 * 32 + 8 * i + rr) * D + c8; rl[i] = *(const GAS u32x4*)(la + o); rg[i] = *(const GAS u32x4*)(gt + o); } }
    for (int bi = 0; bi < 8; ++bi) {
        const int bt = d ? 7 - bi : bi;
#pragma unroll
        for (int i = 0; i < 4; ++i) { *(LAS u32x4*)(tl + (8 * i + rr) * 64 + c8) = rl[i]; *(LAS u32x4*)(tg + (8 * i + rr) * 64 + c8) = rg[i]; }
        if (bi < 7) { const int bn = d ? 6 - bi : bi + 1;
#pragma unroll
            for (int i = 0; i < 4; ++i) { const size_t o = (size_t)(bn * 32 + 8 * i + rr) * D + c8; rl[i] = *(const GAS u32x4*)(la + o); rg[i] = *(const GAS u32x4*)(gt + o); } }
#pragma unroll 8
        for (int s = 0; s < 32; ++s) { const int row = d ? 31 - s : s; const float l = h2f(tl[row * 64 + lane]), g = h2f(tg[row * 64 + lane]);
            h = __builtin_amdgcn_exp2f(l) * h + g; lsum += l;
            if (WRITE) tg[row * 64 + lane] = __builtin_bit_cast(bf16_t, (_Float16)h); }
        if (WRITE) {
#pragma unroll
            for (int i = 0; i < 4; ++i) { const u32x4 v = *(const LAS u32x4*)(tg + (8 * i + rr) * 64 + c8); *(GAS u32x4*)(gt + (size_t)(bt * 32 + 8 * i + rr) * D + c8) = v; } }
    }
}
__device__ __forceinline__ void p12_scan(Frame& F, const bf16_t* LA, bf16_t* GT) {
    LAS float* sA = (LAS float*)F.lds; LAS float* sS = sA + 512;
    LAS bf16_t* tl = (LAS bf16_t*)(F.lds + 4096 + F.wave * 8192); LAS bf16_t* tg = tl + 2048;
    for (int id = F.vcu; id < 256; id += F.G) {
        const int d = id >> 7, b = (id >> 4) & 7, cg = id & 15, chunk = F.wave;
        const size_t base = ((size_t)d * NTOK + (size_t)b * SEQ + (size_t)chunk * 256) * D + cg * 64;
        const GAS bf16_t* la = (const GAS bf16_t*)LA + base; GAS bf16_t* gt = (GAS bf16_t*)GT + base;
        float h = 0.f, lsum = 0.f;
        scan_pass<false>(la, gt, d, tl, tg, F.lane, h, lsum);
        sA[chunk * 64 + F.lane] = __builtin_amdgcn_exp2f(lsum); sS[chunk * 64 + F.lane] = h;
        LDS_WAIT(); __syncthreads();
        float c = 0.f;
        if (d == 0) { for (int cc = 0; cc < chunk; ++cc) c = sA[cc * 64 + F.lane] * c + sS[cc * 64 + F.lane]; }
        else { for (int cc = 7; cc > chunk; --cc) c = sA[cc * 64 + F.lane] * c + sS[cc * 64 + F.lane]; }
        h = c; lsum = 0.f;
        scan_pass<true>(la, gt, d, tl, tg, F.lane, h, lsum);
        LDS_WAIT(); __syncthreads();
    }
}
__device__ __forceinline__ void p13_mul(Frame& F, const bf16_t* YB, const bf16_t* HS, bf16_t* A2) {
    const size_t n8 = (size_t)NTOK * D / 8, stride = (size_t)F.G * NWAVES * 64;
    for (size_t i = ((size_t)F.vcu * NWAVES + F.wave) * 64 + F.lane; i < n8; i += stride) {
        float y[8], a[8], b[8], o[8]; unpack8(((const GAS u32x4*)YB)[i], y); unpack8(((const GAS u32x4*)HS)[i], a); unpack8(((const GAS u32x4*)HS)[n8 + i], b);
#pragma unroll
        for (int j = 0; j < 8; ++j) o[j] = y[j] * (a[j] + b[j]);
        ((GAS u32x4*)A2)[i] = pack8(o);
    }
}
__device__ __forceinline__ void p20_final(Frame& F, float* Hf, const float* ssp, const float* g) {
    DenseSched S; S.init(4, F.G, (int)blockIdx.x, D);
    pg::Unit u;
    for (int i = 0; S.next(i, u); ++i) {
        const f32x4 gv = *(const GAS f32x4*)(g + u.pn * 256 + F.lane * 4);
        for (int rr = F.wave; rr < 256; rr += NWAVES) {
            const int row = u.orow + rr; const size_t off = (size_t)row * D + u.pn * 256 + F.lane * 4;
            const float s = row_rstd(ssp, row);
            f32x4 h = *(const GAS f32x4*)(Hf + off); h = h * s * gv; *(GAS f32x4*)(Hf + off) = h;
        }
    }
}
__global__ void __launch_bounds__(NWAVES * 64, 2) mk_fwd(Args args) {
    extern __shared__ __attribute__((aligned(16))) unsigned char lds_[];
    Frame F;
    F.lds = (LAS unsigned char*)lds_;
    F.MISC = (volatile LAS unsigned*)(F.lds + MISC_OFF);
    F.tid = threadIdx.x; F.lane = F.tid & 63; F.wave = __builtin_amdgcn_readfirstlane(F.tid >> 6);
    F.G = gridDim.x; { const int bx = blockIdx.x; F.vcu = (F.G % 8 == 0) ? (bx % 8) * (F.G / 8) + bx / 8 : bx; }
    unsigned char* ws = args.ws;
    unsigned* ctl = (unsigned*)(ws + WS_CTL);
    for (int u = F.tid; u < (LDS_BYTES - MISC_OFF) / 4; u += NWAVES * 64) ((LAS unsigned*)(F.lds + MISC_OFF))[u] = 0u;
    __syncthreads();
    const int lo = args.ph_lo, hi = args.ph_hi;
    XcdBarrier bar; bar.bar = ctl + CW_BAR; bar.x = 0; bar.st = nullptr;
    if (hi - lo > 1) bar = xcd_barrier_post(ctl + CW_BAR, F.MISC + 8);
#define IN(k) (lo <= (k) && (k) < hi)
#define SEAM(k) do { if (IN(k) && IN((k) + 1)) { xcd_barrier(bar); if (REP_MASK & 0x80000000u) xcd_barrier(bar); } { int t_ = threadIdx.x; asm volatile("" : "+v"(t_)); F.tid = t_; F.lane = t_ & 63; } } while (0)
    bf16_t* wsm = (bf16_t*)(ws + WS_WSM);
    float* rstd = (float*)(ws + WS_RSTD);
    float* ssp0 = (float*)(ws + WS_SSP); float* ssp1 = (float*)(ws + WS_SSP1);
    float* Hf = args.out; bf16_t* Hb = (bf16_t*)(ws + WS_HB); bf16_t* PW = (bf16_t*)(ws + WS_PW); const bf16_t* pb = (const bf16_t*)(ws + WS_PB);
    const int c = (int)blockIdx.x;

    for (int rep_ = 0; rep_ < (((REP_MASK >> (0)) & 1) ? 2 : 1); ++rep_) if (IN(0)) { p0_prologue(F, args, 0, N_PREP_JOBS); }
    SEAM(0);
    {
            for (int rep_ = 0; rep_ < (((REP_MASK >> (1)) & 1) ? 2 : 1); ++rep_) if (IN(1)) {
                { pg::GemmDesc g{(const bf16_t*)(ws + WS_R(0)), D, wsm + OFF_WINA / 2, D, D};
                  DenseSched S; S.init(12, F.G, c, D);
                  EpiInA E{(bf16_t*)(ws + WS_R(1)), (bf16_t*)(ws + WS_R(2)), rstd};
                  pg::gemm_phase<EpiInA, DenseSched, true>(F.lds, g, S, E); }
                { pg::GemmDesc g{pb, 256, wsm + OFF_WPLE / 2, 256, 256};
                  DenseSched S; S.init(4, F.G, c, 256);
                  EpiLin E{PW, PW, 99, 0, 0, nullptr};
                  pg::gemm_phase<EpiLin, DenseSched, true>(F.lds, g, S, E); }
            }
            SEAM(1);
            for (int rep_ = 0; rep_ < (((REP_MASK >> (2)) & 1) ? 2 : 1); ++rep_) if (IN(2)) p2_conv_a(F, (const bf16_t*)(ws + WS_R(1)), (const bf16_t*)(ws + WS_R(2)), args.in[4], (bf16_t*)(ws + WS_R(3)));
            SEAM(2);
            for (int rep_ = 0; rep_ < (((REP_MASK >> (3)) & 1) ? 2 : 1); ++rep_) if (IN(3)) {
                pg::GemmDesc g{(const bf16_t*)(ws + WS_R(3)), D, wsm + OFF_WOUTA / 2, D, D};
                DenseSched S; S.init(4, F.G, c, D);
                EpiResid E{args.in[0], Hf, Hb, ssp0};
                pg::gemm_phase<EpiResid, DenseSched, true>(F.lds, g, S, E);
            }
            SEAM(3);
    }
    {
        const int PB = 4;
        unsigned* gcnt = ctl + CW_CNT + 0;
        int* lslot = (int*)(ws + WS_LSLOT); float* lw = (float*)(ws + WS_LW);
        bf16_t* wmoe = (bf16_t*)(ws + WS_WMOE + (size_t)0 * 96 * MiB);
        bf16_t* HID = (bf16_t*)(ws + WS_R(0)); bf16_t* Y = (bf16_t*)(ws + WS_R(2));
        for (int rep_ = 0; rep_ < (((REP_MASK >> (PB)) & 1) ? 2 : 1); ++rep_) if (IN(PB)) p4_router(F, Hf, (const float*)(ws + WS_WRT) + (size_t)0 * 48 * D, args.in[17] + 0 * 4, args.in[19] + 0 * 32, gcnt, lslot, lw, rstd);
        SEAM(PB);
        for (int rep_ = 0; rep_ < (((REP_MASK >> (PB + 1)) & 1) ? 2 : 1); ++rep_) if (IN(PB + 1)) {
            const int n = moe_setup(F, gcnt, lslot, lw, rstd, 0);
            MoeSched S{(LAS int*)(F.lds + TAB_OFF), n, (const LAS unsigned*)(F.lds + TAB_OFF + 128), 0, D * 2};
            pg::GemmDesc g{Hb, D, wmoe, D, D};
            EpiUp E{HID, (const LAS unsigned*)(F.lds + TAB_OFF + 128 + MAXU * 1024)};
            pg::gemm_phase<EpiUp, MoeSched, true>(F.lds, g, S, E);
        }
        SEAM(PB + 1);
        for (int rep_ = 0; rep_ < (((REP_MASK >> (PB + 2)) & 1) ? 2 : 1); ++rep_) if (IN(PB + 2)) {
            const int n = moe_setup(F, gcnt, lslot, lw, rstd, 1);
            MoeSched S{(LAS int*)(F.lds + TAB_OFF), n, (const LAS unsigned*)(F.lds + TAB_OFF + 128), 1, FEXP * 2};
            pg::GemmDesc g{HID, FEXP, wmoe + (size_t)32 * 1024 * D, FEXP, FEXP};
            EpiDown E{Y, (const LAS unsigned*)(F.lds + TAB_OFF + 128), (const LAS unsigned*)(F.lds + TAB_OFF + 128 + MAXU * 1024)};
            pg::gemm_phase<EpiDown, MoeSched, true>(F.lds, g, S, E);
        }
        SEAM(PB + 2);
        for (int rep_ = 0; rep_ < (((REP_MASK >> (PB + 3)) & 1) ? 2 : 1); ++rep_) if (IN(PB + 3)) p7_combine(F, Hf, Hb, Y, ssp0);
        SEAM(PB + 3);
        for (int rep_ = 0; rep_ < (((REP_MASK >> (PB + 4)) & 1) ? 2 : 1); ++rep_) if (IN(PB + 4)) {
            pg::GemmDesc g{Hb, D, wsm + OFF_WPLEG / 2 + (size_t)0 * D * D, D, D};
            DenseSched S; S.init(4, F.G, c, D);
            EpiPle E{Hf, Hb, ssp0, ssp1, PW, args.in[26] + 0 * D};
            pg::gemm_phase<EpiPle, DenseSched, true>(F.lds, g, S, E);
        }
        SEAM(PB + 4);
    }
    {
            bf16_t* YB = (bf16_t*)(ws + WS_R(0)); bf16_t* Ub = (bf16_t*)(ws + WS_R(1)); bf16_t* ub = (bf16_t*)(ws + WS_R(2));
            bf16_t* LA = (bf16_t*)(ws + WS_WMOE); bf16_t* GT = (bf16_t*)(ws + WS_R(3)); bf16_t* A2 = (bf16_t*)(ws + WS_R(5));
            for (int rep_ = 0; rep_ < (((REP_MASK >> (9)) & 1) ? 2 : 1); ++rep_) if (IN(9)) {
                { pg::GemmDesc g{Hb, D, wsm + OFF_WINB / 2, D, D};
                  DenseSched S; S.init(8, F.G, c, D);
                  EpiLin E{YB, Ub, 4, 1, 0, ssp1};
                  pg::gemm_phase<EpiLin, DenseSched, true>(F.lds, g, S, E); }
                { pg::GemmDesc g{pb + (size_t)NTOK * 256, 256, wsm + OFF_WPLE / 2 + (size_t)D * 256, 256, 256};
                  DenseSched S; S.init(4, F.G, c, 256);
                  EpiLin E{PW, PW, 99, 0, 0, nullptr};
                  pg::gemm_phase<EpiLin, DenseSched, true>(F.lds, g, S, E); }
            }
            SEAM(9);
            for (int rep_ = 0; rep_ < (((REP_MASK >> (10)) & 1) ? 2 : 1); ++rep_) if (IN(10)) p10_conv_b(F, Ub, args.in[7], args.in[8], ub);
            SEAM(10);
            for (int rep_ = 0; rep_ < (((REP_MASK >> (11)) & 1) ? 2 : 1); ++rep_) if (IN(11)) {
                pg::GemmDesc g{ub, D, wsm + OFF_WGATE / 2, 256, 256};
                GateSched S; S.init(F.G, c);
                EpiGate E{LA, GT, ub, args.in[10], args.in[12], args.in[13]};
                pg::gemm_phase<EpiGate, GateSched, true>(F.lds, g, S, E);
            }
            SEAM(11);
            for (int rep_ = 0; rep_ < (((REP_MASK >> (12)) & 1) ? 2 : 1); ++rep_) if (IN(12)) p12_scan(F, LA, GT);
            SEAM(12);
            for (int rep_ = 0; rep_ < (((REP_MASK >> (13)) & 1) ? 2 : 1); ++rep_) if (IN(13)) p13_mul(F, YB, GT, A2);
            SEAM(13);
            for (int rep_ = 0; rep_ < (((REP_MASK >> (14)) & 1) ? 2 : 1); ++rep_) if (IN(14)) {
                pg::GemmDesc g{A2, D, wsm + OFF_WOUTB / 2, D, D};
                DenseSched S; S.init(4, F.G, c, D);
                EpiResid E{Hf, Hf, Hb, ssp0};
                pg::gemm_phase<EpiResid, DenseSched, true>(F.lds, g, S, E);
            }
            SEAM(14);
    }
    {
        const int PB = 15;
        unsigned* gcnt = ctl + CW_CNT + 64;
        int* lslot = (int*)(ws + WS_LSLOT); float* lw = (float*)(ws + WS_LW);
        bf16_t* wmoe = (bf16_t*)(ws + WS_WMOE + (size_t)1 * 96 * MiB);
        bf16_t* HID = (bf16_t*)(ws + WS_R(0)); bf16_t* Y = (bf16_t*)(ws + WS_R(2));
        for (int rep_ = 0; rep_ < (((REP_MASK >> (PB)) & 1) ? 2 : 1); ++rep_) if (IN(PB)) p4_router(F, Hf, (const float*)(ws + WS_WRT) + (size_t)1 * 48 * D, args.in[17] + 1 * 4, args.in[19] + 1 * 32, gcnt, lslot, lw, rstd);
        SEAM(PB);
        for (int rep_ = 0; rep_ < (((REP_MASK >> (PB + 1)) & 1) ? 2 : 1); ++rep_) if (IN(PB + 1)) {
            const int n = moe_setup(F, gcnt, lslot, lw, rstd, 0);
            MoeSched S{(LAS int*)(F.lds + TAB_OFF), n, (const LAS unsigned*)(F.lds + TAB_OFF + 128), 0, D * 2};
            pg::GemmDesc g{Hb, D, wmoe, D, D};
            EpiUp E{HID, (const LAS unsigned*)(F.lds + TAB_OFF + 128 + MAXU * 1024)};
            pg::gemm_phase<EpiUp, MoeSched, true>(F.lds, g, S, E);
        }
        SEAM(PB + 1);
        for (int rep_ = 0; rep_ < (((REP_MASK >> (PB + 2)) & 1) ? 2 : 1); ++rep_) if (IN(PB + 2)) {
            const int n = moe_setup(F, gcnt, lslot, lw, rstd, 1);
            MoeSched S{(LAS int*)(F.lds + TAB_OFF), n, (const LAS unsigned*)(F.lds + TAB_OFF + 128), 1, FEXP * 2};
            pg::GemmDesc g{HID, FEXP, wmoe + (size_t)32 * 1024 * D, FEXP, FEXP};
            EpiDown E{Y, (const LAS unsigned*)(F.lds + TAB_OFF + 128), (const LAS unsigned*)(F.lds + TAB_OFF + 128 + MAXU * 1024)};
            pg::gemm_phase<EpiDown, MoeSched, true>(F.lds, g, S, E);
        }
        SEAM(PB + 2);
        for (int rep_ = 0; rep_ < (((REP_MASK >> (PB + 3)) & 1) ? 2 : 1); ++rep_) if (IN(PB + 3)) p7_combine(F, Hf, Hb, Y, ssp0);
        SEAM(PB + 3);
        for (int rep_ = 0; rep_ < (((REP_MASK >> (PB + 4)) & 1) ? 2 : 1); ++rep_) if (IN(PB + 4)) {
            pg::GemmDesc g{Hb, D, wsm + OFF_WPLEG / 2 + (size_t)1 * D * D, D, D};
            DenseSched S; S.init(4, F.G, c, D);
            EpiPle E{Hf, Hb, ssp0, ssp1, PW, args.in[26] + 1 * D};
            pg::gemm_phase<EpiPle, DenseSched, true>(F.lds, g, S, E);
        }
        SEAM(PB + 4);
    }
    for (int rep_ = 0; rep_ < (((REP_MASK >> (20)) & 1) ? 2 : 1); ++rep_) if (IN(20)) p20_final(F, Hf, ssp1, args.in[27]);
#undef IN
#undef SEAM
}
extern "C" void kernel_launch(void* const* d_in, const int* in_sizes, int n_in, void* d_out, int out_size, void* d_ws, size_t ws_size, hipStream_t stream) {
    static int grid = 0;
    if (grid == 0) {
        if (n_in != 28 || out_size != NTOK * D || ws_size < WS_END) { fprintf(stderr, "kernel_launch: unexpected problem (n_in %d, out %d, ws %zu < %zu)\n", n_in, out_size, ws_size, (size_t)WS_END); grid = -1; return; }
        int dev = 0, cus = 0, per_cu = 0;
        if (hipGetDevice(&dev) != hipSuccess || hipDeviceGetAttribute(&cus, hipDeviceAttributeMultiprocessorCount, dev) != hipSuccess) { grid = -1; return; }
        if (hipFuncSetAttribute((const void*)mk_fwd, hipFuncAttributeMaxDynamicSharedMemorySize, LDS_BYTES) != hipSuccess) { grid = -1; return; }
        if (hipOccupancyMaxActiveBlocksPerMultiprocessor(&per_cu, (const void*)mk_fwd, NWAVES * 64, LDS_BYTES) != hipSuccess || per_cu < 1) { fprintf(stderr, "kernel_launch: occupancy query says %d\n", per_cu); per_cu = 1; }
        (void)hipGetLastError();
        grid = cus;
    }
    if (grid < 0) return;
    (void)in_sizes;
    (void)hipMemsetAsync((char*)d_ws + WS_CTL, 0, CTL_ZERO_BYTES, stream);
    Args a{};
    for (int i = 0; i < 28; ++i) a.in[i] = (const float*)d_in[i];
    a.out = (float*)d_out; a.ws = (unsigned char*)d_ws; a.ph_lo = 0; a.ph_hi = 21;
    hipLaunchKernelGGL(mk_fwd, dim3(grid), dim3(NWAVES * 64), LDS_BYTES, stream, a);
}
```

```cpp
#include <hip/hip_runtime.h>
#include <cstdio>
#include <cstdint>
constexpr int D = 1024, BATCH = 8, SEQ = 2048, NTOK = BATCH * SEQ, PLE = 256, NEXP = 32, FEXP = 512, CAP = NTOK;
constexpr float EPS = 1e-6f;
constexpr unsigned REP_MASK = 0u; constexpr int TS_PHASE = -1;
#define LAS __attribute__((address_space(3)))
#define GAS __attribute__((address_space(1)))
typedef unsigned short bf16_t;
typedef short bf16x8 __attribute__((ext_vector_type(8)));
typedef _Float16 half8 __attribute__((ext_vector_type(8)));
typedef _Float16 half2v __attribute__((ext_vector_type(2)));
typedef float f32x4 __attribute__((ext_vector_type(4)));
typedef float f32x2 __attribute__((ext_vector_type(2)));
typedef unsigned u32x4 __attribute__((ext_vector_type(4)));
typedef unsigned u32x2 __attribute__((ext_vector_type(2)));
namespace pg {
constexpr int BM = 256, BK = 64, HALF = 128, HTB = HALF * BK * 2, STAGE_BYTES = 8 * HTB, NXCD = 8, WGM = 8;
__host__ __device__ __forceinline__ int lds_byte(int r, int c) { const int st = (r >> 4) * 2 + (c >> 5), rr = r & 15, cc = c & 31, ob = rr * 64 + cc * 2; return st * 1024 + (ob ^ (((ob >> 9) & 1) << 5)); }
__host__ __device__ __forceinline__ void stage_rc(int b, int& R, int& C) { const int st = b / 1024, sb = b % 1024, swz = sb ^ (((sb >> 9) & 1) << 5); R = (st >> 1) * 16 + swz / 64; C = (st & 1) * 32 + (swz % 64) / 2; }

struct Unit { int arow, acol, brow, orow, pn, aux; };
struct GemmDesc { const bf16_t* A; int lda; const bf16_t* Bt; int ldb; int K; };

struct DenseOrder {
    int nM, nN, nwg, G, c;
    __device__ __forceinline__ void init(int nM_, int nN_, int G_, int c_) { nM = nM_; nN = nN_; nwg = nM * nN; G = G_; c = c_; }
    __device__ __forceinline__ bool tile(int i, int& pm, int& pn) const {
        const long L = (long)i * G + c; if (L >= nwg) return false;
        int wgid = (int)L; { const int q = nwg / NXCD, r = nwg % NXCD, xcd = wgid % NXCD, off = wgid / NXCD; wgid = (xcd < r ? xcd * (q + 1) : r * (q + 1) + (xcd - r) * q) + off; }
        const int nig = WGM * nN, gid = wgid / nig, fm = gid * WGM, gsz = (nM - fm) < WGM ? (nM - fm) : WGM;
        pm = fm + ((wgid % nig) % gsz); pn = (wgid % nig) / gsz; return true;
    }
};

__device__ __forceinline__ unsigned cvt_pk_bf16(float lo, float hi) { half2v v; v.x = (_Float16)lo; v.y = (_Float16)hi; return __builtin_bit_cast(unsigned, v); }

template <class Epi, class Sched, bool ALIGN_EPI>
__device__ __forceinline__ void gemm_phase(LAS unsigned char* lds, const GemmDesc g, const Sched& S, const Epi& E) {
    int tid_ = threadIdx.x; asm volatile("" : "+v"(tid_));
    const int tid = tid_, wid = __builtin_amdgcn_readfirstlane(tid >> 6), lane = tid & 63, wr = wid >> 2, wc = wid & 3, fr = lane & 15, fq = lane >> 4;
    const int K = g.K, nt = K / BK;
    int R0, C0; stage_rc(tid * 16, R0, C0);
    unsigned voffB[2]; voffB[0] = (unsigned)(R0 * g.ldb + C0) * 2u; voffB[1] = voffB[0] + (unsigned)(64 * g.ldb) * 2u;
    const unsigned c2 = (unsigned)C0 * 2u;
    const size_t kstep = (size_t)(BK * 2);
    const size_t hstepB = (size_t)HALF * g.ldb * 2;
    const unsigned ldsw = (unsigned)wid * 1024u;
    const int aoff = lds_byte(wr * 64 + fr, fq * 8), boff = lds_byte(wc * 32 + fr, fq * 8);
#define PG_SA(b, h) (((b) * 2 + (h)) * HTB)
#define PG_SB(b, h) ((4 + (b) * 2 + (h)) * HTB)
#define PG_STAGE(bufoff, gbase, voff) do { _Pragma("unroll") for (int _i = 0; _i < 2; ++_i) \
        __builtin_amdgcn_global_load_lds((const unsigned*)((const char*)(gbase) + (voff)[_i]), (LAS unsigned*)(lds + (bufoff) + ldsw + _i * 8192), 16, 0, 0); } while (0)
#define PG_LDA(dst, b, h) do { _Pragma("unroll") for (int m = 0; m < 4; ++m) _Pragma("unroll") for (int k = 0; k < 2; ++k) dst[m][k] = *(const LAS bf16x8*)(lds + PG_SA(b, h) + aoff + m * 2048 + k * 1024); } while (0)
#define PG_LDB(dst, b, h) do { _Pragma("unroll") for (int n = 0; n < 2; ++n) _Pragma("unroll") for (int k = 0; k < 2; ++k) dst[n][k] = *(const LAS bf16x8*)(lds + PG_SB(b, h) + boff + n * 2048 + k * 1024); } while (0)
#define PG_MMA(ai, bj, At, Bt) do { __builtin_amdgcn_s_setprio(1); _Pragma("unroll") for (int m = 0; m < 4; ++m) _Pragma("unroll") for (int n = 0; n < 2; ++n) _Pragma("unroll") for (int k = 0; k < 2; ++k) \
        acc[ai][bj][m][n] = __builtin_amdgcn_mfma_f32_16x16x32_f16(__builtin_bit_cast(half8, Bt[n][k]), __builtin_bit_cast(half8, At[m][k]), acc[ai][bj][m][n], 0, 0, 0); __builtin_amdgcn_s_setprio(0); } while (0)
#define PG_WAIT_V(n) asm volatile("s_waitcnt vmcnt(" #n ")" ::: "memory")
#define PG_WAIT_L(n) asm volatile("s_waitcnt lgkmcnt(" #n ")" ::: "memory")
#define PG_BAR __builtin_amdgcn_s_barrier()
#define PG_SCHED __builtin_amdgcn_sched_barrier(0)
    Unit cur, nxt; int ui = 0;
    if (!S.next(0, cur)) return;
    f32x4 acc[2][2][4][2];
#pragma unroll
    for (int a = 0; a < 2; ++a)
#pragma unroll
        for (int b = 0; b < 2; ++b)
#pragma unroll
            for (int m = 0; m < 4; ++m)
#pragma unroll
                for (int n = 0; n < 2; ++n) acc[a][b][m][n] = (f32x4){0.f, 0.f, 0.f, 0.f};
    bf16x8 At[4][2], B0[2][2], B1[2][2];
    unsigned offA[2][2];
    S.a_offs(cur, R0, c2, offA);
    const char* Ab = (const char*)g.A;
    const char* cB = (const char*)g.Bt + (size_t)cur.brow * g.ldb * 2;
    PG_STAGE(PG_SB(0, 0), cB, voffB); PG_STAGE(PG_SB(0, 1), cB + hstepB, voffB); PG_STAGE(PG_SA(0, 0), Ab, offA[0]); PG_STAGE(PG_SA(0, 1), Ab, offA[1]);
    if (wr == 1) PG_BAR;
    PG_WAIT_V(2); PG_BAR;
    PG_STAGE(PG_SB(1, 0), cB + kstep, voffB); PG_STAGE(PG_SA(1, 0), Ab + kstep, offA[0]); PG_STAGE(PG_SB(1, 1), cB + hstepB + kstep, voffB);
    PG_WAIT_V(6); PG_BAR;
    for (;;) {
        const bool has_next = S.next(ui + 1, nxt);
        const char* nB = has_next ? (const char*)g.Bt + (size_t)nxt.brow * g.ldb * 2 : cB;
        unsigned offN[2][2]; S.a_offs(has_next ? nxt : cur, R0, c2, offN);
#pragma clang loop unroll(disable)
        for (int t = 0; t < nt; t += 2) {
            const bool last = (t == nt - 2);
            const char* a1 = Ab + (size_t)(t + 1) * kstep;
            const char* a2 = last ? Ab : Ab + (size_t)(t + 2) * kstep; const char* b2 = last ? nB : cB + (size_t)(t + 2) * kstep;
            const char* a3 = a2 + kstep; const char* b3 = b2 + kstep;
            PG_LDB(B0, 0, 0); PG_LDB(B1, 0, 1); PG_SCHED; PG_LDA(At, 0, 0); PG_STAGE(PG_SA(1, 1), a1, offA[1]);
#pragma unroll
            for (int h_ = 0; h_ < 2; ++h_)
#pragma unroll
                for (int i_ = 0; i_ < 2; ++i_) offA[h_][i_] = last ? offN[h_][i_] : offA[h_][i_];
            PG_WAIT_V(8); PG_WAIT_L(0); PG_BAR; PG_MMA(0, 0, At, B0); PG_MMA(0, 1, At, B1); PG_BAR; PG_SCHED;
            PG_LDA(At, 0, 1); PG_STAGE(PG_SB(0, 0), b2, voffB); PG_STAGE(PG_SB(0, 1), b2 + hstepB, voffB); PG_STAGE(PG_SA(0, 0), a2, offA[0]);
            PG_WAIT_V(8); PG_WAIT_L(0); PG_BAR; PG_MMA(1, 0, At, B0); PG_MMA(1, 1, At, B1); PG_BAR; PG_SCHED;
            PG_LDB(B0, 1, 0); PG_LDB(B1, 1, 1); PG_SCHED; PG_LDA(At, 1, 0); PG_STAGE(PG_SA(0, 1), a2, offA[1]);
            PG_WAIT_V(8); PG_WAIT_L(0); PG_BAR; PG_MMA(0, 0, At, B0); PG_MMA(0, 1, At, B1); PG_BAR; PG_SCHED;
            PG_LDA(At, 1, 1); PG_STAGE(PG_SB(1, 0), b3, voffB); PG_STAGE(PG_SB(1, 1), b3 + hstepB, voffB); PG_STAGE(PG_SA(1, 0), a3, offA[0]);
            PG_WAIT_V(8); PG_WAIT_L(0); PG_BAR; PG_MMA(1, 0, At, B0); PG_MMA(1, 1, At, B1); PG_BAR; PG_SCHED;
        }
        if constexpr (ALIGN_EPI) { if (wr == 0) PG_BAR; }
        { int fr_e = fr, fq_e = fq; asm volatile("" : "+v"(fr_e), "+v"(fq_e));
          E(acc, cur, wr, wc, fr_e, fq_e); }
        __builtin_amdgcn_s_waitcnt(0x0F70);
        if (!has_next) break;
#pragma unroll
        for (int a = 0; a < 2; ++a)
#pragma unroll
            for (int b = 0; b < 2; ++b)
#pragma unroll
                for (int m = 0; m < 4; ++m)
#pragma unroll
                    for (int n = 0; n < 2; ++n) acc[a][b][m][n] = (f32x4){0.f, 0.f, 0.f, 0.f};
        cur = nxt; cB = nB; ++ui;
        if constexpr (ALIGN_EPI) { if (wr == 1) PG_BAR; }
    }
    PG_WAIT_V(0);
    if constexpr (!ALIGN_EPI) { if (wr == 0) PG_BAR; }
    PG_BAR;
#undef PG_SA
#undef PG_SB
#undef PG_STAGE
#undef PG_LDA
#undef PG_LDB
#undef PG_MMA
#undef PG_WAIT_V
#undef PG_WAIT_L
#undef PG_BAR
#undef PG_SCHED
}
}

typedef GAS unsigned gu32;
#define XB_TMO      128
#define XB_XCNT(j)  (256  + 64 * (j))
#define XB_XSUB(j)  (1280 + 64 * (j))
#define XB_XGEN(j)  (2304 + 64 * (j))
#define XB_TOP      3328
#define XB_TOPGEN   3392
#define XCD_BAR_WORDS 3456
#define XB_SPIN_CAP (1u << 18)
__device__ __forceinline__ unsigned xb_ld(unsigned* p)              { return __hip_atomic_load(p, __ATOMIC_RELAXED, __HIP_MEMORY_SCOPE_AGENT); }
__device__ __forceinline__ unsigned xb_add(unsigned* p, unsigned v) { return __hip_atomic_fetch_add(p, v, __ATOMIC_RELAXED, __HIP_MEMORY_SCOPE_AGENT); }
__device__ __forceinline__ unsigned xb_xcc_id() { return (unsigned)__builtin_amdgcn_s_getreg((3 << 11) | 20) & 0xFu; }
#define XB_SPIN(cond, bar) do { unsigned _sp = 0; while (cond) { __builtin_amdgcn_s_sleep(1); \
    if ((++_sp & 255u) == 0u) { if (xb_ld(&(bar)[XB_TMO])) break; if (_sp > XB_SPIN_CAP) { atomicAdd(&(bar)[XB_TMO], 1u); break; } } } } while (0)
struct XcdBarrier { unsigned* bar; unsigned x; volatile LAS unsigned* st; };
__device__ __forceinline__ XcdBarrier xcd_barrier_post(unsigned* bar, volatile LAS unsigned* st) {
    XcdBarrier b; b.bar = bar; b.x = xb_xcc_id(); b.st = st;
    if (threadIdx.x == 0) (void)xb_add(&bar[XB_XCNT(b.x)], 1u);
    return b;
}
__device__ __forceinline__ void xcd_barrier_complete(unsigned* bar, unsigned x, unsigned& nloc, unsigned& nx) {
    const unsigned G = gridDim.x * gridDim.y * gridDim.z;
    unsigned sum, cnt, mine, sp = 0u;
    for (;;) {
        sum = 0u; cnt = 0u; mine = 0u;
#pragma unroll
        for (unsigned j = 0; j < 16; ++j) { const unsigned c = xb_ld(&bar[XB_XCNT(j)]); sum += c; cnt += (c > 0u) ? 1u : 0u; mine = (j == x) ? c : mine; }
        if (sum == G) break;
        __builtin_amdgcn_s_sleep(1);
        if ((++sp & 255u) == 0u) { if (xb_ld(&bar[XB_TMO])) break; if (sp > XB_SPIN_CAP) { atomicAdd(&bar[XB_TMO], 1u); break; } }
    }
    nloc = mine > 0u ? mine : 1u; nx = cnt > 0u ? cnt : 1u;
}
__device__ __forceinline__ void xcd_barrier(const XcdBarrier& b) {
    asm volatile("s_waitcnt vmcnt(0)" ::: "memory");
    __syncthreads();
    if (threadIdx.x == 0) {
        unsigned* bar = b.bar;
        __builtin_amdgcn_s_waitcnt(0);
        unsigned nloc = b.st[0], nx = b.st[1];
        if (nloc == 0u) { xcd_barrier_complete(bar, b.x, nloc, nx); b.st[0] = nloc; b.st[1] = nx; }
        const unsigned old = xb_add(&bar[XB_XSUB(b.x)], 1u);
        const unsigned gen = old / nloc;
        if (old + 1u == (gen + 1u) * nloc) {
            __builtin_amdgcn_fence(__ATOMIC_RELEASE, "agent");
            asm volatile("s_waitcnt vmcnt(0)" ::: "memory");
            const unsigned og = xb_add(&bar[XB_TOP], 1u);
            const unsigned tg = og / nx;
            if (og + 1u == (tg + 1u) * nx) xb_add(&bar[XB_TOPGEN], 1u);
            else XB_SPIN(xb_ld(&bar[XB_TOPGEN]) == tg, bar);
            __builtin_amdgcn_fence(__ATOMIC_ACQUIRE, "agent");
            xb_add(&bar[XB_XGEN(b.x)], 1u);
            asm volatile("s_waitcnt vmcnt(0)" ::: "memory");
        } else {
            XB_SPIN(xb_ld(&bar[XB_XGEN(b.x)]) == gen, bar);
            __builtin_amdgcn_fence(__ATOMIC_ACQUIRE, "agent");
            asm volatile("s_waitcnt vmcnt(0)" ::: "memory");
        }
    }
    __syncthreads();
}
constexpr int NWAVES = 8;
constexpr size_t MiB = 1u << 20;
constexpr int LDS_BYTES = 147456;
constexpr int RING_BYTES = 131072;
constexpr int TAB_OFF = RING_BYTES;
constexpr int TAB_BYTES = 12288;
constexpr int MISC_OFF = TAB_OFF + TAB_BYTES;
constexpr size_t WS_CTL = 0;
constexpr size_t CTL_ZERO_BYTES = 64 * 1024;
constexpr int CW_BAR = 1024;
constexpr int CW_CNT = 8192;
constexpr size_t WS_SSP = 1 * MiB;
constexpr size_t WS_SSP1 = 6 * MiB + 512 * 1024;
constexpr size_t WS_RSTD = 2 * MiB;
constexpr size_t WS_LSLOT = 2 * MiB + 256 * 1024;
constexpr size_t WS_LW = WS_LSLOT + 2 * MiB;
constexpr size_t WS_WRT = 7 * MiB + 512 * 1024;
constexpr size_t WS_WSM = 8 * MiB;
constexpr size_t OFF_WINA = 0, OFF_WOUTA = 6 * MiB, OFF_WINB = 8 * MiB, OFF_WGATE = 12 * MiB, OFF_WOUTB = 14 * MiB, OFF_WPLEG = 16 * MiB, OFF_WPLE = 20 * MiB;
constexpr size_t WS_WMOE = 30 * MiB;
constexpr size_t WS_HB = 222 * MiB;
constexpr size_t WS_PW = 254 * MiB;
constexpr size_t WS_PB = 286 * MiB;
constexpr size_t WS_R0 = 302 * MiB, RSZ = 32 * MiB;
constexpr size_t WS_END = WS_R0 + 6 * RSZ + 28 * MiB;
#define WS_R(i) (WS_R0 + (size_t)(i) * RSZ)

#define RLX_AGENT __ATOMIC_RELAXED, __HIP_MEMORY_SCOPE_AGENT
#define LDS_WAIT() asm volatile("s_waitcnt lgkmcnt(0)" ::: "memory")
#define VM_WAIT() asm volatile("s_waitcnt vmcnt(0)" ::: "memory")
__device__ __forceinline__ unsigned pk2(float lo, float hi) { return pg::cvt_pk_bf16(lo, hi); }
__device__ __forceinline__ float bf_lo(unsigned w) { return (float)__builtin_bit_cast(half2v, w).x; }
__device__ __forceinline__ float bf_hi(unsigned w) { return (float)__builtin_bit_cast(half2v, w).y; }
__device__ __forceinline__ float wave_sum(float v) {
#pragma unroll
    for (int o = 1; o < 64; o <<= 1) v += __shfl_xor(v, o);
    return v;
}
__device__ __forceinline__ float fsigm(float x) { return __builtin_amdgcn_rcpf(1.0f + __builtin_amdgcn_exp2f(-1.4426950408889634f * x)); }

__device__ __forceinline__ int map_lin8(int c) { const int q = c & 31; return (c & ~31) + 16 * ((q >> 2) & 1) + 4 * (q >> 3) + (q & 3); }
__device__ __forceinline__ int map_pair(int ch, int type) { return 256 * (ch >> 7) + 128 * ((ch >> 6) & 1) + 32 * ((ch >> 4) & 3) + 16 * type + (ch & 15); }

struct Args { const float* in[28]; float* out; unsigned char* ws; int ph_lo, ph_hi; };

struct Frame {
    LAS unsigned char* lds;
    volatile LAS unsigned* MISC;
    int tid, lane, wave, vcu, G;
};

struct PrepJob { const float* W; int ldw, K, ncols, nbatch; size_t sbs; const float* gain; bf16_t* dst; size_t dbs; int mode, type; };
__device__ __forceinline__ void prep_item(const PrepJob& J, LAS float* scr, int item, int lane) {
    const int nblk = J.ncols / 64, per = (J.K / 64) * nblk, b = item / per, r = item % per, kb = r / nblk, nb = r % nblk, k0 = 64 * kb, n0 = 64 * nb;
    const float* W = J.W + (size_t)b * J.sbs; bf16_t* WT = J.dst + (size_t)b * J.dbs;
    const int kr = lane >> 4, nq = lane & 15;
    f32x4 v[16];
#pragma unroll
    for (int i = 0; i < 16; ++i) v[i] = *(const GAS f32x4*)(W + (size_t)(k0 + 4 * i + kr) * J.ldw + n0 + 4 * nq);
    if (J.gain) {
#pragma unroll
        for (int i = 0; i < 16; ++i) v[i] = v[i] * J.gain[k0 + 4 * i + kr]; }
#pragma unroll
    for (int i = 0; i < 16; ++i) { LAS float* d = scr + (4 * i + kr) * 65 + 4 * nq; d[0] = v[i][0]; d[1] = v[i][1]; d[2] = v[i][2]; d[3] = v[i][3]; }
    LDS_WAIT(); asm volatile("" ::: "memory");
    const int c = lane & 7;
#pragma unroll
    for (int j = 0; j < 8; ++j) { const int n = (lane >> 3) + 8 * j; const LAS float* s = scr + (8 * c) * 65 + n;
        u32x4 o; o.x = pk2(s[0 * 65], s[1 * 65]); o.y = pk2(s[2 * 65], s[3 * 65]); o.z = pk2(s[4 * 65], s[5 * 65]); o.w = pk2(s[6 * 65], s[7 * 65]);
        const int col = n0 + n; const int drow = (J.mode == 0) ? map_lin8(col) : map_pair(col, J.type);
        *(GAS u32x4*)(WT + (size_t)drow * J.K + k0 + 8 * c) = o; }
    LDS_WAIT(); asm volatile("" ::: "memory");
}
__device__ __forceinline__ bool prep_job(const Args& a, int j, PrepJob& J) {
    unsigned char* ws = a.ws; bf16_t* wsm = (bf16_t*)(ws + WS_WSM);
    const float* norm_mix = a.in[2]; const float* norm_ffn = a.in[15]; const float* norm_ple = a.in[23];
    J.sbs = 0; J.dbs = 0; J.nbatch = 1; J.gain = nullptr; J.type = 0; J.mode = 0;
    switch (j) {
    case 0: J = PrepJob{a.in[3], 3 * D, D, D, 1, 0, norm_mix, wsm + OFF_WINA / 2 + (size_t)2048 * D, 0, 0, 0}; return true;
    case 1: J = PrepJob{a.in[3] + D, 3 * D, D, D, 1, 0, norm_mix, wsm + OFF_WINA / 2, 0, 1, 0}; return true;
    case 2: J = PrepJob{a.in[3] + 2 * D, 3 * D, D, D, 1, 0, norm_mix, wsm + OFF_WINA / 2, 0, 1, 1}; return true;
    case 3: J = PrepJob{a.in[5], D, D, D, 1, 0, nullptr, wsm + OFF_WOUTA / 2, 0, 0, 0}; return true;
    case 4: J = PrepJob{a.in[6], 2 * D, D, 2 * D, 1, 0, norm_mix + D, wsm + OFF_WINB / 2, 0, 0, 0}; return true;
    case 5: J = PrepJob{a.in[9], 256, 256, 256, 8, (size_t)256 * 256, nullptr, wsm + OFF_WGATE / 2, (size_t)512 * 256, 1, 0}; return true;
    case 6: J = PrepJob{a.in[11], 256, 256, 256, 8, (size_t)256 * 256, nullptr, wsm + OFF_WGATE / 2, (size_t)512 * 256, 1, 1}; return true;
    case 7: J = PrepJob{a.in[14], D, D, D, 1, 0, nullptr, wsm + OFF_WOUTB / 2, 0, 0, 0}; return true;
    case 8: J = PrepJob{a.in[25], D, D, D, 1, 0, norm_ple, wsm + OFF_WPLEG / 2, 0, 0, 0}; return true;
    case 9: J = PrepJob{a.in[25] + (size_t)D * D, D, D, D, 1, 0, norm_ple + D, wsm + OFF_WPLEG / 2 + (size_t)D * D, 0, 0, 0}; return true;
    case 10: J = PrepJob{a.in[24], D, 256, D, 2, (size_t)256 * D, nullptr, wsm + OFF_WPLE / 2, (size_t)D * 256, 0, 0}; return true;
    case 11: case 12: { const int L = j - 11; bf16_t* base = (bf16_t*)(ws + WS_WMOE + (size_t)L * 96 * MiB);
        J = PrepJob{a.in[20] + (size_t)L * 32 * D * 512, 512, D, 512, 32, (size_t)D * 512, norm_ffn + L * D, base, (size_t)1024 * D, 1, 0}; return true; }
    case 13: case 14: { const int L = j - 13; bf16_t* base = (bf16_t*)(ws + WS_WMOE + (size_t)L * 96 * MiB);
        J = PrepJob{a.in[21] + (size_t)L * 32 * D * 512, 512, D, 512, 32, (size_t)D * 512, norm_ffn + L * D, base, (size_t)1024 * D, 1, 1}; return true; }
    case 15: case 16: { const int L = j - 15; bf16_t* base = (bf16_t*)(ws + WS_WMOE + (size_t)L * 96 * MiB + 64 * MiB);
        J = PrepJob{a.in[22] + (size_t)L * 32 * 512 * D, D, 512, D, 32, (size_t)512 * D, nullptr, base, (size_t)1024 * 512, 0, 0}; return true; }
    default: return false;
    }
}
constexpr int N_PREP_JOBS = 17;
__device__ __forceinline__ void p0_prologue(Frame& F, const Args& a, int job_lo, int job_hi) {
    LAS float* scr = (LAS float*)(F.lds + F.wave * 16640);
    const int gw = F.vcu * NWAVES + F.wave, NGW = F.G * NWAVES;
    for (int j = job_lo; j < job_hi; ++j) {
        PrepJob J; if (!prep_job(a, j, J)) break;
        const int items = J.nbatch * (J.K / 64) * (J.ncols / 64);
        for (int it = gw; it < items; it += NGW) prep_item(J, scr, it, F.lane);
    }
    {
        float* wrt = (float*)(a.ws + WS_WRT);
        for (int i = gw * 64 + F.lane; i < 2 * 48 * D; i += NGW * 64) { const int L = i / (48 * D), r = (i / D) % 48, k = i % D; const float g = a.in[15][L * D + k];
            wrt[i] = r < 4 ? g * a.in[16][((size_t)L * D + k) * 4 + r] : (r < 36 ? g * a.in[18][((size_t)L * D + k) * 32 + (r - 4)] : 0.f); }
    }
    const float* x = a.in[0]; bf16_t* xb = (bf16_t*)(a.ws + WS_R(0)); float* rstd = (float*)(a.ws + WS_RSTD);
    for (int m = gw; m < NTOK; m += NGW) {
        const GAS f32x4* xr = (const GAS f32x4*)(x + (size_t)m * D) + F.lane;
        f32x4 v[4]; float s = 0.f;
#pragma unroll
        for (int j = 0; j < 4; ++j) { v[j] = xr[64 * j]; s += (v[j].x * v[j].x + v[j].y * v[j].y) + (v[j].z * v[j].z + v[j].w * v[j].w); }
        s = wave_sum(s);
        GAS u32x2* o8 = (GAS u32x2*)(xb + (size_t)m * D) + F.lane;
#pragma unroll
        for (int j = 0; j < 4; ++j) { u32x2 w; w.x = pk2(v[j].x, v[j].y); w.y = pk2(v[j].z, v[j].w); o8[64 * j] = w; }
        if (F.lane == 0) rstd[m] = 1.0f / sqrtf(s * (1.0f / D) + EPS);
    }
    const GAS f32x4* p4 = (const GAS f32x4*)a.in[1]; GAS u32x2* pb = (GAS u32x2*)(a.ws + WS_PB);
    const size_t n4 = (size_t)2 * NTOK * 256 / 4;
    for (size_t i = (size_t)gw * 64 + F.lane; i < n4; i += (size_t)NGW * 64) { const f32x4 v = p4[i]; u32x2 w; w.x = pk2(v.x, v.y); w.y = pk2(v.z, v.w); pb[i] = w; }
}

struct DenseSched {
    pg::DenseOrder O; int lda2;
    __device__ __forceinline__ void init(int nN, int G, int c, int lda) { O.init(NTOK / 256, nN, G, c); lda2 = lda * 2; }
    __device__ __forceinline__ bool next(int i, pg::Unit& u) const { int pm, pn; if (!O.tile(i, pm, pn)) return false; u.arow = pm * 256; u.acol = 0; u.brow = pn * 256; u.orow = pm * 256; u.pn = pn; u.aux = i; return true; }
    __device__ __forceinline__ void a_offs(const pg::Unit& u, int R0, unsigned c2, unsigned (&o)[2][2]) const {
#pragma unroll
        for (int h = 0; h < 2; ++h)
#pragma unroll
            for (int i = 0; i < 2; ++i) o[h][i] = (unsigned)(u.arow + h * 128 + i * 64 + R0) * (unsigned)lda2 + (unsigned)u.acol * 2u + c2;
    }
};

struct EpiInA {
    bf16_t* G; bf16_t* Bg; const LAS float* rt;
    __device__ __forceinline__ void operator()(const f32x4 (&acc)[2][2][4][2], const pg::Unit& u, int wr, int wc, int fr, int fq) const {
        const int row0 = u.orow + wr * 64 + fr;
        if (u.pn < 8) {
            const int col0 = u.pn * 128 + wc * 16 + fq * 4;
#pragma unroll
            for (int ai = 0; ai < 2; ++ai)
#pragma unroll
                for (int m = 0; m < 4; ++m) { const int row = row0 + ai * 128 + m * 16; const float s = rt[u.aux * 256 + wr * 64 + fr + ai * 128 + m * 16]; const float s2 = s * s;
#pragma unroll
                    for (int bj = 0; bj < 2; ++bj) { const f32x4 c = acc[ai][bj][m][0], h = acc[ai][bj][m][1];
                        u32x2 w; w.x = pg::cvt_pk_bf16(c[0] * h[0] * s2, c[1] * h[1] * s2); w.y = pg::cvt_pk_bf16(c[2] * h[2] * s2, c[3] * h[3] * s2);
                        *(u32x2*)(G + (size_t)row * D + col0 + bj * 64) = w; } }
        } else {
            const int col0 = (u.pn - 8) * 256 + wc * 32 + fq * 8;
#pragma unroll
            for (int ai = 0; ai < 2; ++ai)
#pragma unroll
                for (int m = 0; m < 4; ++m) { const int row = row0 + ai * 128 + m * 16; const float s = rt[u.aux * 256 + wr * 64 + fr + ai * 128 + m * 16];
#pragma unroll
                    for (int bj = 0; bj < 2; ++bj) { const f32x4 v0 = acc[ai][bj][m][0] * s, v1 = acc[ai][bj][m][1] * s;
                        u32x4 w; w.x = pg::cvt_pk_bf16(v0[0], v0[1]); w.y = pg::cvt_pk_bf16(v0[2], v0[3]); w.z = pg::cvt_pk_bf16(v1[0], v1[1]); w.w = pg::cvt_pk_bf16(v1[2], v1[3]);
                        *(u32x4*)(Bg + (size_t)row * D + col0 + bj * 128) = w; } }
        }
    }
};

struct EpiResid {
    const float* resid; float* Hf; bf16_t* Hb; float* ssp;
    __device__ __forceinline__ void operator()(const f32x4 (&acc)[2][2][4][2], const pg::Unit& u, int wr, int wc, int fr, int fq) const {
        const int row0 = u.orow + wr * 64 + fr, col0 = u.pn * 256 + wc * 32 + fq * 8;
        f32x4 pre[2][2][2];
#define ER_LOAD(slot, g) do { const size_t off_ = (size_t)(row0 + ((g) >> 2) * 128 + ((g) & 3) * 16) * D + col0; _Pragma("unroll") for (int bj = 0; bj < 2; ++bj) { \
            pre[slot][bj][0] = *(const f32x4*)(resid + off_ + bj * 128); pre[slot][bj][1] = *(const f32x4*)(resid + off_ + bj * 128 + 4); } } while (0)
        ER_LOAD(0, 0); ER_LOAD(1, 1);
#pragma unroll
        for (int g = 0; g < 8; ++g) { const int ai = g >> 2, mm = g & 3, sl = g & 1; const int row = row0 + ai * 128 + mm * 16; const size_t off = (size_t)row * D + col0; float ss = 0.f;
            f32x4 v[2][2];
#pragma unroll
            for (int bj = 0; bj < 2; ++bj) { v[bj][0] = acc[ai][bj][mm][0] + pre[sl][bj][0]; v[bj][1] = acc[ai][bj][mm][1] + pre[sl][bj][1]; }
            asm volatile("" : "+v"(v[0][0]), "+v"(v[0][1]), "+v"(v[1][0]), "+v"(v[1][1]));
            if (g + 2 < 8) ER_LOAD(sl, g + 2);
#pragma unroll
            for (int bj = 0; bj < 2; ++bj) { const f32x4 v0 = v[bj][0], v1 = v[bj][1];
                ss += (v0[0] * v0[0] + v0[1] * v0[1]) + (v0[2] * v0[2] + v0[3] * v0[3]) + (v1[0] * v1[0] + v1[1] * v1[1]) + (v1[2] * v1[2] + v1[3] * v1[3]);
                *(f32x4*)(Hf + off + bj * 128) = v0; *(f32x4*)(Hf + off + bj * 128 + 4) = v1;
                u32x4 w; w.x = pk2(v0[0], v0[1]); w.y = pk2(v0[2], v0[3]); w.z = pk2(v1[0], v1[1]); w.w = pk2(v1[2], v1[3]);
                *(u32x4*)(Hb + off + bj * 128) = w; }
            ss += __shfl_xor(ss, 16); ss += __shfl_xor(ss, 32);
            if (fq == 0) ssp[(size_t)row * 16 + u.pn * 4 + wc] = ss; }
#undef ER_LOAD
    }
};

__device__ __forceinline__ void unpack8(const u32x4 w, float (&f)[8]) { f[0] = bf_lo(w.x); f[1] = bf_hi(w.x); f[2] = bf_lo(w.y); f[3] = bf_hi(w.y); f[4] = bf_lo(w.z); f[5] = bf_hi(w.z); f[6] = bf_lo(w.w); f[7] = bf_hi(w.w); }
__device__ __forceinline__ u32x4 pack8(const float (&f)[8]) { u32x4 w; w.x = pk2(f[0], f[1]); w.y = pk2(f[2], f[3]); w.z = pk2(f[4], f[5]); w.w = pk2(f[6], f[7]); return w; }
__device__ __forceinline__ void p2_conv_a(Frame& F, const bf16_t* G, const bf16_t* Bg, const float* cw, bf16_t* A2) {
    const int gw = F.vcu * NWAVES + F.wave, NGW = F.G * NWAVES;
    for (int it = gw; it < 2048; it += NGW) {
        const int r0 = (it >> 1) * 16, c0 = (it & 1) * 512 + F.lane * 8, t0 = r0 % SEQ;
        float w0[8], w1[8], w2[8];
#pragma unroll
        for (int j = 0; j < 8; ++j) { w0[j] = cw[c0 + j]; w1[j] = cw[D + c0 + j]; w2[j] = cw[2 * D + c0 + j]; }
        const bf16_t* gp = G + (size_t)r0 * D + c0; const bf16_t* bp = Bg + (size_t)r0 * D + c0; bf16_t* op = A2 + (size_t)r0 * D + c0;
        float gm[8], gc[8], gn[8];
        if (t0 > 0) unpack8(*(const GAS u32x4*)(gp - D), gm); else {
#pragma unroll
            for (int j = 0; j < 8; ++j) gm[j] = 0.f; }
        unpack8(*(const GAS u32x4*)gp, gc);
#pragma unroll 4
        for (int r = 0; r < 16; ++r) {
            if (t0 + r + 1 < SEQ) unpack8(*(const GAS u32x4*)(gp + (size_t)(r + 1) * D), gn); else {
#pragma unroll
                for (int j = 0; j < 8; ++j) gn[j] = 0.f; }
            float b[8], o[8]; unpack8(*(const GAS u32x4*)(bp + (size_t)r * D), b);
#pragma unroll
            for (int j = 0; j < 8; ++j) { o[j] = b[j] * (w0[j] * gm[j] + w1[j] * gc[j] + w2[j] * gn[j]); gm[j] = gc[j]; gc[j] = gn[j]; }
            *(GAS u32x4*)(op + (size_t)r * D) = pack8(o);
        }
    }
}

__device__ __forceinline__ void p4_router(Frame& F, const float* Hf, const float* wrt, const float* bg, const float* be, unsigned* gcnt, int* lslot, float* lw, float* rstd_out) {
    LAS float* Lg = (LAS float*)F.lds; LAS float* ssL = (LAS float*)(F.lds + 24576);
    LAS int* s_e = (LAS int*)(F.lds + 25088); LAS float* s_w = (LAS float*)(F.lds + 25600); LAS int* s_rank = (LAS int*)(F.lds + 26112);
    LAS unsigned* lcnt = (LAS unsigned*)(F.lds + 26624); LAS unsigned* lbase = (LAS unsigned*)(F.lds + 26752);
    const int tg = F.wave & 3, kh = F.wave >> 2, t = F.lane & 15, q = F.lane >> 4;
    for (int blk = F.vcu; blk < NTOK / 64; blk += F.G) {
        if (F.tid < 32) lcnt[F.tid] = 0u;
        const GAS float* xrow = (const GAS float*)Hf + (size_t)(blk * 64 + 16 * tg + t) * D + kh * 512 + 4 * q;
        const GAS float* wrow = (const GAS float*)wrt + (size_t)t * D + kh * 512 + 4 * q;
        f32x4 acc0 = {0.f, 0.f, 0.f, 0.f}, acc1 = acc0, acc2 = acc0; float ss = 0.f;
#pragma unroll 4
        for (int st = 0; st < 32; ++st) {
            const f32x4 xv = *(const GAS f32x4*)(xrow + 16 * st);
            const f32x4 w0 = *(const GAS f32x4*)(wrow + 16 * st), w1 = *(const GAS f32x4*)(wrow + 16 * D + 16 * st), w2 = *(const GAS f32x4*)(wrow + 32 * D + 16 * st);
            ss += (xv[0] * xv[0] + xv[1] * xv[1]) + (xv[2] * xv[2] + xv[3] * xv[3]);
#pragma unroll
            for (int s = 0; s < 4; ++s) {
                acc0 = __builtin_amdgcn_mfma_f32_16x16x4f32(w0[s], xv[s], acc0, 0, 0, 0);
                acc1 = __builtin_amdgcn_mfma_f32_16x16x4f32(w1[s], xv[s], acc1, 0, 0, 0);
                acc2 = __builtin_amdgcn_mfma_f32_16x16x4f32(w2[s], xv[s], acc2, 0, 0, 0); }
        }
        ss += __shfl_xor(ss, 16); ss += __shfl_xor(ss, 32);
        { LAS float* L = Lg + ((kh * 64) + 16 * tg + t) * 48 + 4 * q;
          *(LAS f32x4*)(L) = acc0; *(LAS f32x4*)(L + 16) = acc1; *(LAS f32x4*)(L + 32) = acc2;
          if (q == 0) ssL[kh * 64 + 16 * tg + t] = ss; }
        LDS_WAIT(); __syncthreads();
        if (F.tid < 64) {
            const int ts = F.tid, tok = blk * 64 + ts; LAS float* L0 = Lg + ts * 48; const LAS float* L1 = Lg + (64 + ts) * 48;
            const float rs = 1.0f / sqrtf((ssL[ts] + ssL[64 + ts]) * (1.0f / D) + EPS);
            for (int j = 0; j < 4; ++j) L0[j] = (L0[j] + L1[j]) * rs + bg[j];
            for (int j = 0; j < 32; ++j) L0[4 + j] = (L0[4 + j] + L1[4 + j]) * rs + be[j];
            int g = 0;
            for (int j = 1; j < 4; ++j) if (L0[j] > L0[g]) g = j;
            float sg = 0.f; for (int j = 0; j < 4; ++j) sg += expf(L0[j] - L0[g]);
            const float pgt = 1.0f / sg;
            LAS float* le = L0 + 4 + g * 8;
            int i0 = 0; for (int i = 1; i < 8; ++i) if (le[i] > le[i0]) i0 = i;
            int i1 = (i0 == 0) ? 1 : 0; for (int i = 0; i < 8; ++i) if (i != i0 && le[i] > le[i1]) i1 = i;
            const float e1 = expf(le[i1] - le[i0]); const float w0 = 1.0f / (1.0f + e1), w1 = e1 / (1.0f + e1);
            const int E0 = g * 8 + i0, E1 = g * 8 + i1;
            s_e[2 * ts] = E0; s_e[2 * ts + 1] = E1; s_w[2 * ts] = pgt * w0; s_w[2 * ts + 1] = pgt * w1;
            s_rank[2 * ts] = (int)__hip_atomic_fetch_add(&lcnt[E0], 1u, __ATOMIC_RELAXED, __HIP_MEMORY_SCOPE_WORKGROUP);
            s_rank[2 * ts + 1] = (int)__hip_atomic_fetch_add(&lcnt[E1], 1u, __ATOMIC_RELAXED, __HIP_MEMORY_SCOPE_WORKGROUP);
            rstd_out[tok] = rs;
        }
        LDS_WAIT(); __syncthreads();
        if (F.tid < 32) lbase[F.tid] = __hip_atomic_fetch_add(gcnt + F.tid, lcnt[F.tid], __ATOMIC_RELAXED, __HIP_MEMORY_SCOPE_AGENT);
        LDS_WAIT(); __syncthreads();
        if (F.tid < 128) { const int s = F.tid, E = s_e[s]; const unsigned pos = lbase[E] + (unsigned)s_rank[s]; const int tok = blk * 64 + (s >> 1);
            lslot[(size_t)E * CAP + pos] = 2 * tok + (s & 1); lw[(size_t)E * CAP + pos] = s_w[s]; }
        LDS_WAIT(); __syncthreads();
    }
}

constexpr int MAXU = 5;
struct MoeSched {
    LAS int* ud; int n; const LAS unsigned* tabA; int mode; int lda2;
    __device__ __forceinline__ bool next(int i, pg::Unit& u) const { if (i >= n) return false; const int e = ud[4 * i], pn = ud[4 * i + 2], rbg = ud[4 * i + 3];
        u.arow = mode == 0 ? i * 256 : rbg * 256; u.acol = 0; u.brow = e * 1024 + pn * 256; u.orow = rbg * 256; u.pn = pn; u.aux = i; return true; }
    __device__ __forceinline__ void a_offs(const pg::Unit& u, int R0, unsigned c2, unsigned (&o)[2][2]) const {
#pragma unroll
        for (int h = 0; h < 2; ++h)
#pragma unroll
            for (int i = 0; i < 2; ++i) { const int r = h * 128 + i * 64 + R0;
                o[h][i] = (mode == 0 ? tabA[u.arow + r] : (unsigned)(u.arow + r) * (unsigned)lda2) + c2; }
    }
};
__device__ __forceinline__ int moe_setup(Frame& F, const unsigned* gcnt, const int* lslot, const float* lw, const float* rstd, int which) {
    LAS int* ud = (LAS int*)(F.lds + TAB_OFF); LAS unsigned* tabA = (LAS unsigned*)(F.lds + TAB_OFF + 128); LAS unsigned* tabB = (LAS unsigned*)(F.lds + TAB_OFF + 128 + MAXU * 1024);
    __syncthreads();
    if (F.tid == 0) {
        int n = 0, rbg = 0; const int c = F.vcu;
        for (int e = 0; e < NEXP; ++e) { const int nrb = ((int)gcnt[e] + 255) >> 8;
            for (int rb = 0; rb < nrb; ++rb, ++rbg)
                for (int pn = 0; pn < 4; ++pn) { const int L = 4 * rbg + pn; if ((L % F.G) == c && n < MAXU) { ud[4 * n] = e; ud[4 * n + 1] = rb; ud[4 * n + 2] = pn; ud[4 * n + 3] = rbg; ++n; } } }
        ud[4 * MAXU] = n;
    }
    __syncthreads();
    const int n = ud[4 * MAXU];
    for (int i = 0; i < n; ++i) {
        if (F.tid < 256) { const int e = ud[4 * i], rb = ud[4 * i + 1], idx = rb * 256 + F.tid; const bool ok = idx < (int)gcnt[e];
            const int slot = ok ? lslot[(size_t)e * CAP + idx] : 0;
            if (which == 0) { tabA[i * 256 + F.tid] = (unsigned)(slot >> 1) * (unsigned)(D * 2); tabB[i * 256 + F.tid] = __builtin_bit_cast(unsigned, rstd[slot >> 1]); }
            else { tabA[i * 256 + F.tid] = ok ? (unsigned)slot : 0xffffffffu; tabB[i * 256 + F.tid] = ok ? __builtin_bit_cast(unsigned, lw[(size_t)e * CAP + idx]) : 0u; } }
    }
    VM_WAIT(); LDS_WAIT();
    __syncthreads();
    return n;
}
struct EpiUp {
    bf16_t* HID; const LAS unsigned* tabB;
    __device__ __forceinline__ void operator()(const f32x4 (&acc)[2][2][4][2], const pg::Unit& u, int wr, int wc, int fr, int fq) const {
        const int r0 = wr * 64 + fr, col0 = u.pn * 128 + wc * 16 + fq * 4;
#pragma unroll
        for (int ai = 0; ai < 2; ++ai)
#pragma unroll
            for (int m = 0; m < 4; ++m) { const int r = r0 + ai * 128 + m * 16; const float s = __builtin_bit_cast(float, tabB[u.aux * 256 + r]);
#pragma unroll
                for (int bj = 0; bj < 2; ++bj) { const f32x4 g = acc[ai][bj][m][0] * s, v = acc[ai][bj][m][1] * s; float o[4];
#pragma unroll
                    for (int j = 0; j < 4; ++j) o[j] = g[j] * fsigm(g[j]) * v[j];
                    u32x2 w; w.x = pk2(o[0], o[1]); w.y = pk2(o[2], o[3]);
                    *(u32x2*)(HID + (size_t)(u.orow + r) * FEXP + col0 + bj * 64) = w; } }
    }
};
struct EpiDown {
    bf16_t* Y; const LAS unsigned* tabA; const LAS unsigned* tabB;
    __device__ __forceinline__ void operator()(const f32x4 (&acc)[2][2][4][2], const pg::Unit& u, int wr, int wc, int fr, int fq) const {
        const int r0 = wr * 64 + fr, col0 = u.pn * 256 + wc * 32 + fq * 8;
#pragma unroll
        for (int ai = 0; ai < 2; ++ai)
#pragma unroll
            for (int m = 0; m < 4; ++m) { const int r = r0 + ai * 128 + m * 16; const unsigned slot = tabA[u.aux * 256 + r]; const float w = __builtin_bit_cast(float, tabB[u.aux * 256 + r]);
                if (slot != 0xffffffffu) {
#pragma unroll
                    for (int bj = 0; bj < 2; ++bj) { const f32x4 v0 = acc[ai][bj][m][0] * w, v1 = acc[ai][bj][m][1] * w;
                        u32x4 o; o.x = pk2(v0[0], v0[1]); o.y = pk2(v0[2], v0[3]); o.z = pk2(v1[0], v1[1]); o.w = pk2(v1[2], v1[3]);
                        *(u32x4*)(Y + (size_t)slot * D + col0 + bj * 128) = o; } } }
    }
};
__device__ __forceinline__ void p7_combine(Frame& F, float* Hf, bf16_t* Hb, const bf16_t* Y, float* ssp) {
    DenseSched S; S.init(4, F.G, (int)blockIdx.x, D);
    pg::Unit u;
    for (int i = 0; S.next(i, u); ++i) {
        for (int r4 = 0; r4 < 32; r4 += 4) {
            f32x4 h[4]; u32x2 y0[4], y1[4];
#pragma unroll
            for (int j = 0; j < 4; ++j) { const int row = u.orow + F.wave + 8 * (r4 + j), col = u.pn * 256 + F.lane * 4; const size_t off = (size_t)row * D + col;
                h[j] = *(const GAS f32x4*)(Hf + off); y0[j] = *(const GAS u32x2*)(Y + (size_t)(2 * row) * D + col); y1[j] = *(const GAS u32x2*)(Y + (size_t)(2 * row + 1) * D + col); }
            float ss[4];
#pragma unroll
            for (int j = 0; j < 4; ++j) { h[j][0] += bf_lo(y0[j].x) + bf_lo(y1[j].x); h[j][1] += bf_hi(y0[j].x) + bf_hi(y1[j].x); h[j][2] += bf_lo(y0[j].y) + bf_lo(y1[j].y); h[j][3] += bf_hi(y0[j].y) + bf_hi(y1[j].y);
                ss[j] = (h[j][0] * h[j][0] + h[j][1] * h[j][1]) + (h[j][2] * h[j][2] + h[j][3] * h[j][3]); }
#pragma unroll
            for (int o = 1; o < 64; o <<= 1) {
#pragma unroll
                for (int j = 0; j < 4; ++j) ss[j] += __shfl_xor(ss[j], o); }
#pragma unroll
            for (int j = 0; j < 4; ++j) { const int row = u.orow + F.wave + 8 * (r4 + j), col = u.pn * 256 + F.lane * 4; const size_t off = (size_t)row * D + col;
                *(GAS f32x4*)(Hf + off) = h[j];
                u32x2 w; w.x = pk2(h[j][0], h[j][1]); w.y = pk2(h[j][2], h[j][3]); *(GAS u32x2*)(Hb + off) = w;
                if (F.lane < 4) ssp[(size_t)row * 16 + u.pn * 4 + F.lane] = F.lane == 0 ? ss[j] : 0.f; }
        }
    }
}

__device__ __forceinline__ float row_rstd(const float* ssp, int row) {
    const f32x4* p = (const f32x4*)(ssp + (size_t)row * 16); const f32x4 a = p[0], b = p[1], c = p[2], d = p[3];
    const float ss = ((a[0] + a[1]) + (a[2] + a[3])) + ((b[0] + b[1]) + (b[2] + b[3])) + ((c[0] + c[1]) + (c[2] + c[3])) + ((d[0] + d[1]) + (d[2] + d[3]));
    return 1.0f / sqrtf(ss * (1.0f / D) + EPS);
}
template <class Sched>
__device__ __forceinline__ void rstd_table_setup(Frame& F, const Sched& S, const float* ssp, const float* bias) {
    LAS float* rt = (LAS float*)(F.lds + TAB_OFF);
    __syncthreads();
    pg::Unit u;
    for (int i = 0; S.next(i, u) && i < 6; ++i) if (F.tid < 256) { rt[i * 256 + F.tid] = row_rstd(ssp, u.orow + F.tid); if (bias) rt[6 * 256 + i * 256 + F.tid] = bias[u.pn * 256 + F.tid]; }
    LDS_WAIT(); __syncthreads();
}
__device__ __forceinline__ float gelu_t(float x) {
    const float z = 1.5957691216057308f * (x + 0.044715f * x * x * x); return x * fsigm(z);
}
struct EpiLin {
    bf16_t* O0; bf16_t* O1; int split, act0, act1; const LAS float* rt;
    __device__ __forceinline__ void operator()(const f32x4 (&acc)[2][2][4][2], const pg::Unit& u, int wr, int wc, int fr, int fq) const {
        const bool first = u.pn < split; bf16_t* O = first ? O0 : O1; const int act = first ? act0 : act1;
        const int row0 = u.orow + wr * 64 + fr, col0 = (first ? u.pn : u.pn - split) * 256 + wc * 32 + fq * 8;
#pragma unroll
        for (int ai = 0; ai < 2; ++ai)
#pragma unroll
            for (int m = 0; m < 4; ++m) { const int row = row0 + ai * 128 + m * 16; const float s = rt ? rt[u.aux * 256 + wr * 64 + fr + ai * 128 + m * 16] : 1.0f;
#pragma unroll
                for (int bj = 0; bj < 2; ++bj) { f32x4 v0 = acc[ai][bj][m][0] * s, v1 = acc[ai][bj][m][1] * s;
                    if (act == 1) {
#pragma unroll
                        for (int j = 0; j < 4; ++j) { v0[j] = gelu_t(v0[j]); v1[j] = gelu_t(v1[j]); } }
                    u32x4 w; w.x = pk2(v0[0], v0[1]); w.y = pk2(v0[2], v0[3]); w.z = pk2(v1[0], v1[1]); w.w = pk2(v1[2], v1[3]);
                    *(u32x4*)(O + (size_t)row * D + col0 + bj * 128) = w; }
                asm volatile("" ::: "memory"); __builtin_amdgcn_sched_barrier(0); }
    }
};
struct EpiPle {
    float* Hf; bf16_t* Hb; const LAS float* rt; float* ssp_out; const bf16_t* PW;
    __device__ __forceinline__ void operator()(const f32x4 (&acc)[2][2][4][2], const pg::Unit& u, int wr, int wc, int fr, int fq) const {
        const int row0 = u.orow + wr * 64 + fr, col0 = u.pn * 256 + wc * 32 + fq * 8;
        const LAS float* bt = rt + 6 * 256 + u.aux * 256 + wc * 32 + fq * 8;
        f32x4 pre[2][2][2]; u32x4 ppw[2][2];
#define EP_LOAD(slot, g) do { const size_t off_ = (size_t)(row0 + ((g) >> 2) * 128 + ((g) & 3) * 16) * D + col0; _Pragma("unroll") for (int bj = 0; bj < 2; ++bj) { \
            pre[slot][bj][0] = *(const f32x4*)(Hf + off_ + bj * 128); pre[slot][bj][1] = *(const f32x4*)(Hf + off_ + bj * 128 + 4); ppw[slot][bj] = *(const u32x4*)(PW + off_ + bj * 128); } } while (0)
        EP_LOAD(0, 0); EP_LOAD(1, 1);
#pragma unroll
        for (int g = 0; g < 8; ++g) { const int ai = g >> 2, mm = g & 3, sl = g & 1; const int row = row0 + ai * 128 + mm * 16; const size_t off = (size_t)row * D + col0; const float s = rt[u.aux * 256 + wr * 64 + fr + ai * 128 + mm * 16]; float ss = 0.f;
            f32x4 h[2][2];
#pragma unroll
            for (int bj = 0; bj < 2; ++bj) { float pf[8]; unpack8(ppw[sl][bj], pf);
                const f32x4 a0 = acc[ai][bj][mm][0] * s + *(const LAS f32x4*)(bt + bj * 128), a1 = acc[ai][bj][mm][1] * s + *(const LAS f32x4*)(bt + bj * 128 + 4);
                h[bj][0] = pre[sl][bj][0]; h[bj][1] = pre[sl][bj][1];
#pragma unroll
                for (int j = 0; j < 4; ++j) { h[bj][0][j] += fsigm(a0[j]) * pf[j]; h[bj][1][j] += fsigm(a1[j]) * pf[4 + j]; } }
            asm volatile("" : "+v"(h[0][0]), "+v"(h[0][1]), "+v"(h[1][0]), "+v"(h[1][1]));
            if (g + 2 < 8) EP_LOAD(sl, g + 2);
#pragma unroll
            for (int bj = 0; bj < 2; ++bj) { const f32x4 h0 = h[bj][0], h1 = h[bj][1];
                ss += (h0[0] * h0[0] + h0[1] * h0[1]) + (h0[2] * h0[2] + h0[3] * h0[3]) + (h1[0] * h1[0] + h1[1] * h1[1]) + (h1[2] * h1[2] + h1[3] * h1[3]);
                *(f32x4*)(Hf + off + bj * 128) = h0; *(f32x4*)(Hf + off + bj * 128 + 4) = h1;
                u32x4 w; w.x = pk2(h0[0], h0[1]); w.y = pk2(h0[2], h0[3]); w.z = pk2(h1[0], h1[1]); w.w = pk2(h1[2], h1[3]);
                *(u32x4*)(Hb + off + bj * 128) = w; }
            ss += __shfl_xor(ss, 16); ss += __shfl_xor(ss, 32);
            if (fq == 0) ssp_out[(size_t)row * 16 + u.pn * 4 + wc] = ss; }
#undef EP_LOAD
    }
};
struct GateSched {
    pg::DenseOrder O;
    __device__ __forceinline__ void init(int G, int c) { O.init(NTOK / 256, 16, G, c); }
    __device__ __forceinline__ bool next(int i, pg::Unit& u) const { int pm, pn; if (!O.tile(i, pm, pn)) return false; u.arow = pm * 256; u.acol = ((pn >> 1) & 3) * 256; u.brow = pn * 256; u.orow = pm * 256; u.pn = pn; u.aux = 0; return true; }
    __device__ __forceinline__ void a_offs(const pg::Unit& u, int R0, unsigned c2, unsigned (&o)[2][2]) const {
#pragma unroll
        for (int h = 0; h < 2; ++h)
#pragma unroll
            for (int i = 0; i < 2; ++i) o[h][i] = (unsigned)(u.arow + h * 128 + i * 64 + R0) * (unsigned)(D * 2) + (unsigned)u.acol * 2u + c2;
    }
};
struct EpiGate {
    bf16_t* LA; bf16_t* GT; const bf16_t* ub; const float* br; const float* bi; const float* lam;
    __device__ __forceinline__ void operator()(const f32x4 (&acc)[2][2][4][2], const pg::Unit& u, int wr, int wc, int fr, int fq) const {
        const int d = u.pn >> 3, ch0 = ((u.pn >> 1) & 3) * 256 + (u.pn & 1) * 128 + wc * 16 + fq * 4, row0 = u.orow + wr * 64 + fr;
        f32x4 vbr[2], vbi[2], vsp[2];
#pragma unroll
        for (int bj = 0; bj < 2; ++bj) { vbr[bj] = *(const f32x4*)(br + d * D + ch0 + bj * 64); vbi[bj] = *(const f32x4*)(bi + d * D + ch0 + bj * 64);
            const f32x4 l = *(const f32x4*)(lam + d * D + ch0 + bj * 64);
#pragma unroll
            for (int j = 0; j < 4; ++j) vsp[bj][j] = -8.0f * 1.4426950408889634f * log1pf(expf(-l[j])); }
        bf16_t* la = LA + (size_t)d * NTOK * D; bf16_t* gt = GT + (size_t)d * NTOK * D;
#pragma unroll
        for (int ai = 0; ai < 2; ++ai)
#pragma unroll
            for (int m = 0; m < 4; ++m) { const int row = row0 + ai * 128 + m * 16;
#pragma unroll
                for (int bj = 0; bj < 2; ++bj) { const size_t off = (size_t)row * D + ch0 + bj * 64;
                    const u32x2 uw = *(const u32x2*)(ub + off); const float uf[4] = {bf_lo(uw.x), bf_hi(uw.x), bf_lo(uw.y), bf_hi(uw.y)};
                    const f32x4 rl = acc[ai][bj][m][0] + vbr[bj], il = acc[ai][bj][m][1] + vbi[bj]; float l2[4], g[4];
#pragma unroll
                    for (int j = 0; j < 4; ++j) { l2[j] = fsigm(rl[j]) * vsp[bj][j]; const float a2 = __builtin_amdgcn_exp2f(2.0f * l2[j]); g[j] = sqrtf(fmaxf(1.0f - a2, 0.f)) * (fsigm(il[j]) * uf[j]); }
                    u32x2 w; w.x = pk2(l2[0], l2[1]); w.y = pk2(l2[2], l2[3]); *(u32x2*)(la + off) = w;
                    w.x = pk2(g[0], g[1]); w.y = pk2(g[2], g[3]); *(u32x2*)(gt + off) = w; }
                asm volatile("" ::: "memory"); __builtin_amdgcn_sched_barrier(0); }
    }
};
__device__ __forceinline__ void p10_conv_b(Frame& F, const bf16_t* U, const float* cw, const float* cb, bf16_t* ub) {
    const int gw = F.vcu * NWAVES + F.wave, NGW = F.G * NWAVES;
    for (int it = gw; it < 2048; it += NGW) {
        const int r0 = (it >> 1) * 16, c0 = (it & 1) * 512 + F.lane * 8, t0 = r0 % SEQ;
        float w0[8], w1[8], w2[8], w3[8], bb[8];
#pragma unroll
        for (int j = 0; j < 8; ++j) { w0[j] = cw[c0 + j]; w1[j] = cw[D + c0 + j]; w2[j] = cw[2 * D + c0 + j]; w3[j] = cw[3 * D + c0 + j]; bb[j] = cb[c0 + j]; }
        const bf16_t* up = U + (size_t)r0 * D + c0; bf16_t* op = ub + (size_t)r0 * D + c0;
        float x0[8], x1[8], x2[8], x3[8];
        if (t0 > 0) { unpack8(*(const GAS u32x4*)(up - 2 * D), x0); unpack8(*(const GAS u32x4*)(up - D), x1); } else {
#pragma unroll
            for (int j = 0; j < 8; ++j) { x0[j] = 0.f; x1[j] = 0.f; } }
        unpack8(*(const GAS u32x4*)up, x2);
#pragma unroll 4
        for (int r = 0; r < 16; ++r) {
            if (t0 + r + 1 < SEQ) unpack8(*(const GAS u32x4*)(up + (size_t)(r + 1) * D), x3); else {
#pragma unroll
                for (int j = 0; j < 8; ++j) x3[j] = 0.f; }
            float o[8];
#pragma unroll
            for (int j = 0; j < 8; ++j) { o[j] = bb[j] + w0[j] * x0[j] + w1[j] * x1[j] + w2[j] * x2[j] + w3[j] * x3[j]; x0[j] = x1[j]; x1[j] = x2[j]; x2[j] = x3[j]; }
            *(GAS u32x4*)(op + (size_t)r * D) = pack8(o);
        }
    }
}
__device__ __forceinline__ float h2f(bf16_t v) { return (float)__builtin_bit_cast(_Float16, v); }
template <bool WRITE>
__device__ __forceinline__ void scan_pass(const GAS bf16_t* la, const GAS bf16_t* gt, GAS bf16_t* hs, int d, LAS bf16_t* tl, LAS bf16_t* tg, int lane, float& h, float& lsum) {
    const int rr = lane >> 3, c8 = (lane & 7) * 8;
    u32x4 rl[4], rg[4];
    { const int b0 = d ? 7 : 0;
#pragma unroll
      for (int i = 0; i < 4; ++i) { const size_t o = (size_t)(b0 * 32 + 8 * i + rr) * D + c8; rl[i] = *(const GAS u32x4*)(la + o); rg[i] = *(const GAS u32x4*)(gt + o); } }
    for (int bi = 0; bi < 8; ++bi) {
        const int bt = d ? 7 - bi : bi;
#pragma unroll
        for (int i = 0; i < 4; ++i) { *(LAS u32x4*)(tl + (8 * i + rr) * 64 + c8) = rl[i]; *(LAS u32x4*)(tg + (8 * i + rr) * 64 + c8) = rg[i]; }
        if (bi < 7) { const int bn = d ? 6 - bi : bi + 1;
#pragma unroll
            for (int i = 0; i < 4; ++i) { const size_t o = (size_t)(bn * 32 + 8 * i + rr) * D + c8; rl[i] = *(const GAS u32x4*)(la + o); rg[i] = *(const GAS u32x4*)(gt + o); } }
#pragma unroll 8
        for (int s = 0; s < 32; ++s) { const int row = d ? 31 - s : s; const float l = h2f(tl[row * 64 + lane]), g = h2f(tg[row * 64 + lane]);
            h = __builtin_amdgcn_exp2f(l) * h + g; lsum += l;
            if (WRITE) tg[row * 64 + lane] = __builtin_bit_cast(bf16_t, (_Float16)h); }
        if (WRITE) {
#pragma unroll
            for (int i = 0; i < 4; ++i) { const u32x4 v = *(const LAS u32x4*)(tg + (8 * i + rr) * 64 + c8); *(GAS u32x4*)(hs + (size_t)(bt * 32 + 8 * i + rr) * D + c8) = v; } }
    }
}
__device__ __forceinline__ void p12_scan(Frame& F, const bf16_t* LA, const bf16_t* GT, bf16_t* HS) {
    LAS float* sA = (LAS float*)F.lds; LAS float* sS = sA + 512;
    LAS bf16_t* tl = (LAS bf16_t*)(F.lds + 4096 + F.wave * 8192); LAS bf16_t* tg = tl + 2048;
    for (int id = F.vcu; id < 256; id += F.G) {
        const int d = id >> 7, b = (id >> 4) & 7, cg = id & 15, chunk = F.wave;
        const size_t base = ((size_t)d * NTOK + (size_t)b * SEQ + (size_t)chunk * 256) * D + cg * 64;
        const GAS bf16_t* la = (const GAS bf16_t*)LA + base; const GAS bf16_t* gt = (const GAS bf16_t*)GT + base; GAS bf16_t* hs = (GAS bf16_t*)HS + base;
        float h = 0.f, lsum = 0.f;
        scan_pass<false>(la, gt, hs, d, tl, tg, F.lane, h, lsum);
        sA[chunk * 64 + F.lane] = __builtin_amdgcn_exp2f(lsum); sS[chunk * 64 + F.lane] = h;
        LDS_WAIT(); __syncthreads();
        float c = 0.f;
        if (d == 0) { for (int cc = 0; cc < chunk; ++cc) c = sA[cc * 64 + F.lane] * c + sS[cc * 64 + F.lane]; }
        else { for (int cc = 7; cc > chunk; --cc) c = sA[cc * 64 + F.lane] * c + sS[cc * 64 + F.lane]; }
        h = c; lsum = 0.f;
        scan_pass<true>(la, gt, hs, d, tl, tg, F.lane, h, lsum);
        LDS_WAIT(); __syncthreads();
    }
}
__device__ __forceinline__ void p13_mul(Frame& F, const bf16_t* YB, const bf16_t* HS, bf16_t* A2) {
    const size_t n8 = (size_t)NTOK * D / 8, stride = (size_t)F.G * NWAVES * 64;
    for (size_t i = ((size_t)F.vcu * NWAVES + F.wave) * 64 + F.lane; i < n8; i += stride) {
        float y[8], a[8], b[8], o[8]; unpack8(((const GAS u32x4*)YB)[i], y); unpack8(((const GAS u32x4*)HS)[i], a); unpack8(((const GAS u32x4*)HS)[n8 + i], b);
#pragma unroll
        for (int j = 0; j < 8; ++j) o[j] = y[j] * (a[j] + b[j]);
        ((GAS u32x4*)A2)[i] = pack8(o);
    }
}
__device__ __forceinline__ void p20_final(Frame& F, float* Hf, const float* ssp, const float* g, float bump) {
    DenseSched S; S.init(4, F.G, (int)blockIdx.x, D);
    pg::Unit u;
    for (int i = 0; S.next(i, u); ++i) {
        const f32x4 gv = *(const GAS f32x4*)(g + u.pn * 256 + F.lane * 4);
        for (int r4 = 0; r4 < 32; r4 += 4) {
            f32x4 h[4]; float s[4];
#pragma unroll
            for (int j = 0; j < 4; ++j) { const int row = u.orow + F.wave + 8 * (r4 + j); h[j] = *(const GAS f32x4*)(Hf + (size_t)row * D + u.pn * 256 + F.lane * 4); s[j] = row_rstd(ssp, row); }
#pragma unroll
            for (int j = 0; j < 4; ++j) { const int row = u.orow + F.wave + 8 * (r4 + j); f32x4 o = h[j] * s[j] * gv; if (row == 0 && u.pn == 0 && F.lane == 0) o[0] += bump; *(GAS f32x4*)(Hf + (size_t)row * D + u.pn * 256 + F.lane * 4) = o; }
        }
    }
}
__global__ void __launch_bounds__(NWAVES * 64, 2) mk_fwd(Args args) {
    extern __shared__ __attribute__((aligned(16))) unsigned char lds_[];
    Frame F;
    F.lds = (LAS unsigned char*)lds_;
    F.MISC = (volatile LAS unsigned*)(F.lds + MISC_OFF);
    F.tid = threadIdx.x; F.lane = F.tid & 63; F.wave = __builtin_amdgcn_readfirstlane(F.tid >> 6);
    F.G = gridDim.x; { const int bx = blockIdx.x; F.vcu = (F.G % 8 == 0) ? (bx % 8) * (F.G / 8) + bx / 8 : bx; }
    unsigned char* ws = args.ws;
    unsigned* ctl = (unsigned*)(ws + WS_CTL);
    for (int u = F.tid; u < (LDS_BYTES - MISC_OFF) / 4; u += NWAVES * 64) ((LAS unsigned*)(F.lds + MISC_OFF))[u] = 0u;
    __syncthreads();
    const int lo = args.ph_lo, hi = args.ph_hi;
    if (TS_PHASE >= 0 && blockIdx.x == 0 && threadIdx.x == 0) ((unsigned long long*)(ws + WS_CTL + 49152))[0] = __builtin_amdgcn_s_memrealtime();
    XcdBarrier bar; bar.bar = ctl + CW_BAR; bar.x = 0; bar.st = nullptr;
    if (hi - lo > 1) bar = xcd_barrier_post(ctl + CW_BAR, F.MISC + 8);
#define IN(k) (lo <= (k) && (k) < hi)
#define SEAM(k) do { if (IN(k) && IN((k) + 1)) { xcd_barrier(bar); if (REP_MASK & 0x80000000u) xcd_barrier(bar); } if (TS_PHASE >= 0 && blockIdx.x == 0 && threadIdx.x == 0) ((unsigned long long*)(ws + WS_CTL + 49152))[(k) + 1] = __builtin_amdgcn_s_memrealtime(); { int t_ = threadIdx.x; asm volatile("" : "+v"(t_)); F.tid = t_; F.lane = t_ & 63; } } while (0)
    bf16_t* wsm = (bf16_t*)(ws + WS_WSM);
    float* rstd = (float*)(ws + WS_RSTD);
    float* ssp0 = (float*)(ws + WS_SSP); float* ssp1 = (float*)(ws + WS_SSP1);
    float* Hf = args.out; bf16_t* Hb = (bf16_t*)(ws + WS_HB); bf16_t* PW = (bf16_t*)(ws + WS_PW); const bf16_t* pb = (const bf16_t*)(ws + WS_PB);
    const int c = (int)blockIdx.x;

    for (int rep_ = 0; rep_ < (((REP_MASK >> (0)) & 1) ? 2 : 1); ++rep_) if (IN(0)) { p0_prologue(F, args, 0, N_PREP_JOBS); }
    SEAM(0);
    {
            for (int rep_ = 0; rep_ < (((REP_MASK >> (1)) & 1) ? 2 : 1); ++rep_) if (IN(1)) {
                { pg::GemmDesc g{(const bf16_t*)(ws + WS_R(0)), D, wsm + OFF_WINA / 2, D, D};
                  DenseSched S; S.init(12, F.G, c, D);
                  { LAS float* rt = (LAS float*)(F.lds + TAB_OFF); pg::Unit u_; __syncthreads(); for (int i = 0; S.next(i, u_); ++i) if (F.tid < 256) rt[i * 256 + F.tid] = rstd[u_.orow + F.tid]; LDS_WAIT(); __syncthreads(); }
                  EpiInA E{(bf16_t*)(ws + WS_R(1)), (bf16_t*)(ws + WS_R(2)), (const LAS float*)(F.lds + TAB_OFF)};
                  pg::gemm_phase<EpiInA, DenseSched, true>(F.lds, g, S, E); }
                { pg::GemmDesc g{pb, 256, wsm + OFF_WPLE / 2, 256, 256};
                  DenseSched S; S.init(4, F.G, c, 256);
                  EpiLin E{PW, PW, 99, 0, 0, nullptr};
                  pg::gemm_phase<EpiLin, DenseSched, true>(F.lds, g, S, E); }
            }
            SEAM(1);
            for (int rep_ = 0; rep_ < (((REP_MASK >> (2)) & 1) ? 2 : 1); ++rep_) if (IN(2)) p2_conv_a(F, (const bf16_t*)(ws + WS_R(1)), (const bf16_t*)(ws + WS_R(2)), args.in[4], (bf16_t*)(ws + WS_R(3)));
            SEAM(2);
            for (int rep_ = 0; rep_ < (((REP_MASK >> (3)) & 1) ? 2 : 1); ++rep_) if (IN(3)) {
                pg::GemmDesc g{(const bf16_t*)(ws + WS_R(3)), D, wsm + OFF_WOUTA / 2, D, D};
                DenseSched S; S.init(4, F.G, c, D);
                EpiResid E{args.in[0], Hf, Hb, ssp0};
                pg::gemm_phase<EpiResid, DenseSched, true>(F.lds, g, S, E);
            }
            SEAM(3);
    }
    {
        const int PB = 4;
        unsigned* gcnt = ctl + CW_CNT + 0;
        int* lslot = (int*)(ws + WS_LSLOT); float* lw = (float*)(ws + WS_LW);
        bf16_t* wmoe = (bf16_t*)(ws + WS_WMOE + (size_t)0 * 96 * MiB);
        bf16_t* HID = (bf16_t*)(ws + WS_R(0)); bf16_t* Y = (bf16_t*)(ws + WS_R(2));
        for (int rep_ = 0; rep_ < (((REP_MASK >> (PB)) & 1) ? 2 : 1); ++rep_) if (IN(PB)) p4_router(F, Hf, (const float*)(ws + WS_WRT) + (size_t)0 * 48 * D, args.in[17] + 0 * 4, args.in[19] + 0 * 32, rep_ ? ctl + CW_CNT + 256 : gcnt, rep_ ? (int*)(ws + WS_R(5)) : lslot, rep_ ? (float*)(ws + WS_R(5) + 4 * MiB) : lw, rstd);
        SEAM(PB);
        for (int rep_ = 0; rep_ < (((REP_MASK >> (PB + 1)) & 1) ? 2 : 1); ++rep_) if (IN(PB + 1)) {
            const int n = moe_setup(F, gcnt, lslot, lw, rstd, 0);
            MoeSched S{(LAS int*)(F.lds + TAB_OFF), n, (const LAS unsigned*)(F.lds + TAB_OFF + 128), 0, D * 2};
            pg::GemmDesc g{Hb, D, wmoe, D, D};
            EpiUp E{HID, (const LAS unsigned*)(F.lds + TAB_OFF + 128 + MAXU * 1024)};
            pg::gemm_phase<EpiUp, MoeSched, true>(F.lds, g, S, E);
        }
        SEAM(PB + 1);
        for (int rep_ = 0; rep_ < (((REP_MASK >> (PB + 2)) & 1) ? 2 : 1); ++rep_) if (IN(PB + 2)) {
            const int n = moe_setup(F, gcnt, lslot, lw, rstd, 1);
            MoeSched S{(LAS int*)(F.lds + TAB_OFF), n, (const LAS unsigned*)(F.lds + TAB_OFF + 128), 1, FEXP * 2};
            pg::GemmDesc g{HID, FEXP, wmoe + (size_t)32 * 1024 * D, FEXP, FEXP};
            EpiDown E{Y, (const LAS unsigned*)(F.lds + TAB_OFF + 128), (const LAS unsigned*)(F.lds + TAB_OFF + 128 + MAXU * 1024)};
            pg::gemm_phase<EpiDown, MoeSched, true>(F.lds, g, S, E);
        }
        SEAM(PB + 2);
        for (int rep_ = 0; rep_ < (((REP_MASK >> (PB + 3)) & 1) ? 2 : 1); ++rep_) if (IN(PB + 3)) p7_combine(F, Hf, Hb, Y, ssp0);
        SEAM(PB + 3);
        for (int rep_ = 0; rep_ < (((REP_MASK >> (PB + 4)) & 1) ? 2 : 1); ++rep_) if (IN(PB + 4)) {
            pg::GemmDesc g{Hb, D, wsm + OFF_WPLEG / 2 + (size_t)0 * D * D, D, D};
            DenseSched S; S.init(4, F.G, c, D);
            rstd_table_setup(F, S, ssp0, args.in[26] + 0 * D);
            EpiPle E{Hf, Hb, (const LAS float*)(F.lds + TAB_OFF), ssp1, PW};
            pg::gemm_phase<EpiPle, DenseSched, true>(F.lds, g, S, E);
        }
        SEAM(PB + 4);
    }
    {
            bf16_t* YB = (bf16_t*)(ws + WS_R(0)); bf16_t* Ub = (bf16_t*)(ws + WS_R(1)); bf16_t* ub = (bf16_t*)(ws + WS_R(2));
            bf16_t* LA = (bf16_t*)(ws + WS_WMOE); bf16_t* GT = (bf16_t*)(ws + WS_R(3)); bf16_t* A2 = (bf16_t*)(ws + WS_R(5));
            for (int rep_ = 0; rep_ < (((REP_MASK >> (9)) & 1) ? 2 : 1); ++rep_) if (IN(9)) {
                { pg::GemmDesc g{Hb, D, wsm + OFF_WINB / 2, D, D};
                  DenseSched S; S.init(8, F.G, c, D);
                  rstd_table_setup(F, S, ssp1, nullptr);
                  EpiLin E{YB, Ub, 4, 1, 0, (const LAS float*)(F.lds + TAB_OFF)};
                  pg::gemm_phase<EpiLin, DenseSched, true>(F.lds, g, S, E); }
                { pg::GemmDesc g{pb + (size_t)NTOK * 256, 256, wsm + OFF_WPLE / 2 + (size_t)D * 256, 256, 256};
                  DenseSched S; S.init(4, F.G, c, 256);
                  EpiLin E{PW, PW, 99, 0, 0, nullptr};
                  pg::gemm_phase<EpiLin, DenseSched, true>(F.lds, g, S, E); }
            }
            SEAM(9);
            for (int rep_ = 0; rep_ < (((REP_MASK >> (10)) & 1) ? 2 : 1); ++rep_) if (IN(10)) p10_conv_b(F, Ub, args.in[7], args.in[8], ub);
            SEAM(10);
            for (int rep_ = 0; rep_ < (((REP_MASK >> (11)) & 1) ? 2 : 1); ++rep_) if (IN(11)) {
                pg::GemmDesc g{ub, D, wsm + OFF_WGATE / 2, 256, 256};
                GateSched S; S.init(F.G, c);
                EpiGate E{LA, GT, ub, args.in[10], args.in[12], args.in[13]};
                pg::gemm_phase<EpiGate, GateSched, true>(F.lds, g, S, E);
            }
            SEAM(11);
            for (int rep_ = 0; rep_ < (((REP_MASK >> (12)) & 1) ? 2 : 1); ++rep_) if (IN(12)) p12_scan(F, LA, GT, (bf16_t*)(ws + WS_R(1)));
            SEAM(12);
            for (int rep_ = 0; rep_ < (((REP_MASK >> (13)) & 1) ? 2 : 1); ++rep_) if (IN(13)) p13_mul(F, YB, (const bf16_t*)(ws + WS_R(1)), A2);
            SEAM(13);
            for (int rep_ = 0; rep_ < (((REP_MASK >> (14)) & 1) ? 2 : 1); ++rep_) if (IN(14)) {
                pg::GemmDesc g{A2, D, wsm + OFF_WOUTB / 2, D, D};
                DenseSched S; S.init(4, F.G, c, D);
                EpiResid E{Hf, Hf, Hb, ssp0};
                pg::gemm_phase<EpiResid, DenseSched, true>(F.lds, g, S, E);
            }
            SEAM(14);
    }
    {
        const int PB = 15;
        unsigned* gcnt = ctl + CW_CNT + 64;
        int* lslot = (int*)(ws + WS_LSLOT); float* lw = (float*)(ws + WS_LW);
        bf16_t* wmoe = (bf16_t*)(ws + WS_WMOE + (size_t)1 * 96 * MiB);
        bf16_t* HID = (bf16_t*)(ws + WS_R(0)); bf16_t* Y = (bf16_t*)(ws + WS_R(2));
        for (int rep_ = 0; rep_ < (((REP_MASK >> (PB)) & 1) ? 2 : 1); ++rep_) if (IN(PB)) p4_router(F, Hf, (const float*)(ws + WS_WRT) + (size_t)1 * 48 * D, args.in[17] + 1 * 4, args.in[19] + 1 * 32, rep_ ? ctl + CW_CNT + 320 : gcnt, rep_ ? (int*)(ws + WS_R(5)) : lslot, rep_ ? (float*)(ws + WS_R(5) + 4 * MiB) : lw, rstd);
        SEAM(PB);
        for (int rep_ = 0; rep_ < (((REP_MASK >> (PB + 1)) & 1) ? 2 : 1); ++rep_) if (IN(PB + 1)) {
            const int n = moe_setup(F, gcnt, lslot, lw, rstd, 0);
            MoeSched S{(LAS int*)(F.lds + TAB_OFF), n, (const LAS unsigned*)(F.lds + TAB_OFF + 128), 0, D * 2};
            pg::GemmDesc g{Hb, D, wmoe, D, D};
            EpiUp E{HID, (const LAS unsigned*)(F.lds + TAB_OFF + 128 + MAXU * 1024)};
            pg::gemm_phase<EpiUp, MoeSched, true>(F.lds, g, S, E);
        }
        SEAM(PB + 1);
        for (int rep_ = 0; rep_ < (((REP_MASK >> (PB + 2)) & 1) ? 2 : 1); ++rep_) if (IN(PB + 2)) {
            const int n = moe_setup(F, gcnt, lslot, lw, rstd, 1);
            MoeSched S{(LAS int*)(F.lds + TAB_OFF), n, (const LAS unsigned*)(F.lds + TAB_OFF + 128), 1, FEXP * 2};
            pg::GemmDesc g{HID, FEXP, wmoe + (size_t)32 * 1024 * D, FEXP, FEXP};
            EpiDown E{Y, (const LAS unsigned*)(F.lds + TAB_OFF + 128), (const LAS unsigned*)(F.lds + TAB_OFF + 128 + MAXU * 1024)};
            pg::gemm_phase<EpiDown, MoeSched, true>(F.lds, g, S, E);
        }
        SEAM(PB + 2);
        for (int rep_ = 0; rep_ < (((REP_MASK >> (PB + 3)) & 1) ? 2 : 1); ++rep_) if (IN(PB + 3)) p7_combine(F, Hf, Hb, Y, ssp0);
        SEAM(PB + 3);
        for (int rep_ = 0; rep_ < (((REP_MASK >> (PB + 4)) & 1) ? 2 : 1); ++rep_) if (IN(PB + 4)) {
            pg::GemmDesc g{Hb, D, wsm + OFF_WPLEG / 2 + (size_t)1 * D * D, D, D};
            DenseSched S; S.init(4, F.G, c, D);
            rstd_table_setup(F, S, ssp0, args.in[26] + 1 * D);
            EpiPle E{Hf, Hb, (const LAS float*)(F.lds + TAB_OFF), ssp1, PW};
            pg::gemm_phase<EpiPle, DenseSched, true>(F.lds, g, S, E);
        }
        SEAM(PB + 4);
    }
    for (int rep_ = 0; rep_ < (((REP_MASK >> (20)) & 1) ? 2 : 1); ++rep_) if (IN(20)) { float bump = 0.f; if (TS_PHASE >= 0) { const unsigned long long* ts = (const unsigned long long*)(ws + WS_CTL + 49152); bump = sqrtf(167.0f * 0.01f * (float)(ts[TS_PHASE + 1] - ts[TS_PHASE])); }
        p20_final(F, Hf, ssp1, args.in[27], bump); }
#undef IN
#undef SEAM
}
extern "C" void kernel_launch(void* const* d_in, const int* in_sizes, int n_in, void* d_out, int out_size, void* d_ws, size_t ws_size, hipStream_t stream) {
    static int grid = 0;
    if (grid == 0) {
        if (n_in != 28 || out_size != NTOK * D || ws_size < WS_END) { fprintf(stderr, "kernel_launch: unexpected problem (n_in %d, out %d, ws %zu < %zu)\n", n_in, out_size, ws_size, (size_t)WS_END); grid = -1; return; }
        int dev = 0, cus = 0, per_cu = 0;
        if (hipGetDevice(&dev) != hipSuccess || hipDeviceGetAttribute(&cus, hipDeviceAttributeMultiprocessorCount, dev) != hipSuccess) { grid = -1; return; }
        if (hipFuncSetAttribute((const void*)mk_fwd, hipFuncAttributeMaxDynamicSharedMemorySize, LDS_BYTES) != hipSuccess) { grid = -1; return; }
        if (hipOccupancyMaxActiveBlocksPerMultiprocessor(&per_cu, (const void*)mk_fwd, NWAVES * 64, LDS_BYTES) != hipSuccess || per_cu < 1) { fprintf(stderr, "kernel_launch: occupancy query says %d\n", per_cu); per_cu = 1; }
        (void)hipGetLastError();
        grid = cus;
    }
    if (grid < 0) return;
    (void)in_sizes;
    (void)hipMemsetAsync((char*)d_ws + WS_CTL, 0, CTL_ZERO_BYTES, stream);
    Args a{};
    for (int i = 0; i < 28; ++i) a.in[i] = (const float*)d_in[i];
    a.out = (float*)d_out; a.ws = (unsigned char*)d_ws; a.ph_lo = 0; a.ph_hi = 21;
    hipLaunchKernelGGL(mk_fwd, dim3(grid), dim3(NWAVES * 64), LDS_BYTES, stream, a);
}
```

```cpp
#include <hip/hip_runtime.h>
#include <cstdio>
#include <cstdint>
constexpr int D = 1024, BATCH = 8, SEQ = 2048, NTOK = BATCH * SEQ, PLE = 256, NEXP = 32, FEXP = 512, CAP = NTOK;
constexpr float EPS = 1e-6f;
constexpr unsigned REP_MASK = 0u; constexpr int TS_PHASE = -1; constexpr bool NULL_EPI = false;
#define LAS __attribute__((address_space(3)))
#define GAS __attribute__((address_space(1)))
typedef unsigned short bf16_t;
typedef short bf16x8 __attribute__((ext_vector_type(8)));
typedef _Float16 half8 __attribute__((ext_vector_type(8)));
typedef _Float16 half2v __attribute__((ext_vector_type(2)));
typedef float f32x4 __attribute__((ext_vector_type(4)));
typedef float f32x2 __attribute__((ext_vector_type(2)));
typedef unsigned u32x4 __attribute__((ext_vector_type(4)));
typedef unsigned u32x2 __attribute__((ext_vector_type(2)));
namespace pg {
constexpr int BM = 256, BK = 64, HALF = 128, HTB = HALF * BK * 2, STAGE_BYTES = 8 * HTB, NXCD = 8, WGM = 8;
__host__ __device__ __forceinline__ int lds_byte(int r, int c) { const int st = (r >> 4) * 2 + (c >> 5), rr = r & 15, cc = c & 31, ob = rr * 64 + cc * 2; return st * 1024 + (ob ^ (((ob >> 9) & 1) << 5)); }
__host__ __device__ __forceinline__ void stage_rc(int b, int& R, int& C) { const int st = b / 1024, sb = b % 1024, swz = sb ^ (((sb >> 9) & 1) << 5); R = (st >> 1) * 16 + swz / 64; C = (st & 1) * 32 + (swz % 64) / 2; }

struct Unit { int arow, acol, brow, orow, pn, aux; };
struct GemmDesc { const bf16_t* A; int lda; const bf16_t* Bt; int ldb; int K; };

struct DenseOrder {
    int nM, nN, nwg, G, c;
    __device__ __forceinline__ void init(int nM_, int nN_, int G_, int c_) { nM = nM_; nN = nN_; nwg = nM * nN; G = G_; c = c_; }
    __device__ __forceinline__ bool tile(int i, int& pm, int& pn) const {
        const long L = (long)i * G + c; if (L >= nwg) return false;
        int wgid = (int)L; { const int q = nwg / NXCD, r = nwg % NXCD, xcd = wgid % NXCD, off = wgid / NXCD; wgid = (xcd < r ? xcd * (q + 1) : r * (q + 1) + (xcd - r) * q) + off; }
        const int nig = WGM * nN, gid = wgid / nig, fm = gid * WGM, gsz = (nM - fm) < WGM ? (nM - fm) : WGM;
        pm = fm + ((wgid % nig) % gsz); pn = (wgid % nig) / gsz; return true;
    }
};

__device__ __forceinline__ unsigned cvt_pk_bf16(float lo, float hi) { half2v v; v.x = (_Float16)lo; v.y = (_Float16)hi; return __builtin_bit_cast(unsigned, v); }

template <class Epi, class Sched, bool ALIGN_EPI>
__device__ __forceinline__ void gemm_phase(LAS unsigned char* lds, const GemmDesc g, const Sched& S, const Epi& E) {
    int tid_ = threadIdx.x; asm volatile("" : "+v"(tid_));
    const int tid = tid_, wid = __builtin_amdgcn_readfirstlane(tid >> 6), lane = tid & 63, wr = wid >> 2, wc = wid & 3, fr = lane & 15, fq = lane >> 4;
    const int K = g.K, nt = K / BK;
    int R0, C0; stage_rc(tid * 16, R0, C0);
    unsigned voffB[2]; voffB[0] = (unsigned)(R0 * g.ldb + C0) * 2u; voffB[1] = voffB[0] + (unsigned)(64 * g.ldb) * 2u;
    const unsigned c2 = (unsigned)C0 * 2u;
    const size_t kstep = (size_t)(BK * 2);
    const size_t hstepB = (size_t)HALF * g.ldb * 2;
    const unsigned ldsw = (unsigned)wid * 1024u;
    const int aoff = lds_byte(wr * 64 + fr, fq * 8), boff = lds_byte(wc * 32 + fr, fq * 8);
#define PG_SA(b, h) (((b) * 2 + (h)) * HTB)
#define PG_SB(b, h) ((4 + (b) * 2 + (h)) * HTB)
#define PG_STAGE(bufoff, gbase, voff) do { _Pragma("unroll") for (int _i = 0; _i < 2; ++_i) \
        __builtin_amdgcn_global_load_lds((const unsigned*)((const char*)(gbase) + (voff)[_i]), (LAS unsigned*)(lds + (bufoff) + ldsw + _i * 8192), 16, 0, 0); } while (0)
#define PG_LDA(dst, b, h) do { _Pragma("unroll") for (int m = 0; m < 4; ++m) _Pragma("unroll") for (int k = 0; k < 2; ++k) dst[m][k] = *(const LAS bf16x8*)(lds + PG_SA(b, h) + aoff + m * 2048 + k * 1024); } while (0)
#define PG_LDB(dst, b, h) do { _Pragma("unroll") for (int n = 0; n < 2; ++n) _Pragma("unroll") for (int k = 0; k < 2; ++k) dst[n][k] = *(const LAS bf16x8*)(lds + PG_SB(b, h) + boff + n * 2048 + k * 1024); } while (0)
#define PG_MMA(ai, bj, At, Bt) do { __builtin_amdgcn_s_setprio(1); _Pragma("unroll") for (int m = 0; m < 4; ++m) _Pragma("unroll") for (int n = 0; n < 2; ++n) _Pragma("unroll") for (int k = 0; k < 2; ++k) \
        acc[ai][bj][m][n] = __builtin_amdgcn_mfma_f32_16x16x32_f16(__builtin_bit_cast(half8, Bt[n][k]), __builtin_bit_cast(half8, At[m][k]), acc[ai][bj][m][n], 0, 0, 0); __builtin_amdgcn_s_setprio(0); } while (0)
#define PG_WAIT_V(n) asm volatile("s_waitcnt vmcnt(" #n ")" ::: "memory")
#define PG_WAIT_L(n) asm volatile("s_waitcnt lgkmcnt(" #n ")" ::: "memory")
#define PG_BAR __builtin_amdgcn_s_barrier()
#define PG_SCHED __builtin_amdgcn_sched_barrier(0)
    Unit cur, nxt; int ui = 0;
    if (!S.next(0, cur)) return;
    f32x4 acc[2][2][4][2];
#pragma unroll
    for (int a = 0; a < 2; ++a)
#pragma unroll
        for (int b = 0; b < 2; ++b)
#pragma unroll
            for (int m = 0; m < 4; ++m)
#pragma unroll
                for (int n = 0; n < 2; ++n) acc[a][b][m][n] = (f32x4){0.f, 0.f, 0.f, 0.f};
    bf16x8 At[4][2], B0[2][2], B1[2][2];
    unsigned offA[2][2];
    S.a_offs(cur, R0, c2, offA);
    const char* Ab = (const char*)g.A;
    const char* cB = (const char*)g.Bt + (size_t)cur.brow * g.ldb * 2;
    PG_STAGE(PG_SB(0, 0), cB, voffB); PG_STAGE(PG_SB(0, 1), cB + hstepB, voffB); PG_STAGE(PG_SA(0, 0), Ab, offA[0]); PG_STAGE(PG_SA(0, 1), Ab, offA[1]);
    if (wr == 1) PG_BAR;
    PG_WAIT_V(2); PG_BAR;
    PG_STAGE(PG_SB(1, 0), cB + kstep, voffB); PG_STAGE(PG_SA(1, 0), Ab + kstep, offA[0]); PG_STAGE(PG_SB(1, 1), cB + hstepB + kstep, voffB);
    PG_WAIT_V(6); PG_BAR;
    for (;;) {
        const bool has_next = S.next(ui + 1, nxt);
        const char* nB = has_next ? (const char*)g.Bt + (size_t)nxt.brow * g.ldb * 2 : cB;
        unsigned offN[2][2]; S.a_offs(has_next ? nxt : cur, R0, c2, offN);
#pragma clang loop unroll(disable)
        for (int t = 0; t < nt; t += 2) {
            const bool last = (t == nt - 2);
            const char* a1 = Ab + (size_t)(t + 1) * kstep;
            const char* a2 = last ? Ab : Ab + (size_t)(t + 2) * kstep; const char* b2 = last ? nB : cB + (size_t)(t + 2) * kstep;
            const char* a3 = a2 + kstep; const char* b3 = b2 + kstep;
            PG_LDB(B0, 0, 0); PG_LDB(B1, 0, 1); PG_SCHED; PG_LDA(At, 0, 0); PG_STAGE(PG_SA(1, 1), a1, offA[1]);
#pragma unroll
            for (int h_ = 0; h_ < 2; ++h_)
#pragma unroll
                for (int i_ = 0; i_ < 2; ++i_) offA[h_][i_] = last ? offN[h_][i_] : offA[h_][i_];
            PG_WAIT_V(8); PG_WAIT_L(0); PG_BAR; PG_MMA(0, 0, At, B0); PG_MMA(0, 1, At, B1); PG_BAR; PG_SCHED;
            PG_LDA(At, 0, 1); PG_STAGE(PG_SB(0, 0), b2, voffB); PG_STAGE(PG_SB(0, 1), b2 + hstepB, voffB); PG_STAGE(PG_SA(0, 0), a2, offA[0]);
            PG_WAIT_V(8); PG_WAIT_L(0); PG_BAR; PG_MMA(1, 0, At, B0); PG_MMA(1, 1, At, B1); PG_BAR; PG_SCHED;
            PG_LDB(B0, 1, 0); PG_LDB(B1, 1, 1); PG_SCHED; PG_LDA(At, 1, 0); PG_STAGE(PG_SA(0, 1), a2, offA[1]);
            PG_WAIT_V(8); PG_WAIT_L(0); PG_BAR; PG_MMA(0, 0, At, B0); PG_MMA(0, 1, At, B1); PG_BAR; PG_SCHED;
            PG_LDA(At, 1, 1); PG_STAGE(PG_SB(1, 0), b3, voffB); PG_STAGE(PG_SB(1, 1), b3 + hstepB, voffB); PG_STAGE(PG_SA(1, 0), a3, offA[0]);
            PG_WAIT_V(8); PG_WAIT_L(0); PG_BAR; PG_MMA(1, 0, At, B0); PG_MMA(1, 1, At, B1); PG_BAR; PG_SCHED;
        }
        if constexpr (ALIGN_EPI) { if (wr == 0) PG_BAR; }
        { int fr_e = fr, fq_e = fq; asm volatile("" : "+v"(fr_e), "+v"(fq_e));
          E(acc, cur, wr, wc, fr_e, fq_e); }
        __builtin_amdgcn_s_waitcnt(0x0F70);
        if (!has_next) break;
#pragma unroll
        for (int a = 0; a < 2; ++a)
#pragma unroll
            for (int b = 0; b < 2; ++b)
#pragma unroll
                for (int m = 0; m < 4; ++m)
#pragma unroll
                    for (int n = 0; n < 2; ++n) acc[a][b][m][n] = (f32x4){0.f, 0.f, 0.f, 0.f};
        cur = nxt; cB = nB; ++ui;
        if constexpr (ALIGN_EPI) { if (wr == 1) PG_BAR; }
    }
    PG_WAIT_V(0);
    if constexpr (!ALIGN_EPI) { if (wr == 0) PG_BAR; }
    PG_BAR;
#undef PG_SA
#undef PG_SB
#undef PG_STAGE
#undef PG_LDA
#undef PG_LDB
#undef PG_MMA
#undef PG_WAIT_V
#undef PG_WAIT_L
#undef PG_BAR
#undef PG_SCHED
}
}

typedef GAS unsigned gu32;
#define XB_TMO      128
#define XB_XCNT(j)  (256  + 64 * (j))
#define XB_XSUB(j)  (1280 + 64 * (j))
#define XB_XGEN(j)  (2304 + 64 * (j))
#define XB_TOP      3328
#define XB_TOPGEN   3392
#define XCD_BAR_WORDS 3456
#define XB_SPIN_CAP (1u << 18)
__device__ __forceinline__ unsigned xb_ld(unsigned* p)              { return __hip_atomic_load(p, __ATOMIC_RELAXED, __HIP_MEMORY_SCOPE_AGENT); }
__device__ __forceinline__ unsigned xb_add(unsigned* p, unsigned v) { return __hip_atomic_fetch_add(p, v, __ATOMIC_RELAXED, __HIP_MEMORY_SCOPE_AGENT); }
__device__ __forceinline__ unsigned xb_xcc_id() { return (unsigned)__builtin_amdgcn_s_getreg((3 << 11) | 20) & 0xFu; }
#define XB_SPIN(cond, bar) do { unsigned _sp = 0; while (cond) { __builtin_amdgcn_s_sleep(1); \
    if ((++_sp & 255u) == 0u) { if (xb_ld(&(bar)[XB_TMO])) break; if (_sp > XB_SPIN_CAP) { atomicAdd(&(bar)[XB_TMO], 1u); break; } } } } while (0)
struct XcdBarrier { unsigned* bar; unsigned x; volatile LAS unsigned* st; };
__device__ __forceinline__ XcdBarrier xcd_barrier_post(unsigned* bar, volatile LAS unsigned* st) {
    XcdBarrier b; b.bar = bar; b.x = xb_xcc_id(); b.st = st;
    if (threadIdx.x == 0) (void)xb_add(&bar[XB_XCNT(b.x)], 1u);
    return b;
}
__device__ __forceinline__ void xcd_barrier_complete(unsigned* bar, unsigned x, unsigned& nloc, unsigned& nx) {
    const unsigned G = gridDim.x * gridDim.y * gridDim.z;
    unsigned sum, cnt, mine, sp = 0u;
    for (;;) {
        sum = 0u; cnt = 0u; mine = 0u;
#pragma unroll
        for (unsigned j = 0; j < 16; ++j) { const unsigned c = xb_ld(&bar[XB_XCNT(j)]); sum += c; cnt += (c > 0u) ? 1u : 0u; mine = (j == x) ? c : mine; }
        if (sum == G) break;
        __builtin_amdgcn_s_sleep(1);
        if ((++sp & 255u) == 0u) { if (xb_ld(&bar[XB_TMO])) break; if (sp > XB_SPIN_CAP) { atomicAdd(&bar[XB_TMO], 1u); break; } }
    }
    nloc = mine > 0u ? mine : 1u; nx = cnt > 0u ? cnt : 1u;
}
__device__ __forceinline__ void xcd_barrier(const XcdBarrier& b) {
    asm volatile("s_waitcnt vmcnt(0)" ::: "memory");
    __syncthreads();
    if (threadIdx.x == 0) {
        unsigned* bar = b.bar;
        __builtin_amdgcn_s_waitcnt(0);
        unsigned nloc = b.st[0], nx = b.st[1];
        if (nloc == 0u) { xcd_barrier_complete(bar, b.x, nloc, nx); b.st[0] = nloc; b.st[1] = nx; }
        const unsigned old = xb_add(&bar[XB_XSUB(b.x)], 1u);
        const unsigned gen = old / nloc;
        if (old + 1u == (gen + 1u) * nloc) {
            __builtin_amdgcn_fence(__ATOMIC_RELEASE, "agent");
            asm volatile("s_waitcnt vmcnt(0)" ::: "memory");
            const unsigned og = xb_add(&bar[XB_TOP], 1u);
            const unsigned tg = og / nx;
            if (og + 1u == (tg + 1u) * nx) xb_add(&bar[XB_TOPGEN], 1u);
            else XB_SPIN(xb_ld(&bar[XB_TOPGEN]) == tg, bar);
            __builtin_amdgcn_fence(__ATOMIC_ACQUIRE, "agent");
            xb_add(&bar[XB_XGEN(b.x)], 1u);
            asm volatile("s_waitcnt vmcnt(0)" ::: "memory");
        } else {
            XB_SPIN(xb_ld(&bar[XB_XGEN(b.x)]) == gen, bar);
            __builtin_amdgcn_fence(__ATOMIC_ACQUIRE, "agent");
            asm volatile("s_waitcnt vmcnt(0)" ::: "memory");
        }
    }
    __syncthreads();
}
constexpr int NWAVES = 8;
constexpr size_t MiB = 1u << 20;
constexpr int LDS_BYTES = 147456;
constexpr int RING_BYTES = 131072;
constexpr int TAB_OFF = RING_BYTES;
constexpr int TAB_BYTES = 12288;
constexpr int MISC_OFF = TAB_OFF + TAB_BYTES;
constexpr size_t WS_CTL = 0;
constexpr size_t CTL_ZERO_BYTES = 64 * 1024;
constexpr int CW_BAR = 1024;
constexpr int CW_CNT = 8192;
constexpr size_t WS_SSP = 1 * MiB;
constexpr size_t WS_SSP1 = 6 * MiB + 512 * 1024;
constexpr size_t WS_RSTD = 2 * MiB;
constexpr size_t WS_LSLOT = 2 * MiB + 256 * 1024;
constexpr size_t WS_LW = WS_LSLOT + 2 * MiB;
constexpr size_t WS_WRT = 7 * MiB + 512 * 1024;
constexpr size_t WS_WSM = 8 * MiB;
constexpr size_t OFF_WINA = 0, OFF_WOUTA = 6 * MiB, OFF_WINB = 8 * MiB, OFF_WGATE = 12 * MiB, OFF_WOUTB = 14 * MiB, OFF_WPLEG = 16 * MiB, OFF_WPLE = 20 * MiB;
constexpr size_t WS_WMOE = 30 * MiB;
constexpr size_t WS_HB = 222 * MiB;
constexpr size_t WS_PW = 254 * MiB;
constexpr size_t WS_PB = 286 * MiB;
constexpr size_t WS_R0 = 302 * MiB, RSZ = 32 * MiB;
constexpr size_t WS_END = WS_R0 + 6 * RSZ + 28 * MiB;
#define WS_R(i) (WS_R0 + (size_t)(i) * RSZ)

#define RLX_AGENT __ATOMIC_RELAXED, __HIP_MEMORY_SCOPE_AGENT
#define LDS_WAIT() asm volatile("s_waitcnt lgkmcnt(0)" ::: "memory")
#define VM_WAIT() asm volatile("s_waitcnt vmcnt(0)" ::: "memory")
__device__ __forceinline__ unsigned pk2(float lo, float hi) { return pg::cvt_pk_bf16(lo, hi); }
__device__ __forceinline__ float bf_lo(unsigned w) { return (float)__builtin_bit_cast(half2v, w).x; }
__device__ __forceinline__ float bf_hi(unsigned w) { return (float)__builtin_bit_cast(half2v, w).y; }
__device__ __forceinline__ void unpack8(const u32x4 w, float (&f)[8]) { f[0] = bf_lo(w.x); f[1] = bf_hi(w.x); f[2] = bf_lo(w.y); f[3] = bf_hi(w.y); f[4] = bf_lo(w.z); f[5] = bf_hi(w.z); f[6] = bf_lo(w.w); f[7] = bf_hi(w.w); }
__device__ __forceinline__ u32x4 pack8(const float (&f)[8]) { u32x4 w; w.x = pk2(f[0], f[1]); w.y = pk2(f[2], f[3]); w.z = pk2(f[4], f[5]); w.w = pk2(f[6], f[7]); return w; }
__device__ __forceinline__ float wave_sum(float v) {
#pragma unroll
    for (int o = 1; o < 64; o <<= 1) v += __shfl_xor(v, o);
    return v;
}
__device__ __forceinline__ float fsigm(float x) { return __builtin_amdgcn_rcpf(1.0f + __builtin_amdgcn_exp2f(-1.4426950408889634f * x)); }

__device__ __forceinline__ int map_lin8(int c) { const int q = c & 31; return (c & ~31) + 16 * ((q >> 2) & 1) + 4 * (q >> 3) + (q & 3); }
__device__ __forceinline__ int map_pair(int ch, int type) { return 256 * (ch >> 7) + 128 * ((ch >> 6) & 1) + 32 * ((ch >> 4) & 3) + 16 * type + (ch & 15); }

struct Args { const float* in[28]; float* out; unsigned char* ws; int ph_lo, ph_hi; };

struct Frame {
    LAS unsigned char* lds;
    volatile LAS unsigned* MISC;
    int tid, lane, wave, vcu, G;
};

struct PrepJob { const float* W; int ldw, K, ncols, nbatch; size_t sbs; const float* gain; bf16_t* dst; size_t dbs; int mode, type; };
__device__ __forceinline__ void prep_item(const PrepJob& J, LAS float* scr, int item, int lane) {
    const int nblk = J.ncols / 64, per = (J.K / 64) * nblk, b = item / per, r = item % per, kb = r / nblk, nb = r % nblk, k0 = 64 * kb, n0 = 64 * nb;
    const float* W = J.W + (size_t)b * J.sbs; bf16_t* WT = J.dst + (size_t)b * J.dbs;
    const int kr = lane >> 4, nq = lane & 15;
    f32x4 v[16];
#pragma unroll
    for (int i = 0; i < 16; ++i) v[i] = *(const GAS f32x4*)(W + (size_t)(k0 + 4 * i + kr) * J.ldw + n0 + 4 * nq);
    if (J.gain) {
#pragma unroll
        for (int i = 0; i < 16; ++i) v[i] = v[i] * J.gain[k0 + 4 * i + kr]; }
#pragma unroll
    for (int i = 0; i < 16; ++i) { LAS float* d = scr + (4 * i + kr) * 65 + 4 * nq; d[0] = v[i][0]; d[1] = v[i][1]; d[2] = v[i][2]; d[3] = v[i][3]; }
    LDS_WAIT(); asm volatile("" ::: "memory");
    const int c = lane & 7;
#pragma unroll
    for (int j = 0; j < 8; ++j) { const int n = (lane >> 3) + 8 * j; const LAS float* s = scr + (8 * c) * 65 + n;
        u32x4 o; o.x = pk2(s[0 * 65], s[1 * 65]); o.y = pk2(s[2 * 65], s[3 * 65]); o.z = pk2(s[4 * 65], s[5 * 65]); o.w = pk2(s[6 * 65], s[7 * 65]);
        const int col = n0 + n; const int drow = (J.mode == 0) ? map_lin8(col) : map_pair(col, J.type);
        *(GAS u32x4*)(WT + (size_t)drow * J.K + k0 + 8 * c) = o; }
    LDS_WAIT(); asm volatile("" ::: "memory");
}
__device__ __forceinline__ bool prep_job(const Args& a, int j, PrepJob& J) {
    unsigned char* ws = a.ws; bf16_t* wsm = (bf16_t*)(ws + WS_WSM);
    const float* norm_mix = a.in[2]; const float* norm_ffn = a.in[15]; const float* norm_ple = a.in[23];
    J.sbs = 0; J.dbs = 0; J.nbatch = 1; J.gain = nullptr; J.type = 0; J.mode = 0;
    switch (j) {
    case 0: J = PrepJob{a.in[3], 3 * D, D, D, 1, 0, norm_mix, wsm + OFF_WINA / 2 + (size_t)2048 * D, 0, 0, 0}; return true;
    case 1: J = PrepJob{a.in[3] + D, 3 * D, D, D, 1, 0, norm_mix, wsm + OFF_WINA / 2, 0, 1, 0}; return true;
    case 2: J = PrepJob{a.in[3] + 2 * D, 3 * D, D, D, 1, 0, norm_mix, wsm + OFF_WINA / 2, 0, 1, 1}; return true;
    case 3: J = PrepJob{a.in[5], D, D, D, 1, 0, nullptr, wsm + OFF_WOUTA / 2, 0, 0, 0}; return true;
    case 4: J = PrepJob{a.in[6], 2 * D, D, 2 * D, 1, 0, norm_mix + D, wsm + OFF_WINB / 2, 0, 0, 0}; return true;
    case 5: J = PrepJob{a.in[9], 256, 256, 256, 8, (size_t)256 * 256, nullptr, wsm + OFF_WGATE / 2, (size_t)512 * 256, 1, 0}; return true;
    case 6: J = PrepJob{a.in[11], 256, 256, 256, 8, (size_t)256 * 256, nullptr, wsm + OFF_WGATE / 2, (size_t)512 * 256, 1, 1}; return true;
    case 7: J = PrepJob{a.in[14], D, D, D, 1, 0, nullptr, wsm + OFF_WOUTB / 2, 0, 0, 0}; return true;
    case 8: J = PrepJob{a.in[25], D, D, D, 1, 0, norm_ple, wsm + OFF_WPLEG / 2, 0, 0, 0}; return true;
    case 9: J = PrepJob{a.in[25] + (size_t)D * D, D, D, D, 1, 0, norm_ple + D, wsm + OFF_WPLEG / 2 + (size_t)D * D, 0, 0, 0}; return true;
    case 10: J = PrepJob{a.in[24], D, 256, D, 2, (size_t)256 * D, nullptr, wsm + OFF_WPLE / 2, (size_t)D * 256, 0, 0}; return true;
    case 11: case 12: { const int L = j - 11; bf16_t* base = (bf16_t*)(ws + WS_WMOE + (size_t)L * 96 * MiB);
        J = PrepJob{a.in[20] + (size_t)L * 32 * D * 512, 512, D, 512, 32, (size_t)D * 512, norm_ffn + L * D, base, (size_t)1024 * D, 1, 0}; return true; }
    case 13: case 14: { const int L = j - 13; bf16_t* base = (bf16_t*)(ws + WS_WMOE + (size_t)L * 96 * MiB);
        J = PrepJob{a.in[21] + (size_t)L * 32 * D * 512, 512, D, 512, 32, (size_t)D * 512, norm_ffn + L * D, base, (size_t)1024 * D, 1, 1}; return true; }
    case 15: case 16: { const int L = j - 15; bf16_t* base = (bf16_t*)(ws + WS_WMOE + (size_t)L * 96 * MiB + 64 * MiB);
        J = PrepJob{a.in[22] + (size_t)L * 32 * 512 * D, D, 512, D, 32, (size_t)512 * D, nullptr, base, (size_t)1024 * 512, 0, 0}; return true; }
    default: return false;
    }
}
constexpr int N_PREP_JOBS = 17;
__device__ __forceinline__ void p0_prologue(Frame& F, const Args& a, int job_lo, int job_hi) {
    LAS float* scr = (LAS float*)(F.lds + F.wave * 16640);
    const int gw = F.vcu * NWAVES + F.wave, NGW = F.G * NWAVES;
    for (int j = job_lo; j < job_hi; ++j) {
        PrepJob J; if (!prep_job(a, j, J)) break;
        const int items = J.nbatch * (J.K / 64) * (J.ncols / 64);
        for (int it = gw; it < items; it += NGW) prep_item(J, scr, it, F.lane);
    }
    {
        float* wrt = (float*)(a.ws + WS_WRT);
        for (int i = gw * 64 + F.lane; i < 2 * 48 * D; i += NGW * 64) { const int L = i / (48 * D), r = (i / D) % 48, k = i % D; const float g = a.in[15][L * D + k];
            wrt[i] = r < 4 ? g * a.in[16][((size_t)L * D + k) * 4 + r] : (r < 36 ? g * a.in[18][((size_t)L * D + k) * 32 + (r - 4)] : 0.f); }
    }
    const float* x = a.in[0]; bf16_t* xb = (bf16_t*)(a.ws + WS_R(0)); float* rstd = (float*)(a.ws + WS_RSTD);
    for (int m = gw; m < NTOK; m += NGW) {
        const GAS f32x4* xr = (const GAS f32x4*)(x + (size_t)m * D) + F.lane;
        f32x4 v[4]; float s = 0.f;
#pragma unroll
        for (int j = 0; j < 4; ++j) { v[j] = xr[64 * j]; s += (v[j].x * v[j].x + v[j].y * v[j].y) + (v[j].z * v[j].z + v[j].w * v[j].w); }
        s = wave_sum(s);
        GAS u32x2* o8 = (GAS u32x2*)(xb + (size_t)m * D) + F.lane;
#pragma unroll
        for (int j = 0; j < 4; ++j) { u32x2 w; w.x = pk2(v[j].x, v[j].y); w.y = pk2(v[j].z, v[j].w); o8[64 * j] = w; }
        if (F.lane == 0) rstd[m] = 1.0f / sqrtf(s * (1.0f / D) + EPS);
    }
    const GAS f32x4* p4 = (const GAS f32x4*)a.in[1]; GAS u32x2* pb = (GAS u32x2*)(a.ws + WS_PB);
    const size_t n4 = (size_t)2 * NTOK * 256 / 4;
    for (size_t i = (size_t)gw * 64 + F.lane; i < n4; i += (size_t)NGW * 64) { const f32x4 v = p4[i]; u32x2 w; w.x = pk2(v.x, v.y); w.y = pk2(v.z, v.w); pb[i] = w; }
}

struct DenseSched {
    pg::DenseOrder O; int lda2;
    __device__ __forceinline__ void init(int nN, int G, int c, int lda) { O.init(NTOK / 256, nN, G, c); lda2 = lda * 2; }
    __device__ __forceinline__ bool next(int i, pg::Unit& u) const { int pm, pn; if (!O.tile(i, pm, pn)) return false; u.arow = pm * 256; u.acol = 0; u.brow = pn * 256; u.orow = pm * 256; u.pn = pn; u.aux = i; return true; }
    __device__ __forceinline__ void a_offs(const pg::Unit& u, int R0, unsigned c2, unsigned (&o)[2][2]) const {
#pragma unroll
        for (int h = 0; h < 2; ++h)
#pragma unroll
            for (int i = 0; i < 2; ++i) o[h][i] = (unsigned)(u.arow + h * 128 + i * 64 + R0) * (unsigned)lda2 + (unsigned)u.acol * 2u + c2;
    }
};

struct EpiNull { __device__ __forceinline__ void operator()(const f32x4 (&acc)[2][2][4][2], const pg::Unit& u, int wr, int wc, int fr, int fq) const { f32x4 s = {0.f, 0.f, 0.f, 0.f};
#pragma unroll
    for (int a = 0; a < 2; ++a)
#pragma unroll
        for (int b = 0; b < 2; ++b)
#pragma unroll
            for (int m = 0; m < 4; ++m)
#pragma unroll
                for (int n = 0; n < 2; ++n) s += acc[a][b][m][n];
    asm volatile("" :: "v"(s)); } };
struct EpiInA {
    bf16_t* G; bf16_t* Bg; const LAS float* rt;
    __device__ __forceinline__ void operator()(const f32x4 (&acc)[2][2][4][2], const pg::Unit& u, int wr, int wc, int fr, int fq) const {
        const int row0 = u.orow + wr * 64 + fr;
        if (u.pn < 8) {
            const int col0 = u.pn * 128 + wc * 16 + fq * 4;
#pragma unroll
            for (int ai = 0; ai < 2; ++ai)
#pragma unroll
                for (int m = 0; m < 4; ++m) { const int row = row0 + ai * 128 + m * 16; const float s = rt[u.aux * 256 + wr * 64 + fr + ai * 128 + m * 16]; const float s2 = s * s;
#pragma unroll
                    for (int bj = 0; bj < 2; ++bj) { const f32x4 c = acc[ai][bj][m][0], h = acc[ai][bj][m][1];
                        u32x2 w; w.x = pg::cvt_pk_bf16(c[0] * h[0] * s2, c[1] * h[1] * s2); w.y = pg::cvt_pk_bf16(c[2] * h[2] * s2, c[3] * h[3] * s2);
                        *(u32x2*)(G + (size_t)row * D + col0 + bj * 64) = w; } }
        } else {
            const int col0 = (u.pn - 8) * 256 + wc * 32 + fq * 8;
#pragma unroll
            for (int ai = 0; ai < 2; ++ai)
#pragma unroll
                for (int m = 0; m < 4; ++m) { const int row = row0 + ai * 128 + m * 16; const float s = rt[u.aux * 256 + wr * 64 + fr + ai * 128 + m * 16];
#pragma unroll
                    for (int bj = 0; bj < 2; ++bj) { const f32x4 v0 = acc[ai][bj][m][0] * s, v1 = acc[ai][bj][m][1] * s;
                        u32x4 w; w.x = pg::cvt_pk_bf16(v0[0], v0[1]); w.y = pg::cvt_pk_bf16(v0[2], v0[3]); w.z = pg::cvt_pk_bf16(v1[0], v1[1]); w.w = pg::cvt_pk_bf16(v1[2], v1[3]);
                        *(u32x4*)(Bg + (size_t)row * D + col0 + bj * 128) = w; } }
        }
    }
};

template <bool F32RES>
struct EpiResid {
    const void* resid; bf16_t* H; float* ssp;
    __device__ __forceinline__ void operator()(const f32x4 (&acc)[2][2][4][2], const pg::Unit& u, int wr, int wc, int fr, int fq) const {
        const int row0 = u.orow + wr * 64 + fr, col0 = u.pn * 256 + wc * 32 + fq * 8;
        f32x4 pre[2][2][2]; u32x4 preh[2][2];
#define ER_LOAD(slot, g) do { const size_t off_ = (size_t)(row0 + ((g) >> 2) * 128 + ((g) & 3) * 16) * D + col0; _Pragma("unroll") for (int bj = 0; bj < 2; ++bj) { \
            if (F32RES) { pre[slot][bj][0] = *(const f32x4*)((const float*)resid + off_ + bj * 128); pre[slot][bj][1] = *(const f32x4*)((const float*)resid + off_ + bj * 128 + 4); } \
            else preh[slot][bj] = *(const u32x4*)((const bf16_t*)resid + off_ + bj * 128); } } while (0)
        ER_LOAD(0, 0); ER_LOAD(1, 1);
#pragma unroll
        for (int g = 0; g < 8; ++g) { const int ai = g >> 2, mm = g & 3, sl = g & 1; const int row = row0 + ai * 128 + mm * 16; const size_t off = (size_t)row * D + col0; float ss = 0.f;
            f32x4 v[2][2];
#pragma unroll
            for (int bj = 0; bj < 2; ++bj) {
                if (F32RES) { v[bj][0] = acc[ai][bj][mm][0] + pre[sl][bj][0]; v[bj][1] = acc[ai][bj][mm][1] + pre[sl][bj][1]; }
                else { float rf[8]; unpack8(preh[sl][bj], rf);
#pragma unroll
                    for (int j = 0; j < 4; ++j) { v[bj][0][j] = acc[ai][bj][mm][0][j] + rf[j]; v[bj][1][j] = acc[ai][bj][mm][1][j] + rf[4 + j]; } } }
            asm volatile("" : "+v"(v[0][0]), "+v"(v[0][1]), "+v"(v[1][0]), "+v"(v[1][1]));
            if (g + 2 < 8) ER_LOAD(sl, g + 2);
#pragma unroll
            for (int bj = 0; bj < 2; ++bj) { const f32x4 v0 = v[bj][0], v1 = v[bj][1];
                ss += (v0[0] * v0[0] + v0[1] * v0[1]) + (v0[2] * v0[2] + v0[3] * v0[3]) + (v1[0] * v1[0] + v1[1] * v1[1]) + (v1[2] * v1[2] + v1[3] * v1[3]);
                u32x4 w; w.x = pk2(v0[0], v0[1]); w.y = pk2(v0[2], v0[3]); w.z = pk2(v1[0], v1[1]); w.w = pk2(v1[2], v1[3]);
                *(u32x4*)(H + off + bj * 128) = w; }
            ss += __shfl_xor(ss, 16); ss += __shfl_xor(ss, 32);
            if (fq == 0) ssp[(size_t)row * 16 + u.pn * 4 + wc] = ss; }
#undef ER_LOAD
    }
};

__device__ __forceinline__ void p2_conv_a(Frame& F, const bf16_t* G, const bf16_t* Bg, const float* cw, bf16_t* A2) {
    const int gw = F.vcu * NWAVES + F.wave, NGW = F.G * NWAVES;
    for (int it = gw; it < 2048; it += NGW) {
        const int r0 = (it >> 1) * 16, c0 = (it & 1) * 512 + F.lane * 8, t0 = r0 % SEQ;
        float w0[8], w1[8], w2[8];
#pragma unroll
        for (int j = 0; j < 8; ++j) { w0[j] = cw[c0 + j]; w1[j] = cw[D + c0 + j]; w2[j] = cw[2 * D + c0 + j]; }
        const bf16_t* gp = G + (size_t)r0 * D + c0; const bf16_t* bp = Bg + (size_t)r0 * D + c0; bf16_t* op = A2 + (size_t)r0 * D + c0;
        float gm[8], gc[8], gn[8];
        if (t0 > 0) unpack8(*(const GAS u32x4*)(gp - D), gm); else {
#pragma unroll
            for (int j = 0; j < 8; ++j) gm[j] = 0.f; }
        unpack8(*(const GAS u32x4*)gp, gc);
#pragma unroll 4
        for (int r = 0; r < 16; ++r) {
            if (t0 + r + 1 < SEQ) unpack8(*(const GAS u32x4*)(gp + (size_t)(r + 1) * D), gn); else {
#pragma unroll
                for (int j = 0; j < 8; ++j) gn[j] = 0.f; }
            float b[8], o[8]; unpack8(*(const GAS u32x4*)(bp + (size_t)r * D), b);
#pragma unroll
            for (int j = 0; j < 8; ++j) { o[j] = b[j] * (w0[j] * gm[j] + w1[j] * gc[j] + w2[j] * gn[j]); gm[j] = gc[j]; gc[j] = gn[j]; }
            *(GAS u32x4*)(op + (size_t)r * D) = pack8(o);
        }
    }
}

__device__ __forceinline__ void p4_router(Frame& F, const bf16_t* Hh, const float* wrt, const float* bg, const float* be, unsigned* gcnt, int* lslot, float* lw, float* rstd_out) {
    LAS float* Lg = (LAS float*)F.lds; LAS float* ssL = (LAS float*)(F.lds + 24576);
    LAS int* s_e = (LAS int*)(F.lds + 25088); LAS float* s_w = (LAS float*)(F.lds + 25600); LAS int* s_rank = (LAS int*)(F.lds + 26112);
    LAS unsigned* lcnt = (LAS unsigned*)(F.lds + 26624); LAS unsigned* lbase = (LAS unsigned*)(F.lds + 26752);
    const int tg = F.wave & 3, kh = F.wave >> 2, t = F.lane & 15, q = F.lane >> 4;
    for (int blk = F.vcu; blk < NTOK / 64; blk += F.G) {
        if (F.tid < 32) lcnt[F.tid] = 0u;
        const GAS bf16_t* xrow = (const GAS bf16_t*)Hh + (size_t)(blk * 64 + 16 * tg + t) * D + kh * 512 + 8 * q;
        const GAS float* wrow = (const GAS float*)wrt + (size_t)t * D + kh * 512 + 8 * q;
        f32x4 acc0 = {0.f, 0.f, 0.f, 0.f}, acc1 = acc0, acc2 = acc0; float ss = 0.f;
#pragma unroll 2
        for (int st = 0; st < 16; ++st) {
            float xf[8]; unpack8(*(const GAS u32x4*)(xrow + 32 * st), xf);
#pragma unroll
            for (int hh = 0; hh < 2; ++hh) {
                const f32x4 w0 = *(const GAS f32x4*)(wrow + 32 * st + 4 * hh), w1 = *(const GAS f32x4*)(wrow + 16 * D + 32 * st + 4 * hh), w2 = *(const GAS f32x4*)(wrow + 32 * D + 32 * st + 4 * hh);
#pragma unroll
                for (int s = 0; s < 4; ++s) { const float xv = xf[4 * hh + s]; ss += xv * xv;
                    acc0 = __builtin_amdgcn_mfma_f32_16x16x4f32(w0[s], xv, acc0, 0, 0, 0);
                    acc1 = __builtin_amdgcn_mfma_f32_16x16x4f32(w1[s], xv, acc1, 0, 0, 0);
                    acc2 = __builtin_amdgcn_mfma_f32_16x16x4f32(w2[s], xv, acc2, 0, 0, 0); } }
        }
        ss += __shfl_xor(ss, 16); ss += __shfl_xor(ss, 32);
        { LAS float* L = Lg + ((kh * 64) + 16 * tg + t) * 48 + 4 * q;
          *(LAS f32x4*)(L) = acc0; *(LAS f32x4*)(L + 16) = acc1; *(LAS f32x4*)(L + 32) = acc2;
          if (q == 0) ssL[kh * 64 + 16 * tg + t] = ss; }
        LDS_WAIT(); __syncthreads();
        if (F.tid < 64) {
            const int ts = F.tid, tok = blk * 64 + ts; LAS float* L0 = Lg + ts * 48; const LAS float* L1 = Lg + (64 + ts) * 48;
            const float rs = 1.0f / sqrtf((ssL[ts] + ssL[64 + ts]) * (1.0f / D) + EPS);
            for (int j = 0; j < 4; ++j) L0[j] = (L0[j] + L1[j]) * rs + bg[j];
            for (int j = 0; j < 32; ++j) L0[4 + j] = (L0[4 + j] + L1[4 + j]) * rs + be[j];
            int g = 0;
            for (int j = 1; j < 4; ++j) if (L0[j] > L0[g]) g = j;
            float sg = 0.f; for (int j = 0; j < 4; ++j) sg += expf(L0[j] - L0[g]);
            const float pgt = 1.0f / sg;
            LAS float* le = L0 + 4 + g * 8;
            int i0 = 0; for (int i = 1; i < 8; ++i) if (le[i] > le[i0]) i0 = i;
            int i1 = (i0 == 0) ? 1 : 0; for (int i = 0; i < 8; ++i) if (i != i0 && le[i] > le[i1]) i1 = i;
            const float e1 = expf(le[i1] - le[i0]); const float w0 = 1.0f / (1.0f + e1), w1 = e1 / (1.0f + e1);
            const int E0 = g * 8 + i0, E1 = g * 8 + i1;
            s_e[2 * ts] = E0; s_e[2 * ts + 1] = E1; s_w[2 * ts] = pgt * w0; s_w[2 * ts + 1] = pgt * w1;
            s_rank[2 * ts] = (int)__hip_atomic_fetch_add(&lcnt[E0], 1u, __ATOMIC_RELAXED, __HIP_MEMORY_SCOPE_WORKGROUP);
            s_rank[2 * ts + 1] = (int)__hip_atomic_fetch_add(&lcnt[E1], 1u, __ATOMIC_RELAXED, __HIP_MEMORY_SCOPE_WORKGROUP);
            rstd_out[tok] = rs;
        }
        LDS_WAIT(); __syncthreads();
        if (F.tid < 32) lbase[F.tid] = __hip_atomic_fetch_add(gcnt + F.tid, lcnt[F.tid], __ATOMIC_RELAXED, __HIP_MEMORY_SCOPE_AGENT);
        LDS_WAIT(); __syncthreads();
        if (F.tid < 128) { const int s = F.tid, E = s_e[s]; const unsigned pos = lbase[E] + (unsigned)s_rank[s]; const int tok = blk * 64 + (s >> 1);
            lslot[(size_t)E * CAP + pos] = 2 * tok + (s & 1); lw[(size_t)E * CAP + pos] = s_w[s]; }
        LDS_WAIT(); __syncthreads();
    }
}

constexpr int MAXU = 5;
struct MoeSched {
    LAS int* ud; int n; const LAS unsigned* tabA; int mode; int lda2;
    __device__ __forceinline__ bool next(int i, pg::Unit& u) const { if (i >= n) return false; const int e = ud[4 * i], pn = ud[4 * i + 2], rbg = ud[4 * i + 3];
        u.arow = mode == 0 ? i * 256 : rbg * 256; u.acol = 0; u.brow = e * 1024 + pn * 256; u.orow = rbg * 256; u.pn = pn; u.aux = i; return true; }
    __device__ __forceinline__ void a_offs(const pg::Unit& u, int R0, unsigned c2, unsigned (&o)[2][2]) const {
#pragma unroll
        for (int h = 0; h < 2; ++h)
#pragma unroll
            for (int i = 0; i < 2; ++i) { const int r = h * 128 + i * 64 + R0;
                o[h][i] = (mode == 0 ? tabA[u.arow + r] : (unsigned)(u.arow + r) * (unsigned)lda2) + c2; }
    }
};
__device__ __forceinline__ int moe_setup(Frame& F, const unsigned* gcnt, const int* lslot, const float* lw, const float* rstd, int which) {
    LAS int* ud = (LAS int*)(F.lds + TAB_OFF); LAS unsigned* tabA = (LAS unsigned*)(F.lds + TAB_OFF + 128); LAS unsigned* tabB = (LAS unsigned*)(F.lds + TAB_OFF + 128 + MAXU * 1024);
    __syncthreads();
    if (F.tid == 0) {
        int n = 0, rbg = 0; const int c = F.vcu;
        for (int e = 0; e < NEXP; ++e) { const int nrb = ((int)gcnt[e] + 255) >> 8;
            for (int rb = 0; rb < nrb; ++rb, ++rbg)
                for (int pn = 0; pn < 4; ++pn) { const int L = 4 * rbg + pn; if ((L % F.G) == c && n < MAXU) { ud[4 * n] = e; ud[4 * n + 1] = rb; ud[4 * n + 2] = pn; ud[4 * n + 3] = rbg; ++n; } } }
        ud[4 * MAXU] = n;
    }
    __syncthreads();
    const int n = ud[4 * MAXU];
    for (int i = 0; i < n; ++i) {
        if (F.tid < 256) { const int e = ud[4 * i], rb = ud[4 * i + 1], idx = rb * 256 + F.tid; const bool ok = idx < (int)gcnt[e];
            const int slot = ok ? lslot[(size_t)e * CAP + idx] : 0;
            if (which == 0) { tabA[i * 256 + F.tid] = (unsigned)(slot >> 1) * (unsigned)(D * 2); tabB[i * 256 + F.tid] = __builtin_bit_cast(unsigned, rstd[slot >> 1]); }
            else { tabA[i * 256 + F.tid] = ok ? (unsigned)slot : 0xffffffffu; tabB[i * 256 + F.tid] = ok ? __builtin_bit_cast(unsigned, lw[(size_t)e * CAP + idx]) : 0u; } }
    }
    VM_WAIT(); LDS_WAIT();
    __syncthreads();
    return n;
}
struct EpiUp {
    bf16_t* HID; const LAS unsigned* tabB;
    __device__ __forceinline__ void operator()(const f32x4 (&acc)[2][2][4][2], const pg::Unit& u, int wr, int wc, int fr, int fq) const {
        const int r0 = wr * 64 + fr, col0 = u.pn * 128 + wc * 16 + fq * 4;
#pragma unroll
        for (int ai = 0; ai < 2; ++ai)
#pragma unroll
            for (int m = 0; m < 4; ++m) { const int r = r0 + ai * 128 + m * 16; const float s = __builtin_bit_cast(float, tabB[u.aux * 256 + r]);
#pragma unroll
                for (int bj = 0; bj < 2; ++bj) { const f32x4 g = acc[ai][bj][m][0] * s, v = acc[ai][bj][m][1] * s; float o[4];
#pragma unroll
                    for (int j = 0; j < 4; ++j) o[j] = g[j] * fsigm(g[j]) * v[j];
                    u32x2 w; w.x = pk2(o[0], o[1]); w.y = pk2(o[2], o[3]);
                    *(u32x2*)(HID + (size_t)(u.orow + r) * FEXP + col0 + bj * 64) = w; } }
    }
};
struct EpiDown {
    bf16_t* Y; const LAS unsigned* tabA; const LAS unsigned* tabB;
    __device__ __forceinline__ void operator()(const f32x4 (&acc)[2][2][4][2], const pg::Unit& u, int wr, int wc, int fr, int fq) const {
        const int r0 = wr * 64 + fr, col0 = u.pn * 256 + wc * 32 + fq * 8;
#pragma unroll
        for (int ai = 0; ai < 2; ++ai)
#pragma unroll
            for (int m = 0; m < 4; ++m) { const int r = r0 + ai * 128 + m * 16; const unsigned slot = tabA[u.aux * 256 + r]; const float w = __builtin_bit_cast(float, tabB[u.aux * 256 + r]);
                if (slot != 0xffffffffu) {
#pragma unroll
                    for (int bj = 0; bj < 2; ++bj) { const f32x4 v0 = acc[ai][bj][m][0] * w, v1 = acc[ai][bj][m][1] * w;
                        u32x4 o; o.x = pk2(v0[0], v0[1]); o.y = pk2(v0[2], v0[3]); o.z = pk2(v1[0], v1[1]); o.w = pk2(v1[2], v1[3]);
                        *(u32x4*)(Y + (size_t)slot * D + col0 + bj * 128) = o; } } }
    }
};
__device__ __forceinline__ void p7_combine(Frame& F, bf16_t* H, const bf16_t* Y, float* ssp) {
    DenseSched S; S.init(4, F.G, (int)blockIdx.x, D);
    pg::Unit u;
    const int hl = F.lane >> 5, cl = (F.lane & 31) * 8;
    for (int i = 0; S.next(i, u); ++i) {
        for (int r4 = 0; r4 < 16; r4 += 4) {
            u32x4 h[4], y0[4], y1[4];
#pragma unroll
            for (int j = 0; j < 4; ++j) { const int row = u.orow + 2 * (F.wave + 8 * (r4 + j)) + hl, col = u.pn * 256 + cl; const size_t off = (size_t)row * D + col;
                h[j] = *(const GAS u32x4*)(H + off); y0[j] = *(const GAS u32x4*)(Y + (size_t)(2 * row) * D + col); y1[j] = *(const GAS u32x4*)(Y + (size_t)(2 * row + 1) * D + col); }
            float ss[4]; u32x4 o[4];
#pragma unroll
            for (int j = 0; j < 4; ++j) { float a[8], b[8], c[8]; unpack8(h[j], a); unpack8(y0[j], b); unpack8(y1[j], c); float q = 0.f;
#pragma unroll
                for (int e = 0; e < 8; ++e) { a[e] += b[e] + c[e]; q += a[e] * a[e]; }
                ss[j] = q; o[j] = pack8(a); }
#pragma unroll
            for (int o_ = 1; o_ < 32; o_ <<= 1) {
#pragma unroll
                for (int j = 0; j < 4; ++j) ss[j] += __shfl_xor(ss[j], o_); }
#pragma unroll
            for (int j = 0; j < 4; ++j) { const int row = u.orow + 2 * (F.wave + 8 * (r4 + j)) + hl, col = u.pn * 256 + cl; const size_t off = (size_t)row * D + col;
                *(GAS u32x4*)(H + off) = o[j];
                if ((F.lane & 31) < 4) ssp[(size_t)row * 16 + u.pn * 4 + (F.lane & 31)] = (F.lane & 31) == 0 ? ss[j] : 0.f; }
        }
    }
}

__device__ __forceinline__ float row_rstd(const float* ssp, int row) {
    const f32x4* p = (const f32x4*)(ssp + (size_t)row * 16); const f32x4 a = p[0], b = p[1], c = p[2], d = p[3];
    const float ss = ((a[0] + a[1]) + (a[2] + a[3])) + ((b[0] + b[1]) + (b[2] + b[3])) + ((c[0] + c[1]) + (c[2] + c[3])) + ((d[0] + d[1]) + (d[2] + d[3]));
    return 1.0f / sqrtf(ss * (1.0f / D) + EPS);
}
template <class Sched>
__device__ __forceinline__ void rstd_table_setup(Frame& F, const Sched& S, const float* ssp, const float* bias) {
    LAS float* rt = (LAS float*)(F.lds + TAB_OFF);
    __syncthreads();
    pg::Unit u;
    for (int i = 0; S.next(i, u) && i < 6; ++i) if (F.tid < 256) { rt[i * 256 + F.tid] = row_rstd(ssp, u.orow + F.tid); if (bias) rt[6 * 256 + i * 256 + F.tid] = bias[u.pn * 256 + F.tid]; }
    LDS_WAIT(); __syncthreads();
}
__device__ __forceinline__ float gelu_t(float x) {
    const float z = 1.5957691216057308f * (x + 0.044715f * x * x * x); return x * fsigm(z);
}
struct EpiLin {
    bf16_t* O0; bf16_t* O1; int split, act0, act1; const LAS float* rt;
    __device__ __forceinline__ void operator()(const f32x4 (&acc)[2][2][4][2], const pg::Unit& u, int wr, int wc, int fr, int fq) const {
        const bool first = u.pn < split; bf16_t* O = first ? O0 : O1; const int act = first ? act0 : act1;
        const int row0 = u.orow + wr * 64 + fr, col0 = (first ? u.pn : u.pn - split) * 256 + wc * 32 + fq * 8;
#pragma unroll
        for (int ai = 0; ai < 2; ++ai)
#pragma unroll
            for (int m = 0; m < 4; ++m) { const int row = row0 + ai * 128 + m * 16; const float s = rt ? rt[u.aux * 256 + wr * 64 + fr + ai * 128 + m * 16] : 1.0f;
#pragma unroll
                for (int bj = 0; bj < 2; ++bj) { f32x4 v0 = acc[ai][bj][m][0] * s, v1 = acc[ai][bj][m][1] * s;
                    if (act == 1) {
#pragma unroll
                        for (int j = 0; j < 4; ++j) { v0[j] = gelu_t(v0[j]); v1[j] = gelu_t(v1[j]); } }
                    u32x4 w; w.x = pk2(v0[0], v0[1]); w.y = pk2(v0[2], v0[3]); w.z = pk2(v1[0], v1[1]); w.w = pk2(v1[2], v1[3]);
                    *(u32x4*)(O + (size_t)row * D + col0 + bj * 128) = w; }
                asm volatile("" ::: "memory"); __builtin_amdgcn_sched_barrier(0); }
    }
};
struct EpiPle {
    const bf16_t* Hin; bf16_t* Hout; const LAS float* rt; float* ssp_out; const bf16_t* PW;
    __device__ __forceinline__ void operator()(const f32x4 (&acc)[2][2][4][2], const pg::Unit& u, int wr, int wc, int fr, int fq) const {
        const int row0 = u.orow + wr * 64 + fr, col0 = u.pn * 256 + wc * 32 + fq * 8;
        const LAS float* bt = rt + 6 * 256 + u.aux * 256 + wc * 32 + fq * 8;
        u32x4 pre[2][2]; u32x4 ppw[2][2];
#define EP_LOAD(slot, g) do { const size_t off_ = (size_t)(row0 + ((g) >> 2) * 128 + ((g) & 3) * 16) * D + col0; _Pragma("unroll") for (int bj = 0; bj < 2; ++bj) { \
            pre[slot][bj] = *(const u32x4*)(Hin + off_ + bj * 128); ppw[slot][bj] = *(const u32x4*)(PW + off_ + bj * 128); } } while (0)
        EP_LOAD(0, 0); EP_LOAD(1, 1);
#pragma unroll
        for (int g = 0; g < 8; ++g) { const int ai = g >> 2, mm = g & 3, sl = g & 1; const int row = row0 + ai * 128 + mm * 16; const size_t off = (size_t)row * D + col0; const float s = rt[u.aux * 256 + wr * 64 + fr + ai * 128 + mm * 16]; float ss = 0.f;
            f32x4 h[2][2];
#pragma unroll
            for (int bj = 0; bj < 2; ++bj) { float pf[8]; unpack8(ppw[sl][bj], pf);
                const f32x4 a0 = acc[ai][bj][mm][0] * s + *(const LAS f32x4*)(bt + bj * 128), a1 = acc[ai][bj][mm][1] * s + *(const LAS f32x4*)(bt + bj * 128 + 4);
                { float hf_[8]; unpack8(pre[sl][bj], hf_);
#pragma unroll
                  for (int j = 0; j < 4; ++j) { h[bj][0][j] = hf_[j]; h[bj][1][j] = hf_[4 + j]; } }
#pragma unroll
                for (int j = 0; j < 4; ++j) { h[bj][0][j] += fsigm(a0[j]) * pf[j]; h[bj][1][j] += fsigm(a1[j]) * pf[4 + j]; } }
            asm volatile("" : "+v"(h[0][0]), "+v"(h[0][1]), "+v"(h[1][0]), "+v"(h[1][1]));
            if (g + 2 < 8) EP_LOAD(sl, g + 2);
#pragma unroll
            for (int bj = 0; bj < 2; ++bj) { const f32x4 h0 = h[bj][0], h1 = h[bj][1];
                ss += (h0[0] * h0[0] + h0[1] * h0[1]) + (h0[2] * h0[2] + h0[3] * h0[3]) + (h1[0] * h1[0] + h1[1] * h1[1]) + (h1[2] * h1[2] + h1[3] * h1[3]);
                u32x4 w; w.x = pk2(h0[0], h0[1]); w.y = pk2(h0[2], h0[3]); w.z = pk2(h1[0], h1[1]); w.w = pk2(h1[2], h1[3]);
                *(u32x4*)(Hout + off + bj * 128) = w; }
            ss += __shfl_xor(ss, 16); ss += __shfl_xor(ss, 32);
            if (fq == 0) ssp_out[(size_t)row * 16 + u.pn * 4 + wc] = ss; }
#undef EP_LOAD
    }
};
struct GateSched {
    pg::DenseOrder O;
    __device__ __forceinline__ void init(int G, int c) { O.init(NTOK / 256, 16, G, c); }
    __device__ __forceinline__ bool next(int i, pg::Unit& u) const { int pm, pn; if (!O.tile(i, pm, pn)) return false; u.arow = pm * 256; u.acol = ((pn >> 1) & 3) * 256; u.brow = pn * 256; u.orow = pm * 256; u.pn = pn; u.aux = 0; return true; }
    __device__ __forceinline__ void a_offs(const pg::Unit& u, int R0, unsigned c2, unsigned (&o)[2][2]) const {
#pragma unroll
        for (int h = 0; h < 2; ++h)
#pragma unroll
            for (int i = 0; i < 2; ++i) o[h][i] = (unsigned)(u.arow + h * 128 + i * 64 + R0) * (unsigned)(D * 2) + (unsigned)u.acol * 2u + c2;
    }
};
struct EpiGate {
    bf16_t* LA; bf16_t* GT; const bf16_t* ub; const float* br; const float* bi; const float* lam;
    __device__ __forceinline__ void operator()(const f32x4 (&acc)[2][2][4][2], const pg::Unit& u, int wr, int wc, int fr, int fq) const {
        const int d = u.pn >> 3, ch0 = ((u.pn >> 1) & 3) * 256 + (u.pn & 1) * 128 + wc * 16 + fq * 4, row0 = u.orow + wr * 64 + fr;
        f32x4 vbr[2], vbi[2], vsp[2];
#pragma unroll
        for (int bj = 0; bj < 2; ++bj) { vbr[bj] = *(const f32x4*)(br + d * D + ch0 + bj * 64); vbi[bj] = *(const f32x4*)(bi + d * D + ch0 + bj * 64);
            const f32x4 l = *(const f32x4*)(lam + d * D + ch0 + bj * 64);
#pragma unroll
            for (int j = 0; j < 4; ++j) vsp[bj][j] = -8.0f * 1.4426950408889634f * log1pf(expf(-l[j])); }
        bf16_t* la = LA + (size_t)d * NTOK * D; bf16_t* gt = GT + (size_t)d * NTOK * D;
#pragma unroll
        for (int ai = 0; ai < 2; ++ai)
#pragma unroll
            for (int m = 0; m < 4; ++m) { const int row = row0 + ai * 128 + m * 16;
#pragma unroll
                for (int bj = 0; bj < 2; ++bj) { const size_t off = (size_t)row * D + ch0 + bj * 64;
                    const u32x2 uw = *(const u32x2*)(ub + off); const float uf[4] = {bf_lo(uw.x), bf_hi(uw.x), bf_lo(uw.y), bf_hi(uw.y)};
                    const f32x4 rl = acc[ai][bj][m][0] + vbr[bj], il = acc[ai][bj][m][1] + vbi[bj]; float l2[4], g[4];
#pragma unroll
                    for (int j = 0; j < 4; ++j) { l2[j] = fsigm(rl[j]) * vsp[bj][j]; const float a2 = __builtin_amdgcn_exp2f(2.0f * l2[j]); g[j] = sqrtf(fmaxf(1.0f - a2, 0.f)) * (fsigm(il[j]) * uf[j]); }
                    u32x2 w; w.x = pk2(l2[0], l2[1]); w.y = pk2(l2[2], l2[3]); *(u32x2*)(la + off) = w;
                    w.x = pk2(g[0], g[1]); w.y = pk2(g[2], g[3]); *(u32x2*)(gt + off) = w; }
                asm volatile("" ::: "memory"); __builtin_amdgcn_sched_barrier(0); }
    }
};
__device__ __forceinline__ void p10_conv_b(Frame& F, const bf16_t* U, const float* cw, const float* cb, bf16_t* ub) {
    const int gw = F.vcu * NWAVES + F.wave, NGW = F.G * NWAVES;
    for (int it = gw; it < 2048; it += NGW) {
        const int r0 = (it >> 1) * 16, c0 = (it & 1) * 512 + F.lane * 8, t0 = r0 % SEQ;
        float w0[8], w1[8], w2[8], w3[8], bb[8];
#pragma unroll
        for (int j = 0; j < 8; ++j) { w0[j] = cw[c0 + j]; w1[j] = cw[D + c0 + j]; w2[j] = cw[2 * D + c0 + j]; w3[j] = cw[3 * D + c0 + j]; bb[j] = cb[c0 + j]; }
        const bf16_t* up = U + (size_t)r0 * D + c0; bf16_t* op = ub + (size_t)r0 * D + c0;
        float x0[8], x1[8], x2[8], x3[8];
        if (t0 > 0) { unpack8(*(const GAS u32x4*)(up - 2 * D), x0); unpack8(*(const GAS u32x4*)(up - D), x1); } else {
#pragma unroll
            for (int j = 0; j < 8; ++j) { x0[j] = 0.f; x1[j] = 0.f; } }
        unpack8(*(const GAS u32x4*)up, x2);
#pragma unroll 4
        for (int r = 0; r < 16; ++r) {
            if (t0 + r + 1 < SEQ) unpack8(*(const GAS u32x4*)(up + (size_t)(r + 1) * D), x3); else {
#pragma unroll
                for (int j = 0; j < 8; ++j) x3[j] = 0.f; }
            float o[8];
#pragma unroll
            for (int j = 0; j < 8; ++j) { o[j] = bb[j] + w0[j] * x0[j] + w1[j] * x1[j] + w2[j] * x2[j] + w3[j] * x3[j]; x0[j] = x1[j]; x1[j] = x2[j]; x2[j] = x3[j]; }
            *(GAS u32x4*)(op + (size_t)r * D) = pack8(o);
        }
    }
}
__device__ __forceinline__ float h2f(bf16_t v) { return (float)__builtin_bit_cast(_Float16, v); }
template <bool WRITE>
__device__ __forceinline__ void scan_pass(const GAS bf16_t* la, const GAS bf16_t* gt, GAS bf16_t* hs, int d, LAS bf16_t* tl, LAS bf16_t* tg, int lane, float& h, float& lsum) {
    const int rr = lane >> 3, c8 = (lane & 7) * 8;
    u32x4 rl[4], rg[4];
    { const int b0 = d ? 7 : 0;
#pragma unroll
      for (int i = 0; i < 4; ++i) { const size_t o = (size_t)(b0 * 32 + 8 * i + rr) * D + c8; rl[i] = *(const GAS u32x4*)(la + o); rg[i] = *(const GAS u32x4*)(gt + o); } }
    for (int bi = 0; bi < 8; ++bi) {
        const int bt = d ? 7 - bi : bi;
#pragma unroll
        for (int i = 0; i < 4; ++i) { *(LAS u32x4*)(tl + (8 * i + rr) * 64 + c8) = rl[i]; *(LAS u32x4*)(tg + (8 * i + rr) * 64 + c8) = rg[i]; }
        if (bi < 7) { const int bn = d ? 6 - bi : bi + 1;
#pragma unroll
            for (int i = 0; i < 4; ++i) { const size_t o = (size_t)(bn * 32 + 8 * i + rr) * D + c8; rl[i] = *(const GAS u32x4*)(la + o); rg[i] = *(const GAS u32x4*)(gt + o); } }
#pragma unroll 8
        for (int s = 0; s < 32; ++s) { const int row = d ? 31 - s : s; const float l = h2f(tl[row * 64 + lane]), g = h2f(tg[row * 64 + lane]);
            h = __builtin_amdgcn_exp2f(l) * h + g; lsum += l;
            if (WRITE) tg[row * 64 + lane] = __builtin_bit_cast(bf16_t, (_Float16)h); }
        if (WRITE) {
#pragma unroll
            for (int i = 0; i < 4; ++i) { const u32x4 v = *(const LAS u32x4*)(tg + (8 * i + rr) * 64 + c8); *(GAS u32x4*)(hs + (size_t)(bt * 32 + 8 * i + rr) * D + c8) = v; } }
    }
}
__device__ __forceinline__ void p12_scan(Frame& F, const bf16_t* LA, const bf16_t* GT, bf16_t* HS) {
    LAS float* sA = (LAS float*)F.lds; LAS float* sS = sA + 512;
    LAS bf16_t* tl = (LAS bf16_t*)(F.lds + 4096 + F.wave * 8192); LAS bf16_t* tg = tl + 2048;
    for (int id = F.vcu; id < 256; id += F.G) {
        const int d = id >> 7, b = (id >> 4) & 7, cg = id & 15, chunk = F.wave;
        const size_t base = ((size_t)d * NTOK + (size_t)b * SEQ + (size_t)chunk * 256) * D + cg * 64;
        const GAS bf16_t* la = (const GAS bf16_t*)LA + base; const GAS bf16_t* gt = (const GAS bf16_t*)GT + base; GAS bf16_t* hs = (GAS bf16_t*)HS + base;
        float h = 0.f, lsum = 0.f;
        scan_pass<false>(la, gt, hs, d, tl, tg, F.lane, h, lsum);
        sA[chunk * 64 + F.lane] = __builtin_amdgcn_exp2f(lsum); sS[chunk * 64 + F.lane] = h;
        LDS_WAIT(); __syncthreads();
        float c = 0.f;
        if (d == 0) { for (int cc = 0; cc < chunk; ++cc) c = sA[cc * 64 + F.lane] * c + sS[cc * 64 + F.lane]; }
        else { for (int cc = 7; cc > chunk; --cc) c = sA[cc * 64 + F.lane] * c + sS[cc * 64 + F.lane]; }
        h = c; lsum = 0.f;
        scan_pass<true>(la, gt, hs, d, tl, tg, F.lane, h, lsum);
        LDS_WAIT(); __syncthreads();
    }
}
__device__ __forceinline__ void p13_mul(Frame& F, const bf16_t* YB, const bf16_t* HS, bf16_t* A2) {
    const size_t n8 = (size_t)NTOK * D / 8, stride = (size_t)F.G * NWAVES * 64;
    for (size_t i = ((size_t)F.vcu * NWAVES + F.wave) * 64 + F.lane; i < n8; i += stride) {
        float y[8], a[8], b[8], o[8]; unpack8(((const GAS u32x4*)YB)[i], y); unpack8(((const GAS u32x4*)HS)[i], a); unpack8(((const GAS u32x4*)HS)[n8 + i], b);
#pragma unroll
        for (int j = 0; j < 8; ++j) o[j] = y[j] * (a[j] + b[j]);
        ((GAS u32x4*)A2)[i] = pack8(o);
    }
}
__device__ __forceinline__ void p20_final(Frame& F, const bf16_t* H, float* out, const float* ssp, const float* g, float bump) {
    DenseSched S; S.init(4, F.G, (int)blockIdx.x, D);
    pg::Unit u;
    const int hl = F.lane >> 5, cl = (F.lane & 31) * 8;
    for (int i = 0; S.next(i, u); ++i) {
        const f32x4 g0 = *(const GAS f32x4*)(g + u.pn * 256 + cl), g1 = *(const GAS f32x4*)(g + u.pn * 256 + cl + 4);
        for (int r4 = 0; r4 < 16; r4 += 4) {
            u32x4 h[4]; float s[4];
#pragma unroll
            for (int j = 0; j < 4; ++j) { const int row = u.orow + 2 * (F.wave + 8 * (r4 + j)) + hl; h[j] = *(const GAS u32x4*)(H + (size_t)row * D + u.pn * 256 + cl); s[j] = row_rstd(ssp, row); }
#pragma unroll
            for (int j = 0; j < 4; ++j) { const int row = u.orow + 2 * (F.wave + 8 * (r4 + j)) + hl; float a[8]; unpack8(h[j], a);
                f32x4 o0 = {a[0], a[1], a[2], a[3]}, o1 = {a[4], a[5], a[6], a[7]}; o0 = o0 * s[j] * g0; o1 = o1 * s[j] * g1;
                if (row == 0 && u.pn == 0 && F.lane == 0) o0[0] += bump;
                *(GAS f32x4*)(out + (size_t)row * D + u.pn * 256 + cl) = o0; *(GAS f32x4*)(out + (size_t)row * D + u.pn * 256 + cl + 4) = o1; }
        }
    }
}
__global__ void __launch_bounds__(NWAVES * 64, 2) mk_fwd(Args args) {
    extern __shared__ __attribute__((aligned(16))) unsigned char lds_[];
    Frame F;
    F.lds = (LAS unsigned char*)lds_;
    F.MISC = (volatile LAS unsigned*)(F.lds + MISC_OFF);
    F.tid = threadIdx.x; F.lane = F.tid & 63; F.wave = __builtin_amdgcn_readfirstlane(F.tid >> 6);
    F.G = gridDim.x; { const int bx = blockIdx.x; F.vcu = (F.G % 8 == 0) ? (bx % 8) * (F.G / 8) + bx / 8 : bx; }
    unsigned char* ws = args.ws;
    unsigned* ctl = (unsigned*)(ws + WS_CTL);
    for (int u = F.tid; u < (LDS_BYTES - MISC_OFF) / 4; u += NWAVES * 64) ((LAS unsigned*)(F.lds + MISC_OFF))[u] = 0u;
    __syncthreads();
    const int lo = args.ph_lo, hi = args.ph_hi;
    if (TS_PHASE >= 0 && blockIdx.x == 0 && threadIdx.x == 0) ((unsigned long long*)(ws + WS_CTL + 49152))[0] = __builtin_amdgcn_s_memrealtime();
    XcdBarrier bar; bar.bar = ctl + CW_BAR; bar.x = 0; bar.st = nullptr;
    if (hi - lo > 1) bar = xcd_barrier_post(ctl + CW_BAR, F.MISC + 8);
#define IN(k) (lo <= (k) && (k) < hi)
#define SEAM(k) do { if (IN(k) && IN((k) + 1)) { xcd_barrier(bar); if (REP_MASK & 0x80000000u) xcd_barrier(bar); } if (TS_PHASE >= 0 && blockIdx.x == 0 && threadIdx.x == 0) ((unsigned long long*)(ws + WS_CTL + 49152))[(k) + 1] = __builtin_amdgcn_s_memrealtime(); { int t_ = threadIdx.x; asm volatile("" : "+v"(t_)); F.tid = t_; F.lane = t_ & 63; } } while (0)
    bf16_t* wsm = (bf16_t*)(ws + WS_WSM);
    float* rstd = (float*)(ws + WS_RSTD);
    float* ssp0 = (float*)(ws + WS_SSP); float* ssp1 = (float*)(ws + WS_SSP1);
    bf16_t* PW = (bf16_t*)(ws + WS_PW); const bf16_t* pb = (const bf16_t*)(ws + WS_PB);
    bf16_t* HA = (bf16_t*)(ws + WS_HB); bf16_t* HB = (bf16_t*)args.out;
    const int c = (int)blockIdx.x;

    for (int rep_ = 0; rep_ < (((REP_MASK >> (0)) & 1) ? 2 : 1); ++rep_) if (IN(0)) { p0_prologue(F, args, 0, N_PREP_JOBS); }
    SEAM(0);
    {
            for (int rep_ = 0; rep_ < (((REP_MASK >> (1)) & 1) ? 2 : 1); ++rep_) if (IN(1)) {
                { pg::GemmDesc g{(const bf16_t*)(ws + WS_R(0)), D, wsm + OFF_WINA / 2, D, D};
                  DenseSched S; S.init(12, F.G, c, D);
                  { LAS float* rt = (LAS float*)(F.lds + TAB_OFF); pg::Unit u_; __syncthreads(); for (int i = 0; S.next(i, u_); ++i) if (F.tid < 256) rt[i * 256 + F.tid] = rstd[u_.orow + F.tid]; LDS_WAIT(); __syncthreads(); }
                  EpiInA E{(bf16_t*)(ws + WS_R(1)), (bf16_t*)(ws + WS_R(2)), (const LAS float*)(F.lds + TAB_OFF)};
                  if (NULL_EPI && rep_) { EpiNull EN; pg::gemm_phase<EpiNull, DenseSched, true>(F.lds, g, S, EN); } else
                  pg::gemm_phase<EpiInA, DenseSched, true>(F.lds, g, S, E); }
                { pg::GemmDesc g{pb, 256, wsm + OFF_WPLE / 2, 256, 256};
                  DenseSched S; S.init(4, F.G, c, 256);
                  EpiLin E{PW, PW, 99, 0, 0, nullptr};
                  pg::gemm_phase<EpiLin, DenseSched, true>(F.lds, g, S, E); }
            }
            SEAM(1);
            for (int rep_ = 0; rep_ < (((REP_MASK >> (2)) & 1) ? 2 : 1); ++rep_) if (IN(2)) p2_conv_a(F, (const bf16_t*)(ws + WS_R(1)), (const bf16_t*)(ws + WS_R(2)), args.in[4], (bf16_t*)(ws + WS_R(3)));
            SEAM(2);
            for (int rep_ = 0; rep_ < (((REP_MASK >> (3)) & 1) ? 2 : 1); ++rep_) if (IN(3)) {
                pg::GemmDesc g{(const bf16_t*)(ws + WS_R(3)), D, wsm + OFF_WOUTA / 2, D, D};
                DenseSched S; S.init(4, F.G, c, D);
                EpiResid<true> E{args.in[0], HA, ssp0};
                pg::gemm_phase<EpiResid<true>, DenseSched, true>(F.lds, g, S, E);
            }
            SEAM(3);
    }
    {
        const int PB = 4;
        unsigned* gcnt = ctl + CW_CNT + 0;
        int* lslot = (int*)(ws + WS_LSLOT); float* lw = (float*)(ws + WS_LW);
        bf16_t* wmoe = (bf16_t*)(ws + WS_WMOE + (size_t)0 * 96 * MiB);
        bf16_t* HID = (bf16_t*)(ws + WS_R(0)); bf16_t* Y = (bf16_t*)(ws + WS_R(2));
        for (int rep_ = 0; rep_ < (((REP_MASK >> (PB)) & 1) ? 2 : 1); ++rep_) if (IN(PB)) p4_router(F, HA, (const float*)(ws + WS_WRT) + (size_t)0 * 48 * D, args.in[17] + 0 * 4, args.in[19] + 0 * 32, rep_ ? ctl + CW_CNT + 256 : gcnt, rep_ ? (int*)(ws + WS_R(5)) : lslot, rep_ ? (float*)(ws + WS_R(5) + 4 * MiB) : lw, rstd);
        SEAM(PB);
        for (int rep_ = 0; rep_ < (((REP_MASK >> (PB + 1)) & 1) ? 2 : 1); ++rep_) if (IN(PB + 1)) {
            const int n = moe_setup(F, gcnt, lslot, lw, rstd, 0);
            MoeSched S{(LAS int*)(F.lds + TAB_OFF), n, (const LAS unsigned*)(F.lds + TAB_OFF + 128), 0, D * 2};
            pg::GemmDesc g{HA, D, wmoe, D, D};
            EpiUp E{HID, (const LAS unsigned*)(F.lds + TAB_OFF + 128 + MAXU * 1024)};
            pg::gemm_phase<EpiUp, MoeSched, true>(F.lds, g, S, E);
        }
        SEAM(PB + 1);
        for (int rep_ = 0; rep_ < (((REP_MASK >> (PB + 2)) & 1) ? 2 : 1); ++rep_) if (IN(PB + 2)) {
            const int n = moe_setup(F, gcnt, lslot, lw, rstd, 1);
            MoeSched S{(LAS int*)(F.lds + TAB_OFF), n, (const LAS unsigned*)(F.lds + TAB_OFF + 128), 1, FEXP * 2};
            pg::GemmDesc g{HID, FEXP, wmoe + (size_t)32 * 1024 * D, FEXP, FEXP};
            EpiDown E{Y, (const LAS unsigned*)(F.lds + TAB_OFF + 128), (const LAS unsigned*)(F.lds + TAB_OFF + 128 + MAXU * 1024)};
            pg::gemm_phase<EpiDown, MoeSched, true>(F.lds, g, S, E);
        }
        SEAM(PB + 2);
        for (int rep_ = 0; rep_ < (((REP_MASK >> (PB + 3)) & 1) ? 2 : 1); ++rep_) if (IN(PB + 3)) p7_combine(F, HA, Y, ssp0);
        SEAM(PB + 3);
        for (int rep_ = 0; rep_ < (((REP_MASK >> (PB + 4)) & 1) ? 2 : 1); ++rep_) if (IN(PB + 4)) {
            pg::GemmDesc g{HA, D, wsm + OFF_WPLEG / 2 + (size_t)0 * D * D, D, D};
            DenseSched S; S.init(4, F.G, c, D);
            rstd_table_setup(F, S, ssp0, args.in[26] + 0 * D);
            EpiPle E{HA, HB, (const LAS float*)(F.lds + TAB_OFF), ssp1, PW};
            pg::gemm_phase<EpiPle, DenseSched, true>(F.lds, g, S, E);
        }
        SEAM(PB + 4);
    }
    {
            bf16_t* YB = (bf16_t*)(ws + WS_R(0)); bf16_t* Ub = (bf16_t*)(ws + WS_R(1)); bf16_t* ub = (bf16_t*)(ws + WS_R(2));
            bf16_t* LA = (bf16_t*)(ws + WS_WMOE); bf16_t* GT = (bf16_t*)(ws + WS_R(3)); bf16_t* A2 = (bf16_t*)(ws + WS_R(5));
            for (int rep_ = 0; rep_ < (((REP_MASK >> (9)) & 1) ? 2 : 1); ++rep_) if (IN(9)) {
                { pg::GemmDesc g{HB, D, wsm + OFF_WINB / 2, D, D};
                  DenseSched S; S.init(8, F.G, c, D);
                  rstd_table_setup(F, S, ssp1, nullptr);
                  EpiLin E{YB, Ub, 4, 1, 0, (const LAS float*)(F.lds + TAB_OFF)};
                  pg::gemm_phase<EpiLin, DenseSched, true>(F.lds, g, S, E); }
                { pg::GemmDesc g{pb + (size_t)NTOK * 256, 256, wsm + OFF_WPLE / 2 + (size_t)D * 256, 256, 256};
                  DenseSched S; S.init(4, F.G, c, 256);
                  EpiLin E{PW, PW, 99, 0, 0, nullptr};
                  pg::gemm_phase<EpiLin, DenseSched, true>(F.lds, g, S, E); }
            }
            SEAM(9);
            for (int rep_ = 0; rep_ < (((REP_MASK >> (10)) & 1) ? 2 : 1); ++rep_) if (IN(10)) p10_conv_b(F, Ub, args.in[7], args.in[8], ub);
            SEAM(10);
            for (int rep_ = 0; rep_ < (((REP_MASK >> (11)) & 1) ? 2 : 1); ++rep_) if (IN(11)) {
                pg::GemmDesc g{ub, D, wsm + OFF_WGATE / 2, 256, 256};
                GateSched S; S.init(F.G, c);
                EpiGate E{LA, GT, ub, args.in[10], args.in[12], args.in[13]};
                pg::gemm_phase<EpiGate, GateSched, true>(F.lds, g, S, E);
            }
            SEAM(11);
            for (int rep_ = 0; rep_ < (((REP_MASK >> (12)) & 1) ? 2 : 1); ++rep_) if (IN(12)) p12_scan(F, LA, GT, (bf16_t*)(ws + WS_R(1)));
            SEAM(12);
            for (int rep_ = 0; rep_ < (((REP_MASK >> (13)) & 1) ? 2 : 1); ++rep_) if (IN(13)) p13_mul(F, YB, (const bf16_t*)(ws + WS_R(1)), A2);
            SEAM(13);
            for (int rep_ = 0; rep_ < (((REP_MASK >> (14)) & 1) ? 2 : 1); ++rep_) if (IN(14)) {
                pg::GemmDesc g{A2, D, wsm + OFF_WOUTB / 2, D, D};
                DenseSched S; S.init(4, F.G, c, D);
                EpiResid<false> E{HB, HB, ssp0};
                pg::gemm_phase<EpiResid<false>, DenseSched, true>(F.lds, g, S, E);
            }
            SEAM(14);
    }
    {
        const int PB = 15;
        unsigned* gcnt = ctl + CW_CNT + 64;
        int* lslot = (int*)(ws + WS_LSLOT); float* lw = (float*)(ws + WS_LW);
        bf16_t* wmoe = (bf16_t*)(ws + WS_WMOE + (size_t)1 * 96 * MiB);
        bf16_t* HID = (bf16_t*)(ws + WS_R(0)); bf16_t* Y = (bf16_t*)(ws + WS_R(2));
        for (int rep_ = 0; rep_ < (((REP_MASK >> (PB)) & 1) ? 2 : 1); ++rep_) if (IN(PB)) p4_router(F, HB, (const float*)(ws + WS_WRT) + (size_t)1 * 48 * D, args.in[17] + 1 * 4, args.in[19] + 1 * 32, rep_ ? ctl + CW_CNT + 320 : gcnt, rep_ ? (int*)(ws + WS_R(5)) : lslot, rep_ ? (float*)(ws + WS_R(5) + 4 * MiB) : lw, rstd);
        SEAM(PB);
        for (int rep_ = 0; rep_ < (((REP_MASK >> (PB + 1)) & 1) ? 2 : 1); ++rep_) if (IN(PB + 1)) {
            const int n = moe_setup(F, gcnt, lslot, lw, rstd, 0);
            MoeSched S{(LAS int*)(F.lds + TAB_OFF), n, (const LAS unsigned*)(F.lds + TAB_OFF + 128), 0, D * 2};
            pg::GemmDesc g{HB, D, wmoe, D, D};
            EpiUp E{HID, (const LAS unsigned*)(F.lds + TAB_OFF + 128 + MAXU * 1024)};
            pg::gemm_phase<EpiUp, MoeSched, true>(F.lds, g, S, E);
        }
        SEAM(PB + 1);
        for (int rep_ = 0; rep_ < (((REP_MASK >> (PB + 2)) & 1) ? 2 : 1); ++rep_) if (IN(PB + 2)) {
            const int n = moe_setup(F, gcnt, lslot, lw, rstd, 1);
            MoeSched S{(LAS int*)(F.lds + TAB_OFF), n, (const LAS unsigned*)(F.lds + TAB_OFF + 128), 1, FEXP * 2};
            pg::GemmDesc g{HID, FEXP, wmoe + (size_t)32 * 1024 * D, FEXP, FEXP};
            EpiDown E{Y, (const LAS unsigned*)(F.lds + TAB_OFF + 128), (const LAS unsigned*)(F.lds + TAB_OFF + 128 + MAXU * 1024)};
            pg::gemm_phase<EpiDown, MoeSched, true>(F.lds, g, S, E);
        }
        SEAM(PB + 2);
        for (int rep_ = 0; rep_ < (((REP_MASK >> (PB + 3)) & 1) ? 2 : 1); ++rep_) if (IN(PB + 3)) p7_combine(F, HB, Y, ssp0);
        SEAM(PB + 3);
        for (int rep_ = 0; rep_ < (((REP_MASK >> (PB + 4)) & 1) ? 2 : 1); ++rep_) if (IN(PB + 4)) {
            pg::GemmDesc g{HB, D, wsm + OFF_WPLEG / 2 + (size_t)1 * D * D, D, D};
            DenseSched S; S.init(4, F.G, c, D);
            rstd_table_setup(F, S, ssp0, args.in[26] + 1 * D);
            EpiPle E{HB, HA, (const LAS float*)(F.lds + TAB_OFF), ssp1, PW};
            pg::gemm_phase<EpiPle, DenseSched, true>(F.lds, g, S, E);
        }
        SEAM(PB + 4);
    }
    for (int rep_ = 0; rep_ < (((REP_MASK >> (20)) & 1) ? 2 : 1); ++rep_) if (IN(20)) { float bump = 0.f; if (TS_PHASE >= 0) { const unsigned long long* ts = (const unsigned long long*)(ws + WS_CTL + 49152); bump = sqrtf(167.0f * 0.01f * (float)(ts[TS_PHASE + 1] - ts[TS_PHASE])); }
        p20_final(F, HA, args.out, ssp1, args.in[27], bump); }
#undef IN
#undef SEAM
}
extern "C" void kernel_launch(void* const* d_in, const int* in_sizes, int n_in, void* d_out, int out_size, void* d_ws, size_t ws_size, hipStream_t stream) {
    static int grid = 0;
    if (grid == 0) {
        if (n_in != 28 || out_size != NTOK * D || ws_size < WS_END) { fprintf(stderr, "kernel_launch: unexpected problem (n_in %d, out %d, ws %zu < %zu)\n", n_in, out_size, ws_size, (size_t)WS_END); grid = -1; return; }
        int dev = 0, cus = 0, per_cu = 0;
        if (hipGetDevice(&dev) != hipSuccess || hipDeviceGetAttribute(&cus, hipDeviceAttributeMultiprocessorCount, dev) != hipSuccess) { grid = -1; return; }
        if (hipFuncSetAttribute((const void*)mk_fwd, hipFuncAttributeMaxDynamicSharedMemorySize, LDS_BYTES) != hipSuccess) { grid = -1; return; }
        if (hipOccupancyMaxActiveBlocksPerMultiprocessor(&per_cu, (const void*)mk_fwd, NWAVES * 64, LDS_BYTES) != hipSuccess || per_cu < 1) { fprintf(stderr, "kernel_launch: occupancy query says %d\n", per_cu); per_cu = 1; }
        (void)hipGetLastError();
        grid = cus;
    }
    if (grid < 0) return;
    (void)in_sizes;
    (void)hipMemsetAsync((char*)d_ws + WS_CTL, 0, CTL_ZERO_BYTES, stream);
    Args a{};
    for (int i = 0; i < 28; ++i) a.in[i] = (const float*)d_in[i];
    a.out = (float*)d_out; a.ws = (unsigned char*)d_ws; a.ph_lo = 0; a.ph_hi = 21;
    hipLaunchKernelGGL(mk_fwd, dim3(grid), dim3(NWAVES * 64), LDS_BYTES, stream, a);
}
```
